# Optimizing an MI355X kernel written in HIP

```python
import math
import jax, jax.numpy as jnp
from jax import lax
import numpy as np

D_MODEL = 4096
BATCH = 4
SEQ = 4096
DEPTH = 1

MEM_LEN = 256
EPS = 1e-6

DA_HEADS = 16
DA_HALF = 64
DA_VDIM = 2 * DA_HALF
DA_WIDTH = DA_HEADS * DA_VDIM
HG_HEADS = 16
HG_DK = 128
HG_DV = 128
HG_WIDTH = HG_HEADS * HG_DV
HG_CHUNK = 64
MIX_WIDTH = DA_WIDTH + HG_WIDTH
IN_SIZES = (DA_HEADS * 2 * DA_HALF, DA_HEADS * 2 * DA_HALF, DA_WIDTH,
            HG_HEADS * HG_DK, HG_HEADS * HG_DK, HG_WIDTH, HG_WIDTH)
IN_WIDTH = sum(IN_SIZES)
IN_OFFSETS = tuple(int(o) for o in np.cumsum(IN_SIZES)[:-1])
Q_BLOCK = 128
XA_HEADS = 4
XA_HDIM = D_MODEL // XA_HEADS
PEER_HEADS = 8
PEER_NKEYS = 128
PEER_N = PEER_NKEYS * PEER_NKEYS
PEER_QDIM = 256
PEER_HALF = PEER_QDIM // 2
PEER_TOPK = 16
PEER_TOK_BLOCK = 128

kernel_name = "hybrid_diffattn_hgrn2_peer_block"


def rmsnorm(x, g):
    xf = x.astype(jnp.float32)
    y = xf * lax.rsqrt(jnp.mean(xf * xf, axis=-1, keepdims=True) + EPS)
    return (y * g.astype(jnp.float32)).astype(x.dtype)


def alibi_slopes(n_heads):
    return jnp.asarray(np.array([2.0 ** (-8.0 * (h + 1) / n_heads) for h in range(n_heads)], dtype=np.float32))


def diff_attention(q, k, v, lq1, lk1, lq2, lk2, subln_g, layer_idx):
    B, S = q.shape[0], q.shape[1]
    lam_init = 0.8 - 0.6 * math.exp(-0.3 * layer_idx)
    f32 = jnp.float32
    lam = (jnp.exp(jnp.sum(lq1.astype(f32) * lk1.astype(f32)))
           - jnp.exp(jnp.sum(lq2.astype(f32) * lk2.astype(f32))) + lam_init)
    scale = DA_HALF ** -0.5
    slopes = alibi_slopes(DA_HEADS)
    kpos = jnp.arange(S)
    n_blocks = S // Q_BLOCK
    qb = q.reshape(B, n_blocks, Q_BLOCK, DA_HEADS, 2, DA_HALF).transpose(1, 0, 2, 3, 4, 5)

    def block(args):
        qblk, blk = args
        qpos = blk * Q_BLOCK + jnp.arange(Q_BLOCK)
        dist = (qpos[:, None] - kpos[None, :]).astype(f32)
        bias = jnp.where(dist[None] >= 0, -slopes[:, None, None] * dist[None], -jnp.inf)
        s = jnp.einsum('bqhcd,bkhcd->bchqk', qblk, k).astype(f32) * scale + bias[None, None]
        p = jax.nn.softmax(s, axis=-1)
        attn = p[:, 0] - lam * p[:, 1]
        return jnp.einsum('bhqk,bkhd->bqhd', attn.astype(v.dtype), v)

    out = lax.map(block, (qb, jnp.arange(n_blocks)))
    out = out.transpose(1, 0, 2, 3, 4).reshape(B, S, DA_HEADS, DA_VDIM)
    out = rmsnorm(out, subln_g) * (1.0 - lam_init)
    return out.reshape(B, S, DA_WIDTH)


def hgrn2(q, f_logit, i, g, lb, norm_g):
    B, S = q.shape[0], q.shape[1]
    f32 = jnp.float32
    qf = jax.nn.silu(q.astype(f32))
    f = lb + (1.0 - lb) * jax.nn.sigmoid(f_logit.astype(f32))
    logf = jnp.log(f)
    kf = 1.0 - f
    nc = S // HG_CHUNK

    def to_chunks(t):
        return t.reshape(B, nc, HG_CHUNK, HG_HEADS, t.shape[-1]).transpose(1, 0, 3, 2, 4)

    causal = jnp.tril(jnp.ones((HG_CHUNK, HG_CHUNK), dtype=bool))

    def step(state, inp):
        qc, kc, lfc, ic = inp
        b = jnp.cumsum(lfc, axis=2)
        dec = b[:, :, :, None, :] - b[:, :, None, :, :]
        dec = jnp.where(causal[None, None, :, :, None], dec, -jnp.inf)
        a = jnp.einsum('bhtd,bhsd,bhtsd->bhts', qc, kc, jnp.exp(dec))
        o = (jnp.einsum('bhts,bhsv->bhtv', a, ic)
             + jnp.einsum('bhtd,bhdv->bhtv', qc * jnp.exp(b), state))
        b_end = b[:, :, -1:, :]
        new_state = (jnp.exp(b_end[:, :, 0, :])[..., None] * state
                     + jnp.einsum('bhsd,bhsv->bhdv', kc * jnp.exp(b_end - b), ic))
        return new_state, o

    s0 = jnp.zeros((B, HG_HEADS, HG_DK, HG_DV), f32)
    _, o = lax.scan(step, s0, (to_chunks(qf), to_chunks(kf), to_chunks(logf), to_chunks(i.astype(f32))))
    o = o.transpose(1, 0, 3, 2, 4).reshape(B, S, HG_HEADS, HG_DV)
    o = rmsnorm(o, norm_g) * jax.nn.silu(g.astype(f32))
    return o.reshape(B, S, HG_WIDTH).astype(q.dtype)


def cross_attention(hn, mem_n, w_q, w_kv, w_o):
    B, S, _ = hn.shape
    M = mem_n.shape[1]
    q = (hn @ w_q).reshape(B, S, XA_HEADS, XA_HDIM)
    kv = (mem_n @ w_kv).reshape(B, M, 2, XA_HEADS, XA_HDIM)
    k, v = kv[:, :, 0], kv[:, :, 1]
    s = jnp.einsum('bqhd,bkhd->bhqk', q, k).astype(jnp.float32) * (XA_HDIM ** -0.5)
    p = jax.nn.softmax(s, axis=-1)
    o = jnp.einsum('bhqk,bkhd->bqhd', p.astype(v.dtype), v).reshape(B, S, D_MODEL)
    return o @ w_o


def peer(hn, w_q, sub_keys, down, up):
    B, S, D = hn.shape
    tok = hn.reshape(-1, PEER_TOK_BLOCK, D)

    def block(xb):
        t = xb.shape[0]
        q = (xb @ w_q).reshape(t, PEER_HEADS, 2, PEER_HALF)
        s = jnp.einsum('thcd,hckd->thck', q, sub_keys).astype(jnp.float32)
        sv, si = lax.top_k(s, PEER_TOPK)
        cand = (sv[:, :, 0, :, None] + sv[:, :, 1, None, :]).reshape(t, PEER_HEADS, PEER_TOPK * PEER_TOPK)
        cidx = (si[:, :, 0, :, None] * PEER_NKEYS + si[:, :, 1, None, :]).reshape(t, PEER_HEADS, PEER_TOPK * PEER_TOPK)
        best, pos = lax.top_k(cand, PEER_TOPK)
        eidx = jnp.take_along_axis(cidx, pos, axis=-1)
        gate = jax.nn.softmax(best, axis=-1)
        u = down[eidx]
        act = jax.nn.gelu(jnp.einsum('td,thkd->thk', xb, u).astype(jnp.float32), approximate=False)
        w = (gate * act).astype(xb.dtype)
        return jnp.einsum('thk,thkd->td', w, up[eidx])

    return lax.map(block, tok).reshape(B, S, D)


def setup_inputs(seed: int = 0) -> dict:
    key = jax.random.key(seed)
    ks = jax.random.split(key, 24)
    f32 = jnp.float32
    D = D_MODEL

    def nrm(k, shape, scale):
        return jax.random.normal(k, shape, f32) * scale

    def gain(k, shape):
        return 1.0 + 0.02 * jax.random.normal(k, shape, f32)

    return {
        "x": nrm(ks[0], (BATCH, SEQ, D), 1.0),
        "mem": nrm(ks[1], (BATCH, MEM_LEN, D), 1.0),
        "mix_norm_g": gain(ks[2], (DEPTH, D)),
        "w_in": nrm(ks[3], (DEPTH, D, IN_WIDTH), D ** -0.5),
        "da_lambda_q1": nrm(ks[4], (DEPTH, DA_HALF), 0.1),
        "da_lambda_k1": nrm(ks[5], (DEPTH, DA_HALF), 0.1),
        "da_lambda_q2": nrm(ks[6], (DEPTH, DA_HALF), 0.1),
        "da_lambda_k2": nrm(ks[7], (DEPTH, DA_HALF), 0.1),
        "da_subln_g": gain(ks[8], (DEPTH, DA_VDIM)),
        "hgrn_gamma": nrm(ks[9], (DEPTH + 1, HG_HEADS * HG_DK), 0.5),
        "hgrn_norm_g": gain(ks[10], (DEPTH, HG_DV)),
        "w_out": nrm(ks[11], (DEPTH, MIX_WIDTH, D), MIX_WIDTH ** -0.5),
        "cross_norm_g": gain(ks[12], (DEPTH, D)),
        "mem_norm_g": gain(ks[13], (DEPTH, D)),
        "w_cq": nrm(ks[14], (DEPTH, D, D), D ** -0.5),
        "w_ckv": nrm(ks[15], (DEPTH, D, 2 * D), D ** -0.5),
        "w_co": nrm(ks[16], (DEPTH, D, D), D ** -0.5),
        "ffn_norm_g": gain(ks[17], (DEPTH, D)),
        "peer_wq": nrm(ks[18], (DEPTH, D, PEER_HEADS * PEER_QDIM), D ** -0.5),
        "peer_subkeys": nrm(ks[19], (DEPTH, PEER_HEADS, 2, PEER_NKEYS, PEER_HALF), PEER_HALF ** -0.5),
        "peer_down": nrm(ks[20], (DEPTH, PEER_N, D), D ** -0.5),
        "peer_up": nrm(ks[21], (DEPTH, PEER_N, D), 0.5),
        "final_norm_g": gain(ks[22], (D,)),
    }


def reference(x, mem, mix_norm_g, w_in, da_lambda_q1, da_lambda_k1, da_lambda_q2, da_lambda_k2,
              da_subln_g, hgrn_gamma, hgrn_norm_g, w_out, cross_norm_g, mem_norm_g, w_cq, w_ckv, w_co,
              ffn_norm_g, peer_wq, peer_subkeys, peer_down, peer_up, final_norm_g):
    B, S, _ = x.shape
    lb_all = jnp.cumsum(jax.nn.softmax(hgrn_gamma.astype(jnp.float32), axis=0), axis=0)
    h = x
    for l in range(DEPTH):
        xn = rmsnorm(h, mix_norm_g[l])
        proj = xn @ w_in[l]
        dq, dk, dv, hq, hf, hi, hg = jnp.split(proj, IN_OFFSETS, axis=-1)
        a_out = diff_attention(
            dq.reshape(B, S, DA_HEADS, 2, DA_HALF), dk.reshape(B, S, DA_HEADS, 2, DA_HALF),
            dv.reshape(B, S, DA_HEADS, DA_VDIM),
            da_lambda_q1[l], da_lambda_k1[l], da_lambda_q2[l], da_lambda_k2[l], da_subln_g[l], l)
        b_out = hgrn2(
            hq.reshape(B, S, HG_HEADS, HG_DK), hf.reshape(B, S, HG_HEADS, HG_DK),
            hi.reshape(B, S, HG_HEADS, HG_DV), hg.reshape(B, S, HG_HEADS, HG_DV),
            lb_all[l].reshape(HG_HEADS, HG_DK), hgrn_norm_g[l])
        h = h + jnp.concatenate([a_out, b_out], axis=-1) @ w_out[l]
        h = h + cross_attention(rmsnorm(h, cross_norm_g[l]), rmsnorm(mem, mem_norm_g[l]),
                                w_cq[l], w_ckv[l], w_co[l])
        h = h + peer(rmsnorm(h, ffn_norm_g[l]), peer_wq[l], peer_subkeys[l], peer_down[l], peer_up[l])
    return rmsnorm(h, final_norm_g)
```

```cpp
#include <hip/hip_runtime.h>
#include <cstdio>
#include <cstdint>

namespace pg8 {
#define PG8_LAS __attribute__((address_space(3)))
typedef unsigned short bf16_t;
typedef short bf16x8 __attribute__((ext_vector_type(8)));
typedef float f32x4 __attribute__((ext_vector_type(4)));
typedef unsigned u32x4 __attribute__((ext_vector_type(4)));
constexpr int BM = 256, BK = 64, HALF = 128, HTB = HALF * BK * 2  , STAGE_BYTES = 8 * HTB, NXCD = 8, WGM = 8;

__host__ __device__ __forceinline__ int lds_byte(int r, int c) { const int st = (r >> 4) * 2 + (c >> 5), rr = r & 15, cc = c & 31, ob = rr * 64 + cc * 2; return st * 1024 + (ob ^ (((ob >> 9) & 1) << 5)); }
__host__ __device__ __forceinline__ void stage_rc(int b, int& R, int& C) { const int st = b / 1024, sb = b % 1024, swz = sb ^ (((sb >> 9) & 1) << 5); R = (st >> 1) * 16 + swz / 64; C = (st & 1) * 32 + (swz % 64) / 2; }
__host__ __device__ __forceinline__ int perm32(int rho) { const int n = rho >> 4, i = rho & 15; return 8 * (i >> 2) + 4 * n + (i & 3); }

struct Unit { int pm, pn, zb, zh; };
struct Gemm {
    const bf16_t* A; const bf16_t* Bt; int K, lda, ldb; size_t a_zb, a_zh, b_zb, b_zh;
    __device__ __forceinline__ const char* a_ptr(const Unit& u) const { return (const char*)(A + (size_t)u.zb * a_zb + (size_t)u.zh * a_zh + (size_t)u.pm * BM * lda); }
    __device__ __forceinline__ const char* b_ptr(const Unit& u) const { return (const char*)(Bt + (size_t)u.zb * b_zb + (size_t)u.zh * b_zh + (size_t)u.pn * BM * ldb); }
};

struct StaticOrder {
    int nM, nN, nwg, G, c, zdiv;
    __host__ __device__ void init(int M, int N, int G_, int c_, int zdiv_) { nM = M / BM; nN = N / BM; nwg = nM * nN; G = G_; c = c_; zdiv = zdiv_; }
    __host__ __device__ bool next(int i, Unit& u) const {
        const long L = (long)i * G + c; if (L >= nwg) return false;
        int wgid = (int)L; { const int q = nwg / NXCD, r = nwg % NXCD, xcd = wgid % NXCD, off = wgid / NXCD; wgid = (xcd < r ? xcd * (q + 1) : r * (q + 1) + (xcd - r) * q) + off; }
        const int nig = WGM * nN, gid = wgid / nig, fm = gid * WGM, gsz = (nM - fm) < WGM ? (nM - fm) : WGM;
        u.pm = fm + ((wgid % nig) % gsz); u.pn = (wgid % nig) / gsz; u.zb = u.pm / zdiv; u.zh = 0; return true;
    }
    __device__ __forceinline__ void a_ready(const Unit&) const {}
    __device__ __forceinline__ void done(const Unit&) const {}
};
struct BatchOrder {
    int nM, nN, nzh, ntot, G, c;
    __host__ __device__ void init(int nzb_, int nzh_, int nM_, int nN_, int G_, int c_) { nM = nM_; nN = nN_; nzh = nzh_; ntot = nzb_ * nzh_ * nM_ * nN_; G = G_; c = c_; }
    __host__ __device__ bool next(int i, Unit& u) const {
        const long L = (long)i * G + c; if (L >= ntot) return false;
        const int l = (int)L, per = nM * nN, z = l / per, r = l % per; u.zb = z / nzh; u.zh = z % nzh; u.pm = r / nN; u.pn = r % nN; return true;
    }
    __device__ __forceinline__ void a_ready(const Unit&) const {}
    __device__ __forceinline__ void done(const Unit&) const {}
};

__device__ __forceinline__ unsigned cvt_pk_bf16(float lo, float hi) { typedef float f2 __attribute__((ext_vector_type(2))); typedef __bf16 b2 __attribute__((ext_vector_type(2))); f2 v = {lo, hi}; b2 b = __builtin_convertvector(v, b2); return __builtin_bit_cast(unsigned, b); }
__device__ __forceinline__ u32x4 pack8(const f32x4& v0, const f32x4& v1) { u32x4 w; w.x = cvt_pk_bf16(v0[0], v0[1]); w.y = cvt_pk_bf16(v0[2], v0[3]); w.z = cvt_pk_bf16(v1[0], v1[1]); w.w = cvt_pk_bf16(v1[2], v1[3]); return w; }
__device__ __forceinline__ float sigm(float t) { return __builtin_amdgcn_rcpf(1.0f + __expf(-t)); }

constexpr float QK_SCALE_LOG2E = 0.125f * 1.4426950408889634f;
struct EpiInproj {
    static constexpr bool PERM = true, AFTER_DRAIN = false;
    bf16_t* O; int ldc; const float* gamma;
    __device__ __forceinline__ void operator()(const f32x4 (&acc)[2][2][4][2], const Unit& u, int wr, int wc, int fr, int fq) const {
        const int seg = u.pn >> 3; const int row0 = u.pm * BM + wr * 64 + fr, col0 = u.pn * BM + wc * 32 + 8 * fq;
#pragma unroll
        for (int bj = 0; bj < 2; ++bj) {
            const int col = col0 + bj * HALF;
            f32x4 om0 = {1.f, 1.f, 1.f, 1.f}, om1 = om0;
            if (seg == 4) { const int c = col - 8192; const f32x4 g00 = *(const f32x4*)(gamma + c), g01 = *(const f32x4*)(gamma + c + 4), g10 = *(const f32x4*)(gamma + 2048 + c), g11 = *(const f32x4*)(gamma + 2048 + c + 4);
#pragma unroll
                for (int e = 0; e < 4; ++e) { om0[e] = sigm(g10[e] - g00[e]); om1[e] = sigm(g11[e] - g01[e]); } }
#pragma unroll
            for (int ai = 0; ai < 2; ++ai)
#pragma unroll
                for (int m = 0; m < 4; ++m) {
                    f32x4 v0 = acc[ai][bj][m][0], v1 = acc[ai][bj][m][1];
                    if (seg == 3 || seg == 6) {
#pragma unroll
                        for (int e = 0; e < 4; ++e) { v0[e] = v0[e] * sigm(v0[e]); v1[e] = v1[e] * sigm(v1[e]); }
                    } else if (seg == 4) {
#pragma unroll
                        for (int e = 0; e < 4; ++e) { v0[e] = om0[e] * sigm(-v0[e]); v1[e] = om1[e] * sigm(-v1[e]); }
                    } else if (seg == 0) { v0 = v0 * QK_SCALE_LOG2E; v1 = v1 * QK_SCALE_LOG2E; }
                    *(u32x4*)(O + (size_t)(row0 + ai * HALF + m * 16) * ldc + col) = pack8(v0, v1);
                }
        }
    }
};
struct EpiBf16Z {
    static constexpr bool PERM = true, AFTER_DRAIN = false;
    bf16_t* O; int ldc; size_t c_zb, c_zh;
    __device__ __forceinline__ void operator()(const f32x4 (&acc)[2][2][4][2], const Unit& u, int wr, int wc, int fr, int fq) const {
        bf16_t* base = O + (size_t)u.zb * c_zb + (size_t)u.zh * c_zh; const int row0 = u.pm * BM + wr * 64 + fr, col0 = u.pn * BM + wc * 32 + 8 * fq;
#pragma unroll
        for (int ai = 0; ai < 2; ++ai)
#pragma unroll
            for (int m = 0; m < 4; ++m)
#pragma unroll
                for (int bj = 0; bj < 2; ++bj) *(u32x4*)(base + (size_t)(row0 + ai * HALF + m * 16) * ldc + col0 + bj * HALF) = pack8(acc[ai][bj][m][0], acc[ai][bj][m][1]);
    }
};
struct EpiResid {
    static constexpr bool PERM = true, AFTER_DRAIN = false;
    const float* resid; float* outf; bf16_t* outb; float* ssq;
    __device__ __forceinline__ void operator()(const f32x4 (&acc)[2][2][4][2], const Unit& u, int wr, int wc, int fr, int fq) const {
        const int row0 = u.pm * BM + wr * 64 + fr, col0 = u.pn * BM + wc * 32 + 8 * fq;
#pragma unroll
        for (int ai = 0; ai < 2; ++ai)
#pragma unroll
            for (int m = 0; m < 4; ++m) { const int row = row0 + ai * HALF + m * 16; float s = 0.f;
#pragma unroll
                for (int bj = 0; bj < 2; ++bj) { const size_t off = (size_t)row * 4096 + col0 + bj * HALF;
                    const f32x4 v0 = acc[ai][bj][m][0] + *(const f32x4*)(resid + off), v1 = acc[ai][bj][m][1] + *(const f32x4*)(resid + off + 4);
                    *(f32x4*)(outf + off) = v0; *(f32x4*)(outf + off + 4) = v1; *(u32x4*)(outb + off) = pack8(v0, v1);
                    s += ((v0[0] * v0[0] + v0[1] * v0[1]) + (v0[2] * v0[2] + v0[3] * v0[3])) + ((v1[0] * v1[0] + v1[1] * v1[1]) + (v1[2] * v1[2] + v1[3] * v1[3])); }
                s += __shfl_xor(s, 16); s += __shfl_xor(s, 32);
                if (fq == 0) ssq[(size_t)row * 64 + u.pn * 4 + wc] = s; }
    }
};
__device__ __forceinline__ float row_rstd(const float* ssq, int row, int fq) {
    const f32x4* p = (const f32x4*)(ssq + (size_t)row * 64 + fq * 16); float s = 0.f;
#pragma unroll
    for (int k = 0; k < 4; ++k) { const f32x4 v = p[k]; s += (v[0] + v[1]) + (v[2] + v[3]); }
    s += __shfl_xor(s, 16); s += __shfl_xor(s, 32);
    return __builtin_amdgcn_rsqf(s * (1.0f / 4096.0f) + 1e-6f);
}
struct EpiRowScale {
    static constexpr bool PERM = true, AFTER_DRAIN = false;
    bf16_t* O; int ldc; const float* ssq;
    __device__ __forceinline__ void operator()(const f32x4 (&acc)[2][2][4][2], const Unit& u, int wr, int wc, int fr, int fq) const {
        const int row0 = u.pm * BM + wr * 64 + fr, col0 = u.pn * BM + wc * 32 + 8 * fq;
#pragma unroll
        for (int ai = 0; ai < 2; ++ai)
#pragma unroll
            for (int m = 0; m < 4; ++m) { const int row = row0 + ai * HALF + m * 16; const float rs = row_rstd(ssq, row, fq);
#pragma unroll
                for (int bj = 0; bj < 2; ++bj) *(u32x4*)(O + (size_t)row * ldc + col0 + bj * HALF) = pack8(acc[ai][bj][m][0] * rs, acc[ai][bj][m][1] * rs); }
    }
};
struct EpiSoftmax {
    static constexpr bool PERM = true, AFTER_DRAIN = true;
    bf16_t* O; int ldc; const float* ssq; float scale_log2e;
    __device__ __forceinline__ void fused(f32x4 (&acc)[2][2][4][2], const Unit& u, int wr, int wc, int fr, int fq, PG8_LAS unsigned char* lds, int wid, int lane) const {
        typedef float f32x2v __attribute__((ext_vector_type(2)));
        PG8_LAS f32x2v* X = (PG8_LAS f32x2v*)lds;
        float mwv[2][4];
#pragma unroll
        for (int ai = 0; ai < 2; ++ai)
#pragma unroll
            for (int m = 0; m < 4; ++m) { const int rl = ai * HALF + wr * 64 + m * 16 + fr; const float rs = row_rstd(ssq, u.pm * BM + rl, fq) * scale_log2e;
                float mx = -3.0e38f;
#pragma unroll
                for (int bj = 0; bj < 2; ++bj)
#pragma unroll
                    for (int n = 0; n < 2; ++n) { acc[ai][bj][m][n] = acc[ai][bj][m][n] * rs; const f32x4 v = acc[ai][bj][m][n]; mx = fmaxf(mx, fmaxf(fmaxf(v[0], v[1]), fmaxf(v[2], v[3]))); }
                mx = fmaxf(mx, __shfl_xor(mx, 16)); mx = fmaxf(mx, __shfl_xor(mx, 32));
                float sm = 0.f;
#pragma unroll
                for (int bj = 0; bj < 2; ++bj)
#pragma unroll
                    for (int n = 0; n < 2; ++n) { f32x4 v = acc[ai][bj][m][n];
#pragma unroll
                        for (int e = 0; e < 4; ++e) { v[e] = __builtin_amdgcn_exp2f(v[e] - mx); sm += v[e]; } acc[ai][bj][m][n] = v; }
                sm += __shfl_xor(sm, 16); sm += __shfl_xor(sm, 32);
                mwv[ai][m] = mx;
                if (fq == 0) X[rl * 4 + wc] = (f32x2v){mx, sm}; }
        asm volatile("s_waitcnt lgkmcnt(0)" ::: "memory"); __builtin_amdgcn_s_barrier(); asm volatile("" ::: "memory");
        const int col0 = u.pn * BM + wc * 32 + 8 * fq;
#pragma unroll
        for (int ai = 0; ai < 2; ++ai)
#pragma unroll
            for (int m = 0; m < 4; ++m) { const int rl = ai * HALF + wr * 64 + m * 16 + fr;
                const f32x2v a = X[rl * 4 + 0], b = X[rl * 4 + 1], c = X[rl * 4 + 2], d = X[rl * 4 + 3];
                const float Mx = fmaxf(fmaxf(a.x, b.x), fmaxf(c.x, d.x));
                const float S = a.y * __builtin_amdgcn_exp2f(a.x - Mx) + b.y * __builtin_amdgcn_exp2f(b.x - Mx) + c.y * __builtin_amdgcn_exp2f(c.x - Mx) + d.y * __builtin_amdgcn_exp2f(d.x - Mx);
                const float f = __builtin_amdgcn_exp2f(mwv[ai][m] - Mx) / S;
#pragma unroll
                for (int bj = 0; bj < 2; ++bj) *(u32x4*)(O + (size_t)(u.pm * BM + rl) * ldc + col0 + bj * HALF) = pack8(acc[ai][bj][m][0] * f, acc[ai][bj][m][1] * f); }
    }
};

template <class Epi, class Sched, bool ALIGN_EPI = false, bool SP2 = false>
__device__ __forceinline__ void gemm_phase(PG8_LAS unsigned char* lds, const Gemm g, const Sched& S, const Epi& E) {
    const int tid = threadIdx.x, wid = __builtin_amdgcn_readfirstlane(tid >> 6), lane = tid & 63, wr = wid >> 2, wc = wid & 3, fr = lane & 15, fq = lane >> 4;
    const int K = g.K, nt = K / BK;
    unsigned voffA[2], voffB[2];
#pragma unroll
    for (int i = 0; i < 2; ++i) { int R, C; stage_rc(tid * 16 + i * 8192, R, C); const int Rb = Epi::PERM ? ((R & ~31) + perm32(R & 31)) : R;
        voffA[i] = (unsigned)(R * g.lda + C) * 2u; voffB[i] = (unsigned)(Rb * g.ldb + C) * 2u; }
    const size_t kstep = (size_t)(BK * 2);
    const size_t hstepA = (size_t)HALF * g.lda * 2, hstepB = (size_t)HALF * g.ldb * 2;

    const unsigned ldsw = (unsigned)wid * 1024u;
    const int aoff = lds_byte(wr * 64 + fr, fq * 8), boff = lds_byte(wc * 32 + fr, fq * 8);
#define PG8_SA(b, h) (((b) * 2 + (h)) * HTB)
#define PG8_SB(b, h) ((4 + (b) * 2 + (h)) * HTB)
#define PG8_STAGE(bufoff, gbase, voff) do { _Pragma("unroll") for (int _i = 0; _i < 2; ++_i) \
        __builtin_amdgcn_global_load_lds((const unsigned*)((const char*)(gbase) + (voff)[_i]), (PG8_LAS unsigned*)(lds + (bufoff) + ldsw + _i * 8192), 16, 0, 0); } while (0)
#define PG8_LDA(dst, b, h) do { _Pragma("unroll") for (int m = 0; m < 4; ++m) _Pragma("unroll") for (int k = 0; k < 2; ++k) dst[m][k] = *(const PG8_LAS bf16x8*)(lds + PG8_SA(b, h) + aoff + m * 2048 + k * 1024); } while (0)
#define PG8_LDB(dst, b, h) do { _Pragma("unroll") for (int n = 0; n < 2; ++n) _Pragma("unroll") for (int k = 0; k < 2; ++k) dst[n][k] = *(const PG8_LAS bf16x8*)(lds + PG8_SB(b, h) + boff + n * 2048 + k * 1024); } while (0)
#define PG8_MMA(ai, bj, At, Bt) do { __builtin_amdgcn_s_setprio(1); _Pragma("unroll") for (int m = 0; m < 4; ++m) _Pragma("unroll") for (int n = 0; n < 2; ++n) _Pragma("unroll") for (int k = 0; k < 2; ++k) \
        acc[ai][bj][m][n] = __builtin_amdgcn_mfma_f32_16x16x32_bf16(Bt[n][k], At[m][k], acc[ai][bj][m][n], 0, 0, 0); __builtin_amdgcn_s_setprio(0); } while (0)
#define PG8_WAIT_V(n) asm volatile("s_waitcnt vmcnt(" #n ")" ::: "memory")
#define PG8_WAIT_L(n) asm volatile("s_waitcnt lgkmcnt(" #n ")" ::: "memory")
#define PG8_BAR __builtin_amdgcn_s_barrier()
#define PG8_SCHED __builtin_amdgcn_sched_barrier(0)
    Unit cur, nxt; int ui = 0;
    if (!S.next(0, cur)) return;
    f32x4 acc[2][2][4][2];
#pragma unroll
    for (int a = 0; a < 2; ++a)
#pragma unroll
        for (int b = 0; b < 2; ++b)
#pragma unroll
            for (int m = 0; m < 4; ++m)
#pragma unroll
                for (int n = 0; n < 2; ++n) acc[a][b][m][n] = (f32x4){0.f, 0.f, 0.f, 0.f};
    bf16x8 At[4][2], B0[2][2], B1[2][2];
    const char* cA = g.a_ptr(cur); const char* cB = g.b_ptr(cur);
    S.a_ready(cur);
    if constexpr (SP2) {
        PG8_STAGE(PG8_SB(0, 0), cB, voffB); PG8_STAGE(PG8_SB(0, 1), cB + hstepB, voffB); PG8_STAGE(PG8_SA(0, 0), cA, voffA); PG8_STAGE(PG8_SA(0, 1), cA + hstepA, voffA);
        if (wr == 1) PG8_BAR;
        PG8_WAIT_V(2); PG8_BAR;
        PG8_STAGE(PG8_SB(1, 0), cB + kstep, voffB); PG8_STAGE(PG8_SA(1, 0), cA + kstep, voffA); PG8_STAGE(PG8_SB(1, 1), cB + hstepB + kstep, voffB);
        PG8_WAIT_V(6); PG8_BAR;
    } else {
        PG8_STAGE(PG8_SB(0, 0), cB, voffB); PG8_STAGE(PG8_SA(0, 0), cA, voffA); PG8_STAGE(PG8_SB(0, 1), cB + hstepB, voffB); PG8_STAGE(PG8_SA(0, 1), cA + hstepA, voffA);
        if (wr == 1) PG8_BAR;
        PG8_WAIT_V(4); PG8_BAR;
        PG8_STAGE(PG8_SB(1, 0), cB + kstep, voffB); PG8_STAGE(PG8_SA(1, 0), cA + kstep, voffA); PG8_STAGE(PG8_SB(1, 1), cB + hstepB + kstep, voffB);
        PG8_WAIT_V(6); PG8_BAR;
    }
    for (;;) {
        const bool has_next = S.next(ui + 1, nxt);
        const char* nA = has_next ? g.a_ptr(nxt) : cA; const char* nB = has_next ? g.b_ptr(nxt) : cB;
        for (int t = 0; t < nt; t += 2) {
            const bool last = (t == nt - 2);
            const char* a1 = cA + (size_t)(t + 1) * kstep;
            const char* a2 = last ? nA : cA + (size_t)(t + 2) * kstep; const char* b2 = last ? nB : cB + (size_t)(t + 2) * kstep;
            const char* a3 = a2 + kstep; const char* b3 = b2 + kstep;
            if (last && has_next) S.a_ready(nxt);
            if constexpr (SP2) {
            PG8_LDB(B0, 0, 0); PG8_LDB(B1, 0, 1); PG8_SCHED; PG8_LDA(At, 0, 0); PG8_STAGE(PG8_SA(1, 1), a1 + hstepA, voffA);
            PG8_WAIT_V(8); PG8_WAIT_L(0); PG8_BAR; PG8_MMA(0, 0, At, B0); PG8_MMA(0, 1, At, B1); PG8_BAR; PG8_SCHED;
            PG8_LDA(At, 0, 1); PG8_STAGE(PG8_SB(0, 0), b2, voffB); PG8_STAGE(PG8_SB(0, 1), b2 + hstepB, voffB); PG8_STAGE(PG8_SA(0, 0), a2, voffA);
            PG8_WAIT_V(8); PG8_WAIT_L(0); PG8_BAR; PG8_MMA(1, 0, At, B0); PG8_MMA(1, 1, At, B1); PG8_BAR; PG8_SCHED;
            PG8_LDB(B0, 1, 0); PG8_LDB(B1, 1, 1); PG8_SCHED; PG8_LDA(At, 1, 0); PG8_STAGE(PG8_SA(0, 1), a2 + hstepA, voffA);
            PG8_WAIT_V(8); PG8_WAIT_L(0); PG8_BAR; PG8_MMA(0, 0, At, B0); PG8_MMA(0, 1, At, B1); PG8_BAR; PG8_SCHED;
            PG8_LDA(At, 1, 1); PG8_STAGE(PG8_SB(1, 0), b3, voffB); PG8_STAGE(PG8_SB(1, 1), b3 + hstepB, voffB); PG8_STAGE(PG8_SA(1, 0), a3, voffA);
            PG8_WAIT_V(8); PG8_WAIT_L(0); PG8_BAR; PG8_MMA(1, 0, At, B0); PG8_MMA(1, 1, At, B1); PG8_BAR; PG8_SCHED;
            } else {
            PG8_LDB(B0, 0, 0); PG8_SCHED; PG8_LDA(At, 0, 0); PG8_STAGE(PG8_SA(1, 1), a1 + hstepA, voffA);
            PG8_WAIT_L(8); PG8_BAR; PG8_WAIT_L(0); PG8_MMA(0, 0, At, B0); PG8_BAR; PG8_SCHED;
            PG8_LDB(B1, 0, 1); PG8_STAGE(PG8_SB(0, 0), b2, voffB);
            PG8_BAR; PG8_WAIT_L(0); PG8_MMA(0, 1, At, B1); PG8_BAR;
            PG8_LDA(At, 0, 1); PG8_STAGE(PG8_SA(0, 0), a2, voffA);
            PG8_BAR; PG8_WAIT_L(0); PG8_MMA(1, 0, At, B0); PG8_BAR; PG8_SCHED;
            PG8_STAGE(PG8_SB(0, 1), b2 + hstepB, voffB);
            PG8_WAIT_V(6); PG8_BAR; PG8_MMA(1, 1, At, B1); PG8_BAR;
            PG8_LDB(B0, 1, 0); PG8_SCHED; PG8_LDA(At, 1, 0); PG8_STAGE(PG8_SA(0, 1), a2 + hstepA, voffA);
            PG8_WAIT_L(8); PG8_BAR; PG8_WAIT_L(0); PG8_MMA(0, 0, At, B0); PG8_BAR; PG8_SCHED;
            PG8_LDB(B1, 1, 1); PG8_STAGE(PG8_SB(1, 0), b3, voffB);
            PG8_BAR; PG8_WAIT_L(0); PG8_MMA(0, 1, At, B1); PG8_BAR;
            PG8_LDA(At, 1, 1); PG8_STAGE(PG8_SA(1, 0), a3, voffA);
            PG8_BAR; PG8_WAIT_L(0); PG8_MMA(1, 0, At, B0); PG8_BAR; PG8_SCHED;
            PG8_STAGE(PG8_SB(1, 1), b3 + hstepB, voffB);
            PG8_WAIT_V(6); PG8_BAR; PG8_MMA(1, 1, At, B1); PG8_BAR;
            }
        }
        if constexpr (ALIGN_EPI) { if (wr == 0) PG8_BAR; }
        if constexpr (!Epi::AFTER_DRAIN) { E(acc, cur, wr, wc, fr, fq); S.done(cur); }
        if (!has_next) break;
#pragma unroll
        for (int a = 0; a < 2; ++a)
#pragma unroll
            for (int b = 0; b < 2; ++b)
#pragma unroll
                for (int m = 0; m < 4; ++m)
#pragma unroll
                    for (int n = 0; n < 2; ++n) acc[a][b][m][n] = (f32x4){0.f, 0.f, 0.f, 0.f};
        cur = nxt; cA = nA; cB = nB; ++ui;
        if constexpr (ALIGN_EPI) { if (wr == 1) PG8_BAR; }
    }
    PG8_WAIT_V(0);
    if constexpr (!ALIGN_EPI) { if (wr == 0) PG8_BAR; }
    PG8_BAR;
    if constexpr (Epi::AFTER_DRAIN) { E.fused(acc, cur, wr, wc, fr, fq, lds, wid, lane); S.done(cur); }
#undef PG8_SA
#undef PG8_SB
#undef PG8_STAGE
#undef PG8_LDA
#undef PG8_LDB
#undef PG8_MMA
#undef PG8_WAIT_V
#undef PG8_WAIT_L
#undef PG8_BAR
#undef PG8_SCHED
}
}
#define GAS __attribute__((address_space(1)))
#define LAS __attribute__((address_space(3)))
typedef unsigned short bf16;
typedef unsigned v4u __attribute__((ext_vector_type(4)));
typedef float f32x4 __attribute__((ext_vector_type(4)));
typedef short bf16x8 __attribute__((ext_vector_type(8)));
typedef GAS unsigned gu32;
typedef GAS unsigned long long gu64;
#define RLX_AGENT __ATOMIC_RELAXED, __HIP_MEMORY_SCOPE_AGENT
#define LDS_WAIT() asm volatile("s_waitcnt lgkmcnt(0)" ::: "memory")
#define VM_WAIT() asm volatile("s_waitcnt vmcnt(0)" ::: "memory")
__device__ __forceinline__ unsigned long long rt() { return __builtin_amdgcn_s_memrealtime(); }
__device__ __forceinline__ unsigned f2bf(float f) { unsigned u = __builtin_bit_cast(unsigned, f); return (u + 0x7fffu + ((u >> 16) & 1u)) >> 16; }
__device__ __forceinline__ unsigned pk2(float lo, float hi) { return f2bf(lo) | (f2bf(hi) << 16); }

#define XB_TMO      128
#define XB_XCNT(j)  (256  + 64 * (j))
#define XB_XSUB(j)  (1280 + 64 * (j))
#define XB_XGEN(j)  (2304 + 64 * (j))
#define XB_TOP      3328
#define XB_TOPGEN   3392
#define XCD_BAR_WORDS 3456
#define XB_SPIN_CAP (1u << 18)

__device__ __forceinline__ unsigned xb_ld(unsigned* p)              { return __hip_atomic_load(p, __ATOMIC_RELAXED, __HIP_MEMORY_SCOPE_AGENT); }
__device__ __forceinline__ unsigned xb_add(unsigned* p, unsigned v) { return __hip_atomic_fetch_add(p, v, __ATOMIC_RELAXED, __HIP_MEMORY_SCOPE_AGENT); }
__device__ __forceinline__ unsigned xb_xcc_id() { return (unsigned)__builtin_amdgcn_s_getreg((3 << 11) | 20) & 0xFu; }
#define XB_SPIN(cond, bar) do { unsigned _sp = 0; while (cond) { __builtin_amdgcn_s_sleep(1); \
    if ((++_sp & 255u) == 0u) { if (xb_ld(&(bar)[XB_TMO])) break; if (_sp > XB_SPIN_CAP) { atomicAdd(&(bar)[XB_TMO], 1u); break; } } } } while (0)

struct XcdBarrier {
    unsigned* bar; unsigned x;
    volatile LAS unsigned* st;
};

__device__ __forceinline__ XcdBarrier xcd_barrier_post(unsigned* bar, volatile LAS unsigned* st) {
    XcdBarrier b; b.bar = bar; b.x = xb_xcc_id(); b.st = st;
    if (threadIdx.x == 0) (void)xb_add(&bar[XB_XCNT(b.x)], 1u);
    return b;
}
__device__ __forceinline__ void xcd_barrier_complete(unsigned* bar, unsigned x, unsigned& nloc, unsigned& nx) {
    const unsigned G = gridDim.x * gridDim.y * gridDim.z;
    unsigned sum, cnt, mine, sp = 0u;
    for (;;) {
        sum = 0u; cnt = 0u; mine = 0u;
#pragma unroll
        for (unsigned j = 0; j < 16; ++j) { const unsigned c = xb_ld(&bar[XB_XCNT(j)]); sum += c; cnt += (c > 0u) ? 1u : 0u; mine = (j == x) ? c : mine; }
        if (sum == G) break;
        __builtin_amdgcn_s_sleep(1);
        if ((++sp & 255u) == 0u) { if (xb_ld(&bar[XB_TMO])) break; if (sp > XB_SPIN_CAP) { atomicAdd(&bar[XB_TMO], 1u); break; } }
    }
    nloc = mine > 0u ? mine : 1u; nx = cnt > 0u ? cnt : 1u;
}

__device__ __forceinline__ void xcd_barrier(const XcdBarrier& b) {
    asm volatile("s_waitcnt vmcnt(0)" ::: "memory");
    __syncthreads();
    if (threadIdx.x == 0) {
        unsigned* bar = b.bar;
        __builtin_amdgcn_s_waitcnt(0);
        unsigned nloc = b.st[0], nx = b.st[1];
        if (nloc == 0u) { xcd_barrier_complete(bar, b.x, nloc, nx); b.st[0] = nloc; b.st[1] = nx; }
        const unsigned old = xb_add(&bar[XB_XSUB(b.x)], 1u);
        const unsigned gen = old / nloc;
        if (old + 1u == (gen + 1u) * nloc) {
            __builtin_amdgcn_fence(__ATOMIC_RELEASE, "agent");
            asm volatile("s_waitcnt vmcnt(0)" ::: "memory");
            const unsigned og = xb_add(&bar[XB_TOP], 1u);
            const unsigned tg = og / nx;
            if (og + 1u == (tg + 1u) * nx) xb_add(&bar[XB_TOPGEN], 1u);
            else XB_SPIN(xb_ld(&bar[XB_TOPGEN]) == tg, bar);
            __builtin_amdgcn_fence(__ATOMIC_ACQUIRE, "agent");
            xb_add(&bar[XB_XGEN(b.x)], 1u);
            asm volatile("s_waitcnt vmcnt(0)" ::: "memory");
        } else {
            XB_SPIN(xb_ld(&bar[XB_XGEN(b.x)]) == gen, bar);
            __builtin_amdgcn_fence(__ATOMIC_ACQUIRE, "agent");
            asm volatile("s_waitcnt vmcnt(0)" ::: "memory");
        }
    }
    __syncthreads();
}

constexpr int NWAVES = 8, NTHR = 512;
constexpr int D = 4096, BATCH = 4, SEQ = 4096, M = BATCH * SEQ, MEML = 256, MROWS = BATCH * MEML, NIN = 14336;
constexpr int COL_DQ = 0, COL_DK = 2048, COL_DV = 4096, COL_HQ = 6144, COL_HF = 8192, COL_HI = 10240, COL_HG = 12288;
constexpr int NEXP = 16384, PEER_H = 8, PEER_K = 16, NSEL = PEER_H * PEER_K;
constexpr float EPS = 1e-6f, LOG2E = 1.4426950408889634f;
constexpr size_t MiB = 1u << 20;
constexpr size_t WS_CTL = 0, CTL_ZERO_BYTES = 1 * MiB;
constexpr size_t WS_SUBK = 1 * MiB;
constexpr size_t WS_XN = 2 * MiB;
constexpr size_t WS_WIN = 130 * MiB;
constexpr size_t WS_WOUT = 242 * MiB, WS_WCQ = 274 * MiB, WS_WCKV = 306 * MiB, WS_WCO = 370 * MiB, WS_WPQ = 402 * MiB;
constexpr size_t WS_PROJ = 418 * MiB;
constexpr size_t WS_H1F = WS_PROJ, WS_H1B = WS_PROJ + 256 * MiB, WS_PB = WS_PROJ + 384 * MiB;
constexpr size_t WS_MEMN = 866 * MiB, WS_KV = 874 * MiB, WS_WKP = 890 * MiB, WS_VP = 922 * MiB;
constexpr size_t WS_EIDX = 954 * MiB, WS_GATE = 962 * MiB, WS_HSSQ = 970 * MiB, WS_SSQ1 = 974 * MiB, WS_SSQ2 = 978 * MiB;
constexpr size_t WS_ATT = 982 * MiB;
constexpr size_t WS_DOWN = 1014 * MiB, WS_UP = 1142 * MiB, WS_END = 1270 * MiB;
constexpr int CW_BAR = 4096;
constexpr int RING_BYTES = 131072, LDSCTL_OFF = RING_BYTES, MISC_OFF = LDSCTL_OFF + 320, LDS_BYTES = 147456;

struct Frame {
    LAS unsigned char* lds;
    volatile LAS unsigned* MISC;
    gu32* ctl;
    int tid, lane, wave, vcu, G;
    unsigned char* ws;
    const float* in[23];
    float* out;
};
__device__ __forceinline__ float bf2f(unsigned short b) { return __uint_as_float((unsigned)b << 16); }
__device__ __forceinline__ float bflo(unsigned w) { return __uint_as_float(w << 16); }
__device__ __forceinline__ float bfhi(unsigned w) { return __uint_as_float(w & 0xffff0000u); }
__device__ __forceinline__ float wave_sum(float v) {
#pragma unroll
    for (int o = 1; o < 64; o <<= 1) v += __shfl_xor(v, o);
    return v;
}
__device__ __forceinline__ void p0_transpose_item(const float* W, int K, int N, bf16* WT, const float* ks, LAS float* scr, int item, int lane) {
    const int nblk = N / 32, kb = item / nblk, nb = item % nblk, k0 = 64 * kb, n0 = 32 * nb;
#pragma unroll 8
    for (int i = 0; i < 32; ++i) { const int kk = 2 * i + (lane >> 5); float v = W[(size_t)(k0 + kk) * N + n0 + (lane & 31)]; if (ks) v *= ks[k0 + kk]; scr[kk * 33 + (lane & 31)] = v; }
    LDS_WAIT(); asm volatile("" ::: "memory");
    const int c = lane & 7;
#pragma unroll
    for (int j = 0; j < 4; ++j) { const int n = (lane >> 3) + 8 * j; const LAS float* s = scr + (8 * c) * 33 + n;
        v4u o; o.x = pk2(s[0 * 33], s[1 * 33]); o.y = pk2(s[2 * 33], s[3 * 33]); o.z = pk2(s[4 * 33], s[5 * 33]); o.w = pk2(s[6 * 33], s[7 * 33]);
        *(GAS v4u*)(WT + (size_t)(n0 + n) * K + k0 + 8 * c) = o; }
    LDS_WAIT(); asm volatile("" ::: "memory");
}
__device__ __forceinline__ void row4096_to_bf16(const float* src, bf16* dst, const float* g, float sc, int mode, int lane) {
    const GAS f32x4* xr = (const GAS f32x4*)src + lane;
    f32x4 v[16]; float s = 0.f;
#pragma unroll
    for (int j = 0; j < 16; ++j) { v[j] = xr[64 * j]; s += (v[j].x * v[j].x + v[j].y * v[j].y) + (v[j].z * v[j].z + v[j].w * v[j].w); }
    float r = sc;
    if (mode == 1) r = __builtin_amdgcn_rsqf(wave_sum(s) * (1.f / 4096.f) + EPS);
    GAS unsigned long long* o8 = (GAS unsigned long long*)dst + lane;
#pragma unroll
    for (int j = 0; j < 16; ++j) { f32x4 w = v[j] * r; if (mode == 1) w = w * ((const GAS f32x4*)g)[64 * j + lane];
        o8[64 * j] = (unsigned long long)pk2(w.x, w.y) | ((unsigned long long)pk2(w.z, w.w) << 32); }
}
__device__ __forceinline__ void p0_prologue(Frame& F) {
    LAS float* scr = (LAS float*)(F.lds + F.wave * 16384);
    const int gw = F.vcu * NWAVES + F.wave, NGW = F.G * NWAVES;
    bf16* WS = (bf16*)F.ws;
    constexpr int I_IN = 64 * (NIN / 32), I_OUT = 64 * 128, I_CKV = 64 * 256, I_CO = 64 * 128, I_PQ = 64 * 64;
    constexpr int NITEMS = I_IN + I_OUT + I_CKV + I_CO + I_PQ;
    for (int it = gw; it < NITEMS; it += NGW) {
        int r = it;
        if (r < I_IN) { p0_transpose_item(F.in[3], D, NIN, (bf16*)(F.ws + WS_WIN), nullptr, scr, r, F.lane); continue; } r -= I_IN;
        if (r < I_OUT) { p0_transpose_item(F.in[11], D, D, (bf16*)(F.ws + WS_WOUT), nullptr, scr, r, F.lane); continue; } r -= I_OUT;
        if (r < I_CKV) { p0_transpose_item(F.in[15], D, 2 * D, (bf16*)(F.ws + WS_WCKV), nullptr, scr, r, F.lane); continue; } r -= I_CKV;
        if (r < I_CO) { p0_transpose_item(F.in[16], D, D, (bf16*)(F.ws + WS_WCO), nullptr, scr, r, F.lane); continue; } r -= I_CO;
        p0_transpose_item(F.in[18], D, 2048, (bf16*)(F.ws + WS_WPQ), F.in[17], scr, r, F.lane);
    }
    (void)WS;
    constexpr int R_X = M, R_MEM = MROWS, R_CQ = D, R_DOWN = NEXP, R_UP = NEXP, R_SK = 64;
    constexpr int NROWS = R_X + R_MEM + R_CQ + R_DOWN + R_UP + R_SK;
    for (int it = gw; it < NROWS; it += NGW) {
        int r = it;
        if (r < R_X) { row4096_to_bf16(F.in[0] + (size_t)r * D, (bf16*)(F.ws + WS_XN) + (size_t)r * D, F.in[2], 1.f, 1, F.lane); continue; } r -= R_X;
        if (r < R_MEM) { row4096_to_bf16(F.in[1] + (size_t)r * D, (bf16*)(F.ws + WS_MEMN) + (size_t)r * D, F.in[13], 1.f, 1, F.lane); continue; } r -= R_MEM;
        if (r < R_CQ) { row4096_to_bf16(F.in[14] + (size_t)r * D, (bf16*)(F.ws + WS_WCQ) + (size_t)r * D, nullptr, F.in[12][r], 0, F.lane); continue; } r -= R_CQ;
        if (r < R_DOWN) { row4096_to_bf16(F.in[20] + (size_t)r * D, (bf16*)(F.ws + WS_DOWN) + (size_t)r * D, nullptr, 1.f, 0, F.lane); continue; } r -= R_DOWN;
        if (r < R_UP) { row4096_to_bf16(F.in[21] + (size_t)r * D, (bf16*)(F.ws + WS_UP) + (size_t)r * D, nullptr, 1.f, 0, F.lane); continue; } r -= R_UP;
        row4096_to_bf16(F.in[19] + (size_t)r * D, (bf16*)(F.ws + WS_SUBK) + (size_t)r * D, nullptr, 1.f, 0, F.lane);
    }
}

#define DPP_MUL(d, a, b, J) asm volatile("v_mul_f32_dpp %0, %1, %2 row_newbcast:" #J " row_mask:0xf bank_mask:0xf" : "=v"(d) : "v"(a), "v"(b))
#define DPP_FMAC(d, a, b, J) asm volatile("v_fmac_f32_dpp %0, %1, %2 row_newbcast:" #J " row_mask:0xf bank_mask:0xf" : "+v"(d) : "v"(a), "v"(b))
constexpr int HG_T = 32;
__device__ __forceinline__ void hgrn_unit(Frame& F, int b, int h, int vq) {
    const int tid = F.tid, lane = F.lane, w = F.wave;
    LAS float* Ql = (LAS float*)F.lds; LAS float* Fl = Ql + HG_T * 128; LAS float* Kl = Fl + HG_T * 128; LAS float* Il = Kl + HG_T * 128; LAS float* Pl = Il + HG_T * 32;
    const bf16* Pb = (const bf16*)(F.ws + WS_PROJ) + (size_t)b * SEQ * NIN;
    bf16* MIX = (bf16*)(F.ws + WS_XN); float* HSSQ = (float*)(F.ws + WS_HSSQ);
    const int lrow = tid >> 4, lseg = tid & 15;
    const bf16* qsrc = Pb + (size_t)lrow * NIN + COL_HQ + h * 128 + lseg * 8;
    const bf16* ksrc = Pb + (size_t)lrow * NIN + COL_HF + h * 128 + lseg * 8;
    const int irow = (tid >> 2) & 31, iseg = tid & 3;
    const bf16* isrc = Pb + (size_t)irow * NIN + COL_HI + h * 128 + vq * 32 + iseg * 8;
    float s[8];
#pragma unroll
    for (int j = 0; j < 8; ++j) s[j] = 0.f;
    v4u rq = *(const GAS v4u*)qsrc, rk = *(const GAS v4u*)ksrc, ri = (v4u){0u, 0u, 0u, 0u};
    if (tid < 128) ri = *(const GAS v4u*)isrc;
    const int idxq = 16 * w + 8 * (lane >> 5) + (lane & 7), idxi = lane & 31;
    const int pslot = (w * 2 + (lane >> 5)) * HG_T * 32 + (lane & 31);
    constexpr int NCH = SEQ / HG_T;
    __syncthreads();
    for (int c = 0; c < NCH; ++c) {
        {
            f32x4 q0, q1, k0, k1, f0, f1;
            q0 = (f32x4){bflo(rq.x), bfhi(rq.x), bflo(rq.y), bfhi(rq.y)}; q1 = (f32x4){bflo(rq.z), bfhi(rq.z), bflo(rq.w), bfhi(rq.w)};
            k0 = (f32x4){bflo(rk.x), bfhi(rk.x), bflo(rk.y), bfhi(rk.y)}; k1 = (f32x4){bflo(rk.z), bfhi(rk.z), bflo(rk.w), bfhi(rk.w)};
            f0 = 1.0f - k0; f1 = 1.0f - k1;
            const int o = lrow * 128 + lseg * 8;
            *(LAS f32x4*)(Ql + o) = q0; *(LAS f32x4*)(Ql + o + 4) = q1; *(LAS f32x4*)(Kl + o) = k0; *(LAS f32x4*)(Kl + o + 4) = k1; *(LAS f32x4*)(Fl + o) = f0; *(LAS f32x4*)(Fl + o + 4) = f1;
            if (tid < 128) { const int oi = irow * 32 + iseg * 8;
                *(LAS f32x4*)(Il + oi) = (f32x4){bflo(ri.x), bfhi(ri.x), bflo(ri.y), bfhi(ri.y)}; *(LAS f32x4*)(Il + oi + 4) = (f32x4){bflo(ri.z), bfhi(ri.z), bflo(ri.w), bfhi(ri.w)}; }
        }
        if (c + 1 < NCH) { const size_t adv = (size_t)(c + 1) * HG_T * NIN; rq = *(const GAS v4u*)(qsrc + adv); rk = *(const GAS v4u*)(ksrc + adv); if (tid < 128) ri = *(const GAS v4u*)(isrc + adv); }
        __syncthreads();
        float qv = Ql[idxq], fv = Fl[idxq], kv = Kl[idxq], iv = Il[idxi];
#pragma unroll 4
        for (int t = 0; t < HG_T; ++t) {
            const int tn = (t + 1 < HG_T) ? t + 1 : t;
            const float qn = Ql[idxq + tn * 128], fn = Fl[idxq + tn * 128], kn = Kl[idxq + tn * 128], in_ = Il[idxi + tn * 32];
            float t0, t1, t2, t3, t4, t5, t6, t7, a0 = 0.f, a1 = 0.f;
            asm volatile("s_nop 1\n\tv_mul_f32_dpp %0, %1, %2 row_newbcast:0 row_mask:0xf bank_mask:0xf" : "=v"(t0) : "v"(fv), "v"(s[0]), "v"(qv), "v"(kv));
            DPP_MUL(t1, fv, s[1], 1); DPP_MUL(t2, fv, s[2], 2); DPP_MUL(t3, fv, s[3], 3); DPP_MUL(t4, fv, s[4], 4); DPP_MUL(t5, fv, s[5], 5); DPP_MUL(t6, fv, s[6], 6); DPP_MUL(t7, fv, s[7], 7);
            DPP_FMAC(t0, kv, iv, 0); DPP_FMAC(t1, kv, iv, 1); DPP_FMAC(t2, kv, iv, 2); DPP_FMAC(t3, kv, iv, 3); DPP_FMAC(t4, kv, iv, 4); DPP_FMAC(t5, kv, iv, 5); DPP_FMAC(t6, kv, iv, 6); DPP_FMAC(t7, kv, iv, 7);
            DPP_FMAC(a0, qv, t0, 0); DPP_FMAC(a1, qv, t1, 1); DPP_FMAC(a0, qv, t2, 2); DPP_FMAC(a1, qv, t3, 3); DPP_FMAC(a0, qv, t4, 4); DPP_FMAC(a1, qv, t5, 5); DPP_FMAC(a0, qv, t6, 6); DPP_FMAC(a1, qv, t7, 7);
            s[0] = t0; s[1] = t1; s[2] = t2; s[3] = t3; s[4] = t4; s[5] = t5; s[6] = t6; s[7] = t7;
            Pl[pslot + t * 32] = a0 + a1;
            qv = qn; fv = fn; kv = kn; iv = in_;
        }
        __syncthreads();
        {
            const int t = tid >> 4, vp = tid & 15; typedef float f32x2v __attribute__((ext_vector_type(2)));
            f32x2v o = {0.f, 0.f};
#pragma unroll
            for (int p = 0; p < 16; ++p) { const f32x2v x = *(LAS f32x2v*)(Pl + (p * HG_T + t) * 32 + 2 * vp); o += x; }
            const size_t grow = (size_t)b * SEQ + (size_t)c * HG_T + t;
            *(GAS unsigned*)(MIX + grow * D + 2048 + h * 128 + vq * 32 + 2 * vp) = pk2(o.x, o.y);
            float ss = o.x * o.x + o.y * o.y;
            ss += __shfl_xor(ss, 1); ss += __shfl_xor(ss, 2); ss += __shfl_xor(ss, 4); ss += __shfl_xor(ss, 8);
            if (vp == 0) HSSQ[grow * 64 + h * 4 + vq] = ss;
        }
    }
    __syncthreads();
}
__device__ __forceinline__ void hgrn_fixup(Frame& F) {
    bf16* MIX = (bf16*)(F.ws + WS_XN); const float* HSSQ = (const float*)(F.ws + WS_HSSQ); const bf16* PROJ = (const bf16*)(F.ws + WS_PROJ); const float* ng = F.in[10];
    const size_t total = (size_t)M * 256, stride = (size_t)F.G * NTHR;
    for (size_t idx = (size_t)F.vcu * NTHR + F.tid; idx < total; idx += stride) {
        const size_t row = idx >> 8; const int cg = (int)(idx & 255), hh = cg >> 4, col = cg * 8;
        const f32x4 q = *(const GAS f32x4*)(HSSQ + row * 64 + hh * 4);
        const float rstd = __builtin_amdgcn_rsqf(((q.x + q.y) + (q.z + q.w)) * (1.f / 128.f) + EPS);
        const v4u o = *(const GAS v4u*)(MIX + row * D + 2048 + col), g = *(const GAS v4u*)(PROJ + row * NIN + COL_HG + col);
        const f32x4 n0 = *(const GAS f32x4*)(ng + (col & 127)), n1 = *(const GAS f32x4*)(ng + (col & 127) + 4);
        v4u r;
        r.x = pk2(bflo(o.x) * rstd * n0.x * bflo(g.x), bfhi(o.x) * rstd * n0.y * bfhi(g.x)); r.y = pk2(bflo(o.y) * rstd * n0.z * bflo(g.y), bfhi(o.y) * rstd * n0.w * bfhi(g.y));
        r.z = pk2(bflo(o.z) * rstd * n1.x * bflo(g.z), bfhi(o.z) * rstd * n1.y * bfhi(g.z)); r.w = pk2(bflo(o.w) * rstd * n1.z * bflo(g.w), bfhi(o.w) * rstd * n1.w * bfhi(g.w));
        *(GAS v4u*)(MIX + row * D + 2048 + col) = r;
    }
}
typedef float f32x16 __attribute__((ext_vector_type(16)));
typedef short v4i16_t __attribute__((ext_vector_type(4)));
#define MFMA32(a, b, c) __builtin_amdgcn_mfma_f32_32x32x16_bf16((a), (b), (c), 0, 0, 0)
__device__ __forceinline__ int crow(int i, int hh) { return (i & 3) + 8 * (i >> 2) + 4 * hh; }
__device__ __forceinline__ float xhalf_max(float m) { auto rr = __builtin_amdgcn_permlane32_swap(__float_as_uint(m), __float_as_uint(m), false, false); return fmaxf(__uint_as_float(rr[0]), __uint_as_float(rr[1])); }
__device__ __forceinline__ float xhalf_sum(float m) { auto rr = __builtin_amdgcn_permlane32_swap(__float_as_uint(m), __float_as_uint(m), false, false); return __uint_as_float(rr[0]) + __uint_as_float(rr[1]); }
constexpr int AT_KP = 144, AT_VP = 320, AT_KB = 64 * AT_KP, AT_VB = 64 * AT_VP, AT_VOFF = 2 * AT_KB, AT_AOFF = AT_VOFF + 2 * AT_VB;
__device__ __forceinline__ void attn_unit(Frame& F, int b, int h, int qb, float lam) {
    const int tid = F.tid, lane = F.lane, w = F.wave, r = lane & 31, hh = lane >> 5;
    const bf16* Pb = (const bf16*)(F.ws + WS_PROJ) + (size_t)b * SEQ * NIN;
    LAS unsigned char* Kl = F.lds; LAS unsigned char* Vl = F.lds + AT_VOFF; LAS float* Al = (LAS float*)(F.lds + AT_AOFF) + w * 32;
    const int q0 = qb * 256 + w * 32, qpos = q0 + r;
    const float cs = exp2f(-0.5f * (float)(h + 1)) * LOG2E;
    const int NT = 4 * (qb + 1);
    float* scr = (float*)(F.ws + WS_ATT) + (size_t)blockIdx.x * 32768;
    const int i16 = lane & 15, q4 = i16 >> 2, p4 = i16 & 3, g16 = (lane >> 4) & 1;
    const int vrd = (4 * hh + q4) * AT_VP + 32 * g16 + 8 * p4;
    f32x16 O[4];
    for (int c = 0; c < 2; ++c) {
        bf16x8 qf[4];
#pragma unroll
        for (int s = 0; s < 4; ++s) qf[s] = *(const GAS bf16x8*)(Pb + (size_t)qpos * NIN + COL_DQ + h * 128 + c * 64 + 16 * s + 8 * hh);
#pragma unroll
        for (int d = 0; d < 4; ++d)
#pragma unroll
            for (int i = 0; i < 16; ++i) O[d][i] = 0.f;
        float mrun = -1.0e30f, lrun = 0.f;
        const int krow = tid >> 3, kseg = tid & 7, vrow = tid >> 4, vseg = tid & 15;
        const bf16* ksrc = Pb + (size_t)krow * NIN + COL_DK + h * 128 + c * 64 + kseg * 8;
        const bf16* vsrc = Pb + (size_t)vrow * NIN + COL_DV + h * 128 + vseg * 8;
        const int kdst = krow * AT_KP + kseg * 16, vdst = vrow * AT_VP + vseg * 16;
        v4u rk = *(const GAS v4u*)ksrc, rv0 = *(const GAS v4u*)vsrc, rv1 = *(const GAS v4u*)(vsrc + (size_t)32 * NIN);
        __syncthreads();
        *(LAS v4u*)(Kl + kdst) = rk; *(LAS v4u*)(Vl + vdst) = rv0; *(LAS v4u*)(Vl + vdst + 32 * AT_VP) = rv1;
        __syncthreads();
        for (int t = 0; t < NT; ++t) {
            const int buf = t & 1;
            if (t + 1 < NT) { const size_t adv = (size_t)(t + 1) * 64 * NIN; rk = *(const GAS v4u*)(ksrc + adv); rv0 = *(const GAS v4u*)(vsrc + adv); rv1 = *(const GAS v4u*)(vsrc + adv + (size_t)32 * NIN); }
            if (64 * t <= q0 + 31) {
                f32x16 st[2];
#pragma unroll
                for (int nb = 0; nb < 2; ++nb) {
#pragma unroll
                    for (int i = 0; i < 16; ++i) st[nb][i] = 0.f;
#pragma unroll
                    for (int s = 0; s < 4; ++s) { const bf16x8 kf = *(const LAS bf16x8*)(Kl + buf * AT_KB + (32 * nb + r) * AT_KP + (16 * s + 8 * hh) * 2); st[nb] = MFMA32(kf, qf[s], st[nb]); }
                }
                const bool band = (64 * t + 63 > q0);
                float cs_ = cs; asm volatile("" : "+v"(cs_));
                const float basev = cs_ * (float)(64 * t - qpos + 4 * hh);
                const int thr = qpos - 64 * t - 4 * hh;
                float mx = -3.0e38f;
#pragma unroll
                for (int nb = 0; nb < 2; ++nb)
#pragma unroll
                    for (int i = 0; i < 16; ++i) { const int kc = 32 * nb + (i & 3) + 8 * (i >> 2); float v = st[nb][i] + (basev + cs_ * (float)kc);
                        if (band && (kc > thr)) v = -1.0e30f; st[nb][i] = v; mx = fmaxf(mx, v); }
                mx = xhalf_max(mx);
                const float mnew = fmaxf(mrun, mx), alpha = __builtin_amdgcn_exp2f(mrun - mnew); mrun = mnew;
                float rs = 0.f;
#pragma unroll
                for (int nb = 0; nb < 2; ++nb)
#pragma unroll
                    for (int i = 0; i < 16; ++i) { const float p = __builtin_amdgcn_exp2f(st[nb][i] - mnew); st[nb][i] = p; rs += p; }
                rs = xhalf_sum(rs); lrun = lrun * alpha + rs;
                if (hh == 0) Al[r] = alpha;
                f32x4 a4[4];
#pragma unroll
                for (int g = 0; g < 4; ++g) a4[g] = *(const LAS f32x4*)(Al + 8 * g + 4 * hh);
#pragma unroll
                for (int d = 0; d < 4; ++d)
#pragma unroll
                    for (int i = 0; i < 16; ++i) O[d][i] *= a4[i >> 2][i & 3];
#pragma unroll
                for (int nb = 0; nb < 2; ++nb)
#pragma unroll
                    for (int s2 = 0; s2 < 2; ++s2) {
                        v4u pw; pw.x = pg8::cvt_pk_bf16(st[nb][8 * s2 + 0], st[nb][8 * s2 + 1]); pw.y = pg8::cvt_pk_bf16(st[nb][8 * s2 + 2], st[nb][8 * s2 + 3]);
                        pw.z = pg8::cvt_pk_bf16(st[nb][8 * s2 + 4], st[nb][8 * s2 + 5]); pw.w = pg8::cvt_pk_bf16(st[nb][8 * s2 + 6], st[nb][8 * s2 + 7]);
                        const bf16x8 pf = __builtin_bit_cast(bf16x8, pw);
                        const LAS unsigned char* vb = Vl + buf * AT_VB + (32 * nb + 16 * s2) * AT_VP + vrd;
#pragma unroll
                        for (int d = 0; d < 4; ++d) {
                            const v4i16_t lo = __builtin_amdgcn_ds_read_tr16_b64_v4i16((LAS v4i16_t*)(vb + d * 64)), hi = __builtin_amdgcn_ds_read_tr16_b64_v4i16((LAS v4i16_t*)(vb + d * 64 + 8 * AT_VP));
                            const bf16x8 vf = __builtin_shufflevector(lo, hi, 0, 1, 2, 3, 4, 5, 6, 7);
                            O[d] = MFMA32(pf, vf, O[d]);
                        }
                        __builtin_amdgcn_sched_barrier(0);
                    }
            }
            if (t + 1 < NT) { const int nb_ = (buf ^ 1); *(LAS v4u*)(Kl + nb_ * AT_KB + kdst) = rk; *(LAS v4u*)(Vl + nb_ * AT_VB + vdst) = rv0; *(LAS v4u*)(Vl + nb_ * AT_VB + vdst + 32 * AT_VP) = rv1; }
            __syncthreads();
        }
        if (hh == 0) Al[r] = 1.0f / lrun;
        f32x4 a4[4];
#pragma unroll
        for (int g = 0; g < 4; ++g) a4[g] = *(const LAS f32x4*)(Al + 8 * g + 4 * hh);
        float* sp = scr + tid * 64; asm volatile("" : "+v"(sp));
        if (c == 0) {
#pragma unroll
            for (int d = 0; d < 4; ++d)
#pragma unroll
                for (int g = 0; g < 4; ++g) *(GAS f32x4*)(sp + d * 16 + 4 * g) = (f32x4){O[d][4 * g], O[d][4 * g + 1], O[d][4 * g + 2], O[d][4 * g + 3]} * a4[g];
        } else {
            asm volatile("s_waitcnt vmcnt(0)" ::: "memory");
#pragma unroll
            for (int d = 0; d < 4; ++d)
#pragma unroll
                for (int g = 0; g < 4; ++g) { const f32x4 o0 = *(const GAS f32x4*)(sp + d * 16 + 4 * g);
#pragma unroll
                    for (int j = 0; j < 4; ++j) O[d][4 * g + j] = o0[j] - lam * (O[d][4 * g + j] * a4[g][j]); }
        }
    }
    const float* sg = F.in[8]; bf16* MIX = (bf16*)(F.ws + WS_XN);
    float gcol[4];
#pragma unroll
    for (int d = 0; d < 4; ++d) gcol[d] = sg[d * 32 + r] * 0.8f;
    bf16* obase = MIX + ((size_t)b * SEQ + q0 + 4 * hh) * D + h * 128 + r; asm volatile("" : "+v"(obase));
#pragma unroll
    for (int i = 0; i < 16; ++i) {
        float p = (O[0][i] * O[0][i] + O[1][i] * O[1][i]) + (O[2][i] * O[2][i] + O[3][i] * O[3][i]);
        p += __shfl_xor(p, 1); p += __shfl_xor(p, 2); p += __shfl_xor(p, 4); p += __shfl_xor(p, 8); p += __shfl_xor(p, 16);
        const float rstd = __builtin_amdgcn_rsqf(p * (1.f / 128.f) + EPS);
        bf16* orow = obase + (size_t)((i & 3) + 8 * (i >> 2)) * D;
#pragma unroll
        for (int d = 0; d < 4; ++d) orow[d * 32] = (bf16)f2bf(O[d][i] * rstd * gcol[d]);
    }
}
#define DPPX(v, ctrl) __builtin_amdgcn_update_dpp(0, (v), (ctrl), 0xf, 0xf, false)
__device__ __forceinline__ int row16_max_i(int x) {
    x = max(x, DPPX(x, 0xB1)); x = max(x, DPPX(x, 0x4E)); x = max(x, DPPX(x, 0x141)); x = max(x, DPPX(x, 0x140)); return x; }
__device__ __forceinline__ float row16_sum_f(float x) {
    x += __int_as_float(DPPX(__float_as_int(x), 0xB1)); x += __int_as_float(DPPX(__float_as_int(x), 0x4E)); x += __int_as_float(DPPX(__float_as_int(x), 0x141)); x += __int_as_float(DPPX(__float_as_int(x), 0x140)); return x; }
__device__ __forceinline__ int f2sort(float f) { const int b = __float_as_int(f); return b ^ ((b >> 31) & 0x7fffffff); }
__device__ __forceinline__ float sort2f(int k) { return __int_as_float(k ^ ((k >> 31) & 0x7fffffff)); }
__device__ __forceinline__ void topk_phase(Frame& F) {
    const int tid = F.tid, lane = F.lane, w = F.wave, r = lane & 31, hh = lane >> 5, g16 = tid >> 4, l16 = tid & 15;
    LAS float* Sl = (LAS float*)F.lds;
    LAS float* SV = (LAS float*)(F.lds + 65536);
    LAS int* SI = (LAS int*)(F.lds + 65536 + 8192);
    const bf16* QP = (const bf16*)(F.ws + WS_WIN); const bf16* SUBK = (const bf16*)(F.ws + WS_SUBK);
    int* EIDX = (int*)(F.ws + WS_EIDX); float* GATE = (float*)(F.ws + WS_GATE);
    for (int it = F.vcu; it < (M / 64) * PEER_H; it += F.G) {
        const int head = it & 7, tile = it >> 3;
        {
            const int c = w >> 2, kb = w & 3;
            const bf16* Q = QP + (size_t)(tile * 64) * 2048 + head * 256 + c * 128;
            const bf16* SK = SUBK + ((size_t)(head * 2 + c) * 128 + 32 * kb) * 128;
            f32x16 acc[2];
#pragma unroll
            for (int i = 0; i < 16; ++i) { acc[0][i] = 0.f; acc[1][i] = 0.f; }
#pragma unroll
            for (int s = 0; s < 8; ++s) {
                const bf16x8 kf = *(const GAS bf16x8*)(SK + (size_t)r * 128 + 16 * s + 8 * hh);
                const bf16x8 q0 = *(const GAS bf16x8*)(Q + (size_t)r * 2048 + 16 * s + 8 * hh), q1 = *(const GAS bf16x8*)(Q + (size_t)(32 + r) * 2048 + 16 * s + 8 * hh);
                acc[0] = MFMA32(q0, kf, acc[0]); acc[1] = MFMA32(q1, kf, acc[1]);
            }
            __syncthreads();
#pragma unroll
            for (int tb = 0; tb < 2; ++tb)
#pragma unroll
                for (int i = 0; i < 16; ++i) Sl[(32 * tb + crow(i, hh)) * 256 + c * 128 + 32 * kb + r] = acc[tb][i];
        }
        __syncthreads();
#pragma unroll 1
        for (int rd = 0; rd < 4; ++rd) {
            const int row = rd * 32 + g16, tok = row >> 1, c = row & 1;
            int key[8];
#pragma unroll
            for (int s = 0; s < 8; ++s) { const int idx = s * 16 + l16; key[s] = (f2sort(Sl[tok * 256 + c * 128 + idx]) & ~127) | (127 - idx); }
            int mine = 0;
#pragma unroll 1
            for (int k = 0; k < 16; ++k) {
                int m = max(max(max(key[0], key[1]), max(key[2], key[3])), max(max(key[4], key[5]), max(key[6], key[7])));
                m = row16_max_i(m);
                if (l16 == k) mine = m;
#pragma unroll
                for (int s = 0; s < 8; ++s) key[s] = (key[s] == m) ? (int)0x80000000 : key[s];
            }
            SV[(tok * 2 + c) * 16 + l16] = sort2f(mine & ~127); SI[(tok * 2 + c) * 16 + l16] = 127 - (mine & 127);
        }
        __syncthreads();
#pragma unroll 1
        for (int rd = 0; rd < 2; ++rd) {
            const int tok = rd * 32 + g16;
            const float sv0 = SV[(tok * 2) * 16 + l16];
            int ptr = 0;
            int key = (f2sort(sv0 + SV[(tok * 2 + 1) * 16]) & ~255) | (255 - (l16 * 16));
            int mine = 0;
#pragma unroll 1
            for (int k = 0; k < 16; ++k) {
                const int m = row16_max_i(key);
                if (l16 == k) mine = m;
                if (key == m) { ++ptr; key = (ptr < 16) ? ((f2sort(sv0 + SV[(tok * 2 + 1) * 16 + (ptr & 15)]) & ~255) | (255 - (l16 * 16 + ptr))) : (int)0x80000000; }
            }
            const int flat = 255 - (mine & 255), aw = flat >> 4, bw = flat & 15;
            const float best = sort2f(mine & ~255);
            const int e = SI[(tok * 2) * 16 + aw] * 128 + SI[(tok * 2 + 1) * 16 + bw];
            const float mx = sort2f(row16_max_i(mine) & ~255);
            const float ex = __expf(best - mx), sum = row16_sum_f(ex);
            const size_t o = (size_t)(tile * 64 + tok) * NSEL + head * 16 + l16;
            EIDX[o] = e; GATE[o] = ex / sum;
        }
    }
    __syncthreads();
}
typedef __bf16 bf16x2_t __attribute__((ext_vector_type(2)));
__device__ __forceinline__ float dot2bf(unsigned a, unsigned b, float c) { return __builtin_amdgcn_fdot2_f32_bf16(__builtin_bit_cast(bf16x2_t, a), __builtin_bit_cast(bf16x2_t, b), c, false); }
__device__ __forceinline__ void peer_down_phase(Frame& F) {
    const int lane = F.lane, w = F.wave;
    const float* gf = F.in[17]; const float* SSQ2 = (const float*)(F.ws + WS_SSQ2); const bf16* DOWN = (const bf16*)(F.ws + WS_DOWN);
    const int* EIDX = (const int*)(F.ws + WS_EIDX); float* GATE = (float*)(F.ws + WS_GATE);
    for (int t = F.vcu; t < M; t += F.G) {
        const float rstd = __builtin_amdgcn_rsqf(wave_sum(SSQ2[(size_t)t * 64 + lane]) * (1.f / 4096.f) + EPS);
        unsigned xp[32];
        const float* h2 = F.out + (size_t)t * D;
#pragma unroll
        for (int i = 0; i < 8; ++i) { const int e0 = (i * 64 + lane) * 8;
            const f32x4 a0 = *(const GAS f32x4*)(h2 + e0), a1 = *(const GAS f32x4*)(h2 + e0 + 4), g0 = *(const GAS f32x4*)(gf + e0), g1 = *(const GAS f32x4*)(gf + e0 + 4);
            xp[4 * i + 0] = pk2(a0.x * g0.x * rstd, a0.y * g0.y * rstd); xp[4 * i + 1] = pk2(a0.z * g0.z * rstd, a0.w * g0.w * rstd);
            xp[4 * i + 2] = pk2(a1.x * g1.x * rstd, a1.y * g1.y * rstd); xp[4 * i + 3] = pk2(a1.z * g1.z * rstd, a1.w * g1.w * rstd); }
        const size_t ob = (size_t)t * NSEL + w * 16;
        const int myidx = EIDX[ob + (lane & 15)];
        float res = 0.f;
#pragma unroll 1
        for (int jj = 0; jj < 16; jj += 4) {
            float acc[4];
            v4u v[4][8];
#pragma unroll
            for (int k = 0; k < 4; ++k) { const int e = __builtin_amdgcn_readlane(myidx, jj + k); const bf16* rowp = DOWN + (size_t)e * D + lane * 8;
#pragma unroll
                for (int i = 0; i < 8; ++i) v[k][i] = *(const GAS v4u*)(rowp + i * 512); }
#pragma unroll
            for (int k = 0; k < 4; ++k) { float a = 0.f;
#pragma unroll
                for (int i = 0; i < 8; ++i) { a = dot2bf(v[k][i].x, xp[4 * i + 0], a); a = dot2bf(v[k][i].y, xp[4 * i + 1], a); a = dot2bf(v[k][i].z, xp[4 * i + 2], a); a = dot2bf(v[k][i].w, xp[4 * i + 3], a); }
                acc[k] = wave_sum(a); }
#pragma unroll
            for (int k = 0; k < 4; ++k) if (lane == jj + k) res = acc[k];
        }
        if (lane < 16) { const float g = GATE[ob + lane]; GATE[ob + lane] = g * 0.5f * res * (1.0f + erff(res * 0.70710678118654752f)); }
    }
}
__device__ __forceinline__ void peer_up_phase(Frame& F) {
    const int tid = F.tid, lane = F.lane, w = F.wave;
    LAS float* wl = (LAS float*)F.lds; LAS int* el = (LAS int*)(F.lds + 512); LAS float* pr = (LAS float*)(F.lds + 1024);
    const bf16* UP = (const bf16*)(F.ws + WS_UP); const int* EIDX = (const int*)(F.ws + WS_EIDX); const float* GATE = (const float*)(F.ws + WS_GATE); const float* fg = F.in[22];
    for (int t = F.vcu; t < M; t += F.G) {
        __syncthreads();
        if (tid < NSEL) { wl[tid] = GATE[(size_t)t * NSEL + tid]; el[tid] = EIDX[(size_t)t * NSEL + tid]; }
        __syncthreads();
        float acc[8];
#pragma unroll
        for (int e = 0; e < 8; ++e) acc[e] = 0.f;
#pragma unroll 1
        for (int j0 = 0; j0 < NSEL; j0 += 16) {
            v4u v[16];
#pragma unroll
            for (int j = 0; j < 16; ++j) v[j] = *(const GAS v4u*)(UP + (size_t)el[j0 + j] * D + tid * 8);
#pragma unroll
            for (int j = 0; j < 16; ++j) { const float wj = wl[j0 + j];
                acc[0] += wj * bflo(v[j].x); acc[1] += wj * bfhi(v[j].x); acc[2] += wj * bflo(v[j].y); acc[3] += wj * bfhi(v[j].y);
                acc[4] += wj * bflo(v[j].z); acc[5] += wj * bfhi(v[j].z); acc[6] += wj * bflo(v[j].w); acc[7] += wj * bfhi(v[j].w); }
        }
        float* orow = F.out + (size_t)t * D + tid * 8;
        f32x4 y0 = *(const GAS f32x4*)orow, y1 = *(const GAS f32x4*)(orow + 4);
        y0 += (f32x4){acc[0], acc[1], acc[2], acc[3]}; y1 += (f32x4){acc[4], acc[5], acc[6], acc[7]};
        float ss = (y0.x * y0.x + y0.y * y0.y) + (y0.z * y0.z + y0.w * y0.w) + (y1.x * y1.x + y1.y * y1.y) + (y1.z * y1.z + y1.w * y1.w);
        ss = wave_sum(ss);
        if (lane == 0) pr[w] = ss;
        __syncthreads();
        float tot = 0.f;
#pragma unroll
        for (int k = 0; k < 8; ++k) tot += pr[k];
        const float rstd = __builtin_amdgcn_rsqf(tot * (1.f / 4096.f) + EPS);
        const f32x4 g0 = *(const GAS f32x4*)(fg + tid * 8), g1 = *(const GAS f32x4*)(fg + tid * 8 + 4);
        *(GAS f32x4*)orow = y0 * rstd * g0; *(GAS f32x4*)(orow + 4) = y1 * rstd * g1;
    }
    __syncthreads();
}
constexpr int N_PHASES = 11;
struct Args { const float* in[23]; float* out; unsigned char* ws; int ph_lo, ph_hi, use_bar, pad; };
__global__ void __launch_bounds__(NTHR, 2) hybrid_fwd(Args args) {
    extern __shared__ __attribute__((aligned(16))) unsigned char lds[];
    Frame F;
    F.lds = (LAS unsigned char*)lds;
    F.MISC = (volatile LAS unsigned*)(F.lds + MISC_OFF);
    F.tid = threadIdx.x; F.lane = F.tid & 63; F.wave = __builtin_amdgcn_readfirstlane(F.tid >> 6);
    F.G = gridDim.x; { const int bx = blockIdx.x; F.vcu = (F.G % 8 == 0) ? (bx % 8) * (F.G / 8) + bx / 8 : bx; }
    F.ws = args.ws; F.ctl = (gu32*)(args.ws + WS_CTL); F.out = args.out;
#pragma unroll
    for (int i = 0; i < 23; ++i) F.in[i] = args.in[i];
    for (int u = F.tid; u < (LDS_BYTES - LDSCTL_OFF) / 4; u += NTHR) ((LAS unsigned*)(F.lds + LDSCTL_OFF))[u] = 0u;
    __syncthreads();
    XcdBarrier bar; bar.bar = (unsigned*)(F.ctl + CW_BAR); bar.x = 0; bar.st = nullptr;
    if (args.use_bar) bar = xcd_barrier_post((unsigned*)(F.ctl + CW_BAR), F.MISC + 8);
    const int lo = args.ph_lo, hi = args.ph_hi;
#ifndef PH_MASK
#define PH_MASK 0x7ff
#endif
#define IN(k) ((((PH_MASK) >> (k)) & 1) && lo <= (k) && (k) < hi)
#define SEAM(k) do { if (IN(k) && IN((k) + 1)) xcd_barrier(bar); } while (0)
    unsigned char* ws = args.ws;
    bf16* XN = (bf16*)(ws + WS_XN);

    if (IN(0)) { p0_prologue(F); } SEAM(0);

    if (IN(1)) {
        { pg8::Gemm g{XN, (const bf16*)(ws + WS_WIN), D, D, D, 0, 0, 0, 0}; pg8::StaticOrder S; S.init(M, NIN, F.G, (int)blockIdx.x, 1 << 20);
          pg8::EpiInproj E{(bf16*)(ws + WS_PROJ), NIN, F.in[9]};
          pg8::gemm_phase<pg8::EpiInproj, pg8::StaticOrder, true, true>(F.lds, g, S, E); }
        { pg8::Gemm g{(const bf16*)(ws + WS_MEMN), (const bf16*)(ws + WS_WCKV), D, D, D, 0, 0, 0, 0}; pg8::StaticOrder S; S.init(MROWS, 2 * D, F.G, (int)blockIdx.x, 1 << 20);
          pg8::EpiBf16Z E{(bf16*)(ws + WS_KV), 2 * D, 0, 0};
          pg8::gemm_phase<pg8::EpiBf16Z, pg8::StaticOrder, true, true>(F.lds, g, S, E); }
    } SEAM(1);

    if (IN(2)) {
        float lam;
        { const float a = wave_sum(F.in[4][F.lane] * F.in[5][F.lane]), c = wave_sum(F.in[6][F.lane] * F.in[7][F.lane]); lam = __expf(a) - __expf(c) + 0.2f; }
#ifndef NO_HGRN
        for (int u = F.vcu; u < 256; u += F.G) hgrn_unit(F, u >> 6, (u >> 2) & 15, u & 3);
#endif
#ifndef NO_ATTN
        for (int u = F.vcu; u < 256; u += F.G) {
            const int bh = u >> 2, s = u & 3;
#pragma unroll 1
            for (int k = 0; k < 4; ++k) { const int qb = (k == 0) ? 15 - s : (k == 1) ? 8 + s : (k == 2) ? 7 - s : s; attn_unit(F, bh >> 4, bh & 15, qb, lam); }
        }
#endif
    } SEAM(2);

    if (IN(3)) {
        hgrn_fixup(F);
        { pg8::Gemm g{(const bf16*)(ws + WS_KV), (const bf16*)(ws + WS_WCQ), 1024, 2 * D, D, (size_t)MEML * 2 * D, 1024, 0, 1024}; pg8::BatchOrder S; S.init(4, 4, 1, 16, F.G, (int)blockIdx.x);
          pg8::EpiBf16Z E{(bf16*)(ws + WS_WKP), D, (size_t)1024 * D, (size_t)256 * D};
          pg8::gemm_phase<pg8::EpiBf16Z, pg8::BatchOrder, true, true>(F.lds, g, S, E); }
        { pg8::Gemm g{(const bf16*)(ws + WS_WCO), (const bf16*)(ws + WS_KV) + D, 1024, D, 2 * D, 0, 1024, (size_t)MEML * 2 * D, 1024}; pg8::BatchOrder S; S.init(4, 4, 16, 1, F.G, (int)blockIdx.x);
          pg8::EpiBf16Z E{(bf16*)(ws + WS_VP), 1024, (size_t)D * 1024, 256};
          pg8::gemm_phase<pg8::EpiBf16Z, pg8::BatchOrder, true, true>(F.lds, g, S, E); }
    } SEAM(3);

    if (IN(4)) {
        pg8::Gemm g{XN, (const bf16*)(ws + WS_WOUT), D, D, D, 0, 0, 0, 0}; pg8::StaticOrder S; S.init(M, D, F.G, (int)blockIdx.x, 1 << 20);
        pg8::EpiResid E{F.in[0], (float*)(ws + WS_H1F), (bf16*)(ws + WS_H1B), (float*)(ws + WS_SSQ1)};
        pg8::gemm_phase<pg8::EpiResid, pg8::StaticOrder, true, true>(F.lds, g, S, E);
    } SEAM(4);

    if (IN(5)) {
        pg8::Gemm g{(const bf16*)(ws + WS_H1B), (const bf16*)(ws + WS_WKP), D, D, D, 0, 0, (size_t)1024 * D, 0}; pg8::StaticOrder S; S.init(M, 1024, F.G, (int)blockIdx.x, 16);
        pg8::EpiSoftmax E{(bf16*)(ws + WS_PB), 1024, (const float*)(ws + WS_SSQ1), 0.03125f * LOG2E};
        pg8::gemm_phase<pg8::EpiSoftmax, pg8::StaticOrder, false, true>(F.lds, g, S, E);
    } SEAM(5);

    if (IN(6)) {
        pg8::Gemm g{(const bf16*)(ws + WS_PB), (const bf16*)(ws + WS_VP), 1024, 1024, 1024, 0, 0, (size_t)D * 1024, 0}; pg8::StaticOrder S; S.init(M, D, F.G, (int)blockIdx.x, 16);
        pg8::EpiResid E{(const float*)(ws + WS_H1F), F.out, XN, (float*)(ws + WS_SSQ2)};
        pg8::gemm_phase<pg8::EpiResid, pg8::StaticOrder, true, true>(F.lds, g, S, E);
    } SEAM(6);

    if (IN(7)) {
        pg8::Gemm g{XN, (const bf16*)(ws + WS_WPQ), D, D, D, 0, 0, 0, 0}; pg8::StaticOrder S; S.init(M, 2048, F.G, (int)blockIdx.x, 1 << 20);
        pg8::EpiRowScale E{(bf16*)(ws + WS_WIN), 2048, (const float*)(ws + WS_SSQ2)};
        pg8::gemm_phase<pg8::EpiRowScale, pg8::StaticOrder, true, true>(F.lds, g, S, E);
    } SEAM(7);

    if (IN(8)) { topk_phase(F); } SEAM(8);
    if (IN(9)) { peer_down_phase(F); } SEAM(9);
    if (IN(10)) { peer_up_phase(F); }
#undef IN
#undef SEAM
}

#ifndef MK_SPLIT
#define MK_SPLIT 1
#endif
#ifndef MK_LAST_PHASE
#define MK_LAST_PHASE N_PHASES
#endif
extern "C" void kernel_launch(void* const* d_in, const int* in_sizes, int n_in, void* d_out, int out_size, void* d_ws, size_t ws_size, hipStream_t stream) {
    static int grid = 0;
    if (grid == 0) {
        if (n_in != 23 || out_size != M * D || ws_size < WS_END) { fprintf(stderr, "kernel_launch: unexpected shapes (n_in %d out %d ws %zu)\n", n_in, out_size, ws_size); grid = -1; return; }
        int dev = 0, cus = 0, per_cu = 0;
        if (hipGetDevice(&dev) != hipSuccess || hipDeviceGetAttribute(&cus, hipDeviceAttributeMultiprocessorCount, dev) != hipSuccess) { grid = -1; return; }
        if (hipFuncSetAttribute((const void*)hybrid_fwd, hipFuncAttributeMaxDynamicSharedMemorySize, LDS_BYTES) != hipSuccess) { fprintf(stderr, "kernel_launch: hipFuncSetAttribute failed\n"); grid = -1; return; }
        if (hipOccupancyMaxActiveBlocksPerMultiprocessor(&per_cu, (const void*)hybrid_fwd, NTHR, LDS_BYTES) != hipSuccess || per_cu < 1) fprintf(stderr, "kernel_launch: occupancy query reports %d\n", per_cu);
        (void)hipGetLastError();
        grid = cus;
        if (grid != 256) { fprintf(stderr, "kernel_launch: built for 256 CUs, device has %d\n", cus); grid = -1; return; }
    }
    if (grid < 0) return;
    (void)hipMemsetAsync((char*)d_ws + WS_CTL, 0, CTL_ZERO_BYTES, stream);
    Args a{};
    for (int i = 0; i < 23; ++i) a.in[i] = (const float*)d_in[i];
    a.out = (float*)d_out; a.ws = (unsigned char*)d_ws; a.pad = 0;
#if MK_SPLIT
    for (int p = 0; p < MK_LAST_PHASE; ++p) { a.ph_lo = p; a.ph_hi = p + 1; a.use_bar = 0; hipLaunchKernelGGL(hybrid_fwd, dim3(grid), dim3(NTHR), LDS_BYTES, stream, a); }
#else
    a.ph_lo = 0; a.ph_hi = MK_LAST_PHASE; a.use_bar = 1;
    hipLaunchKernelGGL(hybrid_fwd, dim3(grid), dim3(NTHR), LDS_BYTES, stream, a);
#endif
}
```

```cpp
#include <hip/hip_runtime.h>
#include <cstdio>
#include <cstdint>

#ifndef Q8_INT
#define Q8_INT 1
#endif
constexpr bool Q8_INT_ = (Q8_INT != 0);
namespace pg8 {
#define PG8_LAS __attribute__((address_space(3)))
typedef unsigned short bf16_t;
typedef short bf16x8 __attribute__((ext_vector_type(8)));
typedef float f32x4 __attribute__((ext_vector_type(4)));
typedef unsigned u32x4 __attribute__((ext_vector_type(4)));
constexpr int BM = 256, BK = 64, HALF = 128, HTB = HALF * BK * 2  , STAGE_BYTES = 8 * HTB, NXCD = 8, WGM = 8;

__host__ __device__ __forceinline__ int lds_byte(int r, int c) { const int st = (r >> 4) * 2 + (c >> 5), rr = r & 15, cc = c & 31, ob = rr * 64 + cc * 2; return st * 1024 + (ob ^ (((ob >> 9) & 1) << 5)); }
__host__ __device__ __forceinline__ void stage_rc(int b, int& R, int& C) { const int st = b / 1024, sb = b % 1024, swz = sb ^ (((sb >> 9) & 1) << 5); R = (st >> 1) * 16 + swz / 64; C = (st & 1) * 32 + (swz % 64) / 2; }
__host__ __device__ __forceinline__ int perm32(int rho) { const int n = rho >> 4, i = rho & 15; return 8 * (i >> 2) + 4 * n + (i & 3); }

struct Unit { int pm, pn, zb, zh; };
struct Gemm {
    const bf16_t* A; const bf16_t* Bt; int K, lda, ldb; size_t a_zb, a_zh, b_zb, b_zh;
    __device__ __forceinline__ const char* a_ptr(const Unit& u) const { return (const char*)(A + (size_t)u.zb * a_zb + (size_t)u.zh * a_zh + (size_t)u.pm * BM * lda); }
    __device__ __forceinline__ const char* b_ptr(const Unit& u) const { return (const char*)(Bt + (size_t)u.zb * b_zb + (size_t)u.zh * b_zh + (size_t)u.pn * BM * ldb); }
};

struct StaticOrder {
    int nM, nN, nwg, G, c, zdiv;
    __host__ __device__ void init(int M, int N, int G_, int c_, int zdiv_) { nM = M / BM; nN = N / BM; nwg = nM * nN; G = G_; c = c_; zdiv = zdiv_; }
    __host__ __device__ bool next(int i, Unit& u) const {
        const long L = (long)i * G + c; if (L >= nwg) return false;
        int wgid = (int)L; { const int q = nwg / NXCD, r = nwg % NXCD, xcd = wgid % NXCD, off = wgid / NXCD; wgid = (xcd < r ? xcd * (q + 1) : r * (q + 1) + (xcd - r) * q) + off; }
        const int nig = WGM * nN, gid = wgid / nig, fm = gid * WGM, gsz = (nM - fm) < WGM ? (nM - fm) : WGM;
        u.pm = fm + ((wgid % nig) % gsz); u.pn = (wgid % nig) / gsz; u.zb = u.pm / zdiv; u.zh = 0; return true;
    }
    __device__ __forceinline__ void a_ready(const Unit&) const {}
    __device__ __forceinline__ void done(const Unit&) const {}
};
struct SegOrder {
    StaticOrder so; unsigned segs;
    __host__ __device__ void init(int M, int nseg, unsigned segs_, int G_, int c_) { so.init(M, nseg * 2048, G_, c_, 1 << 20); segs = segs_; }
    __host__ __device__ bool next(int i, Unit& u) const { if (!so.next(i, u)) return false; u.pn = (int)((segs >> (3 * (u.pn >> 3))) & 7u) * 8 + (u.pn & 7); return true; }
    __device__ __forceinline__ void a_ready(const Unit&) const {}
    __device__ __forceinline__ void done(const Unit&) const {}
};
struct BatchOrder {
    int nM, nN, nzh, ntot, G, c;
    __host__ __device__ void init(int nzb_, int nzh_, int nM_, int nN_, int G_, int c_) { nM = nM_; nN = nN_; nzh = nzh_; ntot = nzb_ * nzh_ * nM_ * nN_; G = G_; c = c_; }
    __host__ __device__ bool next(int i, Unit& u) const {
        const long L = (long)i * G + c; if (L >= ntot) return false;
        const int l = (int)L, per = nM * nN, z = l / per, r = l % per; u.zb = z / nzh; u.zh = z % nzh; u.pm = r / nN; u.pn = r % nN; return true;
    }
    __device__ __forceinline__ void a_ready(const Unit&) const {}
    __device__ __forceinline__ void done(const Unit&) const {}
};

__device__ __forceinline__ unsigned cvt_pk_bf16(float lo, float hi) { typedef float f2 __attribute__((ext_vector_type(2))); typedef __bf16 b2 __attribute__((ext_vector_type(2))); f2 v = {lo, hi}; b2 b = __builtin_convertvector(v, b2); return __builtin_bit_cast(unsigned, b); }
__device__ __forceinline__ u32x4 pack8(const f32x4& v0, const f32x4& v1) { u32x4 w; w.x = cvt_pk_bf16(v0[0], v0[1]); w.y = cvt_pk_bf16(v0[2], v0[3]); w.z = cvt_pk_bf16(v1[0], v1[1]); w.w = cvt_pk_bf16(v1[2], v1[3]); return w; }
__device__ __forceinline__ float sigm(float t) { return __builtin_amdgcn_rcpf(1.0f + __expf(-t)); }

constexpr float QK_SCALE_LOG2E = 0.125f * 1.4426950408889634f;
struct EpiInproj {
    static constexpr bool PERM = true, AFTER_DRAIN = false;
    bf16_t* O; int ldc; const float* gamma; const float* sa; float sbw;
    __device__ __forceinline__ void operator()(const f32x4 (&acc)[2][2][4][2], const Unit& u, int wr, int wc, int fr, int fq) const {
        asm volatile("" : "+v"(fr), "+v"(fq));
        const int seg = u.pn >> 3; const int row0 = u.pm * BM + wr * 64 + fr, col0 = u.pn * BM + wc * 32 + 8 * fq;
#pragma unroll
        for (int bj = 0; bj < 2; ++bj) {
            const int col = col0 + bj * HALF;
            f32x4 om0 = {1.f, 1.f, 1.f, 1.f}, om1 = om0;
            if (seg == 4) { const int c = col - 8192; const f32x4 g00 = *(const f32x4*)(gamma + c), g01 = *(const f32x4*)(gamma + c + 4), g10 = *(const f32x4*)(gamma + 2048 + c), g11 = *(const f32x4*)(gamma + 2048 + c + 4);
#pragma unroll
                for (int e = 0; e < 4; ++e) { om0[e] = sigm(g10[e] - g00[e]); om1[e] = sigm(g11[e] - g01[e]); } }
#pragma unroll
            for (int ai = 0; ai < 2; ++ai)
#pragma unroll
                for (int m = 0; m < 4; ++m) {
                    const float rs_ = sa ? sa[row0 + ai * HALF + m * 16] * sbw : 1.0f;
                    f32x4 v0 = acc[ai][bj][m][0], v1 = acc[ai][bj][m][1];
                    if (Q8_INT_ && sa) {
#pragma unroll
                        for (int e = 0; e < 4; ++e) { v0[e] = (float)__float_as_int(v0[e]); v1[e] = (float)__float_as_int(v1[e]); } }
                    v0 = v0 * rs_; v1 = v1 * rs_;
                    if (seg == 3 || seg == 6) {
#pragma unroll
                        for (int e = 0; e < 4; ++e) { v0[e] = v0[e] * sigm(v0[e]); v1[e] = v1[e] * sigm(v1[e]); }
                    } else if (seg == 4) {
#pragma unroll
                        for (int e = 0; e < 4; ++e) { v0[e] = om0[e] * sigm(-v0[e]); v1[e] = om1[e] * sigm(-v1[e]); }
                    } else if (seg == 0) { v0 = v0 * QK_SCALE_LOG2E; v1 = v1 * QK_SCALE_LOG2E; }
                    *(u32x4*)(O + (size_t)(row0 + ai * HALF + m * 16) * ldc + col) = pack8(v0, v1);
                }
        }
    }
};
__device__ __forceinline__ float row_rstd(const float* ssq, int row, int fq);
constexpr float H2Q_CLIP = 6.5f;
__device__ __forceinline__ unsigned pk_i8x4(f32x4 v, float q) {
    const int a = (int)rintf(__builtin_amdgcn_fmed3f(v[0] * q, -127.f, 127.f)), b = (int)rintf(__builtin_amdgcn_fmed3f(v[1] * q, -127.f, 127.f)), c = (int)rintf(__builtin_amdgcn_fmed3f(v[2] * q, -127.f, 127.f)), d = (int)rintf(__builtin_amdgcn_fmed3f(v[3] * q, -127.f, 127.f));
    return ((unsigned)a & 255u) | (((unsigned)b & 255u) << 8) | (((unsigned)c & 255u) << 16) | ((unsigned)d << 24); }
struct EpiBf16Z {
    static constexpr bool PERM = true, AFTER_DRAIN = false;
    bf16_t* O; int ldc; size_t c_zb, c_zh; unsigned char* O8 = nullptr; float q8 = 0.f; float deq = 0.f;
    __device__ __forceinline__ void operator()(const f32x4 (&acc)[2][2][4][2], const Unit& u, int wr, int wc, int fr, int fq) const {
        asm volatile("" : "+v"(fr), "+v"(fq));
        bf16_t* base = O + (size_t)u.zb * c_zb + (size_t)u.zh * c_zh; unsigned char* base8 = O8 + (size_t)u.zb * c_zb + (size_t)u.zh * c_zh; const int row0 = u.pm * BM + wr * 64 + fr, col0 = u.pn * BM + wc * 32 + 8 * fq;
#pragma unroll
        for (int ai = 0; ai < 2; ++ai)
#pragma unroll
            for (int m = 0; m < 4; ++m)
#pragma unroll
                for (int bj = 0; bj < 2; ++bj) { const size_t off = (size_t)(row0 + ai * HALF + m * 16) * ldc + col0 + bj * HALF;
                    f32x4 a0 = acc[ai][bj][m][0], a1 = acc[ai][bj][m][1];
                    if (Q8_INT_ && deq != 0.f) {
#pragma unroll
                        for (int e = 0; e < 4; ++e) { a0[e] = (float)__float_as_int(a0[e]) * deq; a1[e] = (float)__float_as_int(a1[e]) * deq; } }
                    if (O8) { typedef unsigned u32x2z __attribute__((ext_vector_type(2))); u32x2z o8_; o8_.x = pk_i8x4(a0, q8); o8_.y = pk_i8x4(a1, q8); *(u32x2z*)(base8 + off) = o8_; }
                    else *(u32x4*)(base + off) = pack8(a0, a1); }
    }
};
template <bool RESID_BF16> struct EpiResid {
    static constexpr bool PERM = true, AFTER_DRAIN = false;
    const void* resid; bf16_t* outb; float* ssq; const float* sa = nullptr; float sbw = 1.0f; unsigned char* out8 = nullptr; const float* ssq_q = nullptr;
    __device__ __forceinline__ void operator()(const f32x4 (&acc)[2][2][4][2], const Unit& u, int wr, int wc, int fr, int fq) const {
        asm volatile("" : "+v"(fr), "+v"(fq));
        const int row0 = u.pm * BM + wr * 64 + fr, col0 = u.pn * BM + wc * 32 + 8 * fq;
#pragma unroll
        for (int ai = 0; ai < 2; ++ai)
#pragma unroll
            for (int m = 0; m < 4; ++m) { const int row = row0 + ai * HALF + m * 16; float s = 0.f; const float rs_ = sa ? sa[row] * sbw : 1.0f; const float q8_ = out8 ? (127.0f / H2Q_CLIP) * row_rstd(ssq_q, row, fq) : 0.f;
#pragma unroll
                for (int bj = 0; bj < 2; ++bj) { const size_t off = (size_t)row * 4096 + col0 + bj * HALF;
                    f32x4 r0, r1;
                    if constexpr (RESID_BF16) { const u32x4 rb = *(const u32x4*)((const bf16_t*)resid + off);
                        r0 = (f32x4){__uint_as_float(rb.x << 16), __uint_as_float(rb.x & 0xffff0000u), __uint_as_float(rb.y << 16), __uint_as_float(rb.y & 0xffff0000u)};
                        r1 = (f32x4){__uint_as_float(rb.z << 16), __uint_as_float(rb.z & 0xffff0000u), __uint_as_float(rb.w << 16), __uint_as_float(rb.w & 0xffff0000u)}; }
                    else { r0 = *(const f32x4*)((const float*)resid + off); r1 = *(const f32x4*)((const float*)resid + off + 4); }
                    f32x4 a0 = acc[ai][bj][m][0], a1 = acc[ai][bj][m][1];
                    if (Q8_INT_ && sa) {
#pragma unroll
                        for (int e = 0; e < 4; ++e) { a0[e] = (float)__float_as_int(a0[e]) * rs_; a1[e] = (float)__float_as_int(a1[e]) * rs_; } }
                    const f32x4 v0 = a0 + r0, v1 = a1 + r1;
                    *(u32x4*)(outb + off) = pack8(v0, v1);
                    if (out8) { typedef unsigned u32x2r __attribute__((ext_vector_type(2))); u32x2r o8_; o8_.x = pk_i8x4(v0, q8_); o8_.y = pk_i8x4(v1, q8_); *(u32x2r*)(out8 + off) = o8_; }
                    s += ((v0[0] * v0[0] + v0[1] * v0[1]) + (v0[2] * v0[2] + v0[3] * v0[3])) + ((v1[0] * v1[0] + v1[1] * v1[1]) + (v1[2] * v1[2] + v1[3] * v1[3])); }
                s += __shfl_xor(s, 16); s += __shfl_xor(s, 32);
                if (fq == 0) ssq[(size_t)row * 64 + u.pn * 4 + wc] = s; }
    }
};
__device__ __forceinline__ float row_rstd(const float* ssq, int row, int fq) {
    const f32x4* p = (const f32x4*)(ssq + (size_t)row * 64 + fq * 16); float s = 0.f;
#pragma unroll
    for (int k = 0; k < 4; ++k) { const f32x4 v = p[k]; s += (v[0] + v[1]) + (v[2] + v[3]); }
    s += __shfl_xor(s, 16); s += __shfl_xor(s, 32);
    return __builtin_amdgcn_rsqf(s * (1.0f / 4096.0f) + 1e-6f);
}
struct EpiRowScale {
    static constexpr bool PERM = true, AFTER_DRAIN = false;
    bf16_t* O; int ldc; const float* ssq; const float* ssq_q = nullptr; float sbw = 1.0f;
    __device__ __forceinline__ void operator()(const f32x4 (&acc)[2][2][4][2], const Unit& u, int wr, int wc, int fr, int fq) const {
        const int row0 = u.pm * BM + wr * 64 + fr, col0 = u.pn * BM + wc * 32 + 8 * fq;
#pragma unroll
        for (int ai = 0; ai < 2; ++ai)
#pragma unroll
            for (int m = 0; m < 4; ++m) { const int row = row0 + ai * HALF + m * 16; float rs = row_rstd(ssq, row, fq);
                if (ssq_q) rs = rs * (H2Q_CLIP / 127.0f) * sbw / row_rstd(ssq_q, row, fq);
#pragma unroll
                for (int bj = 0; bj < 2; ++bj) { f32x4 a0 = acc[ai][bj][m][0], a1 = acc[ai][bj][m][1];
                    if (Q8_INT_ && ssq_q) {
#pragma unroll
                        for (int e = 0; e < 4; ++e) { a0[e] = (float)__float_as_int(a0[e]); a1[e] = (float)__float_as_int(a1[e]); } }
                    *(u32x4*)(O + (size_t)row * ldc + col0 + bj * HALF) = pack8(a0 * rs, a1 * rs); } }
    }
};
struct EpiSoftmax {
    static constexpr bool PERM = true, AFTER_DRAIN = true;
    bf16_t* O; int ldc; const float* ssq; float scale_log2e;
    __device__ __forceinline__ void fused(f32x4 (&acc)[2][2][4][2], const Unit& u, int wr, int wc, int fr, int fq, PG8_LAS unsigned char* lds, int wid, int lane) const {
        typedef float f32x2v __attribute__((ext_vector_type(2)));
        PG8_LAS f32x2v* X = (PG8_LAS f32x2v*)lds;
        float mwv[2][4];
#pragma unroll
        for (int ai = 0; ai < 2; ++ai)
#pragma unroll
            for (int m = 0; m < 4; ++m) { const int rl = ai * HALF + wr * 64 + m * 16 + fr; const float rs = row_rstd(ssq, u.pm * BM + rl, fq) * scale_log2e;
                float mx = -3.0e38f;
#pragma unroll
                for (int bj = 0; bj < 2; ++bj)
#pragma unroll
                    for (int n = 0; n < 2; ++n) { acc[ai][bj][m][n] = acc[ai][bj][m][n] * rs; const f32x4 v = acc[ai][bj][m][n]; mx = fmaxf(mx, fmaxf(fmaxf(v[0], v[1]), fmaxf(v[2], v[3]))); }
                mx = fmaxf(mx, __shfl_xor(mx, 16)); mx = fmaxf(mx, __shfl_xor(mx, 32));
                float sm = 0.f;
#pragma unroll
                for (int bj = 0; bj < 2; ++bj)
#pragma unroll
                    for (int n = 0; n < 2; ++n) { f32x4 v = acc[ai][bj][m][n];
#pragma unroll
                        for (int e = 0; e < 4; ++e) { v[e] = __builtin_amdgcn_exp2f(v[e] - mx); sm += v[e]; } acc[ai][bj][m][n] = v; }
                sm += __shfl_xor(sm, 16); sm += __shfl_xor(sm, 32);
                mwv[ai][m] = mx;
                if (fq == 0) X[rl * 4 + wc] = (f32x2v){mx, sm}; }
        asm volatile("s_waitcnt lgkmcnt(0)" ::: "memory"); __builtin_amdgcn_s_barrier(); asm volatile("" ::: "memory");
        const int col0 = u.pn * BM + wc * 32 + 8 * fq;
#pragma unroll
        for (int ai = 0; ai < 2; ++ai)
#pragma unroll
            for (int m = 0; m < 4; ++m) { const int rl = ai * HALF + wr * 64 + m * 16 + fr;
                const f32x2v a = X[rl * 4 + 0], b = X[rl * 4 + 1], c = X[rl * 4 + 2], d = X[rl * 4 + 3];
                const float Mx = fmaxf(fmaxf(a.x, b.x), fmaxf(c.x, d.x));
                const float S = a.y * __builtin_amdgcn_exp2f(a.x - Mx) + b.y * __builtin_amdgcn_exp2f(b.x - Mx) + c.y * __builtin_amdgcn_exp2f(c.x - Mx) + d.y * __builtin_amdgcn_exp2f(d.x - Mx);
                const float f = __builtin_amdgcn_exp2f(mwv[ai][m] - Mx) / S;
#pragma unroll
                for (int bj = 0; bj < 2; ++bj) *(u32x4*)(O + (size_t)(u.pm * BM + rl) * ldc + col0 + bj * HALF) = pack8(acc[ai][bj][m][0] * f, acc[ai][bj][m][1] * f); }
    }
};

template <class Epi, class Sched, bool ALIGN_EPI = false, bool SP2 = false, bool FP8 = false>
__device__ __forceinline__ void gemm_phase(PG8_LAS unsigned char* lds, const Gemm g, const Sched& S, const Epi& E) {
    int tid_ = threadIdx.x; asm volatile("" : "+v"(tid_));
    const int tid = tid_, wid = __builtin_amdgcn_readfirstlane(tid >> 6), lane = tid & 63, wr = wid >> 2, wc = wid & 3, fr = lane & 15, fq = lane >> 4;
    const int K = g.K, nt = K / BK;
    unsigned voffA[2], voffB[2];
#pragma unroll
    for (int i = 0; i < 2; ++i) { int R, C; stage_rc(tid * 16 + i * 8192, R, C); const int Rb = Epi::PERM ? ((R & ~31) + perm32(R & 31)) : R;
        voffA[i] = (unsigned)(R * g.lda + C) * 2u; voffB[i] = (unsigned)(Rb * g.ldb + C) * 2u; }
    const size_t kstep = (size_t)(BK * 2);
    const size_t hstepA = (size_t)HALF * g.lda * 2, hstepB = (size_t)HALF * g.ldb * 2;

    const unsigned ldsw = (unsigned)wid * 1024u;
    const int aoff = lds_byte(wr * 64 + fr, fq * 8), boff = lds_byte(wc * 32 + fr, fq * 8);
#define PG8_SA(b, h) (((b) * 2 + (h)) * HTB)
#define PG8_SB(b, h) ((4 + (b) * 2 + (h)) * HTB)
#define PG8_STAGE(bufoff, gbase, voff) do { _Pragma("unroll") for (int _i = 0; _i < 2; ++_i) { unsigned keep_; \
        asm volatile("s_mov_b32 %0, m0\n\ts_mov_b32 m0, %3\n\ts_nop 0\n\tglobal_load_lds_dwordx4 %1, %2\n\ts_mov_b32 m0, %0" : "=&s"(keep_) \
            : "v"((voff)[_i]), "s"((const char*)(gbase)), "s"((unsigned)(size_t)(lds + (bufoff) + ldsw + _i * 8192)) : "memory"); } } while (0)
#define PG8_LDA(dst, b, h) do { _Pragma("unroll") for (int m = 0; m < 4; ++m) dst[m] = __builtin_shufflevector(*(const PG8_LAS v4i_*)(lds + PG8_SA(b, h) + aoff + m * 2048), *(const PG8_LAS v4i_*)(lds + PG8_SA(b, h) + aoff + m * 2048 + 1024), 0, 1, 2, 3, 4, 5, 6, 7); } while (0)
#define PG8_LDB(dst, b, h) do { _Pragma("unroll") for (int n = 0; n < 2; ++n) dst[n] = __builtin_shufflevector(*(const PG8_LAS v4i_*)(lds + PG8_SB(b, h) + boff + n * 2048), *(const PG8_LAS v4i_*)(lds + PG8_SB(b, h) + boff + n * 2048 + 1024), 0, 1, 2, 3, 4, 5, 6, 7); } while (0)
#define PG8_LO4(x) __builtin_shufflevector(x, x, 0, 1, 2, 3)
#define PG8_HI4(x) __builtin_shufflevector(x, x, 4, 5, 6, 7)
#define PG8_LO(x) __builtin_bit_cast(bf16x8, __builtin_shufflevector(x, x, 0, 1, 2, 3))
#define PG8_HI(x) __builtin_bit_cast(bf16x8, __builtin_shufflevector(x, x, 4, 5, 6, 7))
#define PG8_MMA(ai, bj, At, Bt) do { __builtin_amdgcn_s_setprio(1); _Pragma("unroll") for (int m = 0; m < 4; ++m) _Pragma("unroll") for (int n = 0; n < 2; ++n) { \
        if constexpr (FP8) { if constexpr (Q8_INT_) { \
                acc[ai][bj][m][n] = __builtin_bit_cast(f32x4, __builtin_amdgcn_mfma_i32_16x16x64_i8(PG8_LO4(Bt[n]), PG8_LO4(At[m]), __builtin_bit_cast(v4i_, acc[ai][bj][m][n]), 0, 0, 0)); \
                acc[ai][bj][m][n] = __builtin_bit_cast(f32x4, __builtin_amdgcn_mfma_i32_16x16x64_i8(PG8_HI4(Bt[n]), PG8_HI4(At[m]), __builtin_bit_cast(v4i_, acc[ai][bj][m][n]), 0, 0, 0)); \
            } else acc[ai][bj][m][n] = __builtin_amdgcn_mfma_scale_f32_16x16x128_f8f6f4(Bt[n], At[m], acc[ai][bj][m][n], 0, 0, 0, 0, 0, 0); } \
        else { acc[ai][bj][m][n] = __builtin_amdgcn_mfma_f32_16x16x32_bf16(PG8_LO(Bt[n]), PG8_LO(At[m]), acc[ai][bj][m][n], 0, 0, 0); acc[ai][bj][m][n] = __builtin_amdgcn_mfma_f32_16x16x32_bf16(PG8_HI(Bt[n]), PG8_HI(At[m]), acc[ai][bj][m][n], 0, 0, 0); } } \
        __builtin_amdgcn_s_setprio(0); } while (0)
#define PG8_WAIT_V(n) asm volatile("s_waitcnt vmcnt(" #n ")" ::: "memory")
#define PG8_WAIT_L(n) asm volatile("s_waitcnt lgkmcnt(" #n ")" ::: "memory")
#define PG8_BAR __builtin_amdgcn_s_barrier()
#define PG8_SCHED __builtin_amdgcn_sched_barrier(0)
    Unit cur, nxt; int ui = 0;
    if (!S.next(0, cur)) return;
    f32x4 acc[2][2][4][2];
#pragma unroll
    for (int a = 0; a < 2; ++a)
#pragma unroll
        for (int b = 0; b < 2; ++b)
#pragma unroll
            for (int m = 0; m < 4; ++m)
#pragma unroll
                for (int n = 0; n < 2; ++n) acc[a][b][m][n] = (f32x4){0.f, 0.f, 0.f, 0.f};
    typedef int v4i_ __attribute__((ext_vector_type(4))); typedef int v8i_ __attribute__((ext_vector_type(8)));
    v8i_ At[4], B0[2], B1[2];
    const char* cA = g.a_ptr(cur); const char* cB = g.b_ptr(cur);
    S.a_ready(cur);
    if constexpr (SP2) {
        PG8_STAGE(PG8_SB(0, 0), cB, voffB); PG8_STAGE(PG8_SB(0, 1), cB + hstepB, voffB); PG8_STAGE(PG8_SA(0, 0), cA, voffA); PG8_STAGE(PG8_SA(0, 1), cA + hstepA, voffA);
        if (wr == 1) PG8_BAR;
        PG8_WAIT_V(2); PG8_BAR;
        PG8_STAGE(PG8_SB(1, 0), cB + kstep, voffB); PG8_STAGE(PG8_SA(1, 0), cA + kstep, voffA); PG8_STAGE(PG8_SB(1, 1), cB + hstepB + kstep, voffB);
        PG8_WAIT_V(6); PG8_BAR;
    } else {
        PG8_STAGE(PG8_SB(0, 0), cB, voffB); PG8_STAGE(PG8_SA(0, 0), cA, voffA); PG8_STAGE(PG8_SB(0, 1), cB + hstepB, voffB); PG8_STAGE(PG8_SA(0, 1), cA + hstepA, voffA);
        if (wr == 1) PG8_BAR;
        PG8_WAIT_V(4); PG8_BAR;
        PG8_STAGE(PG8_SB(1, 0), cB + kstep, voffB); PG8_STAGE(PG8_SA(1, 0), cA + kstep, voffA); PG8_STAGE(PG8_SB(1, 1), cB + hstepB + kstep, voffB);
        PG8_WAIT_V(6); PG8_BAR;
    }
    for (;;) {
        const bool has_next = S.next(ui + 1, nxt);
        const char* nA = has_next ? g.a_ptr(nxt) : cA; const char* nB = has_next ? g.b_ptr(nxt) : cB;
        for (int t = 0; t < nt; t += 2) {
            const bool last = (t == nt - 2);
            const char* a1 = cA + (size_t)(t + 1) * kstep;
            const char* a2 = last ? nA : cA + (size_t)(t + 2) * kstep; const char* b2 = last ? nB : cB + (size_t)(t + 2) * kstep;
            const char* a3 = a2 + kstep; const char* b3 = b2 + kstep;
            if (last && has_next) S.a_ready(nxt);
            if constexpr (SP2) {
            PG8_LDB(B0, 0, 0); PG8_LDB(B1, 0, 1); PG8_SCHED; PG8_LDA(At, 0, 0); PG8_STAGE(PG8_SA(1, 1), a1 + hstepA, voffA);
            PG8_WAIT_V(8); PG8_WAIT_L(0); PG8_BAR; PG8_MMA(0, 0, At, B0); PG8_MMA(0, 1, At, B1); PG8_BAR; PG8_SCHED;
            PG8_LDA(At, 0, 1); PG8_STAGE(PG8_SB(0, 0), b2, voffB); PG8_STAGE(PG8_SB(0, 1), b2 + hstepB, voffB); PG8_STAGE(PG8_SA(0, 0), a2, voffA);
            PG8_WAIT_V(8); PG8_WAIT_L(0); PG8_BAR; PG8_MMA(1, 0, At, B0); PG8_MMA(1, 1, At, B1); PG8_BAR; PG8_SCHED;
            PG8_LDB(B0, 1, 0); PG8_LDB(B1, 1, 1); PG8_SCHED; PG8_LDA(At, 1, 0); PG8_STAGE(PG8_SA(0, 1), a2 + hstepA, voffA);
            PG8_WAIT_V(8); PG8_WAIT_L(0); PG8_BAR; PG8_MMA(0, 0, At, B0); PG8_MMA(0, 1, At, B1); PG8_BAR; PG8_SCHED;
            PG8_LDA(At, 1, 1); PG8_STAGE(PG8_SB(1, 0), b3, voffB); PG8_STAGE(PG8_SB(1, 1), b3 + hstepB, voffB); PG8_STAGE(PG8_SA(1, 0), a3, voffA);
            PG8_WAIT_V(8); PG8_WAIT_L(0); PG8_BAR; PG8_MMA(1, 0, At, B0); PG8_MMA(1, 1, At, B1); PG8_BAR; PG8_SCHED;
            } else {
            PG8_LDB(B0, 0, 0); PG8_SCHED; PG8_LDA(At, 0, 0); PG8_STAGE(PG8_SA(1, 1), a1 + hstepA, voffA);
            PG8_WAIT_L(8); PG8_BAR; PG8_WAIT_L(0); PG8_MMA(0, 0, At, B0); PG8_BAR; PG8_SCHED;
            PG8_LDB(B1, 0, 1); PG8_STAGE(PG8_SB(0, 0), b2, voffB);
            PG8_BAR; PG8_WAIT_L(0); PG8_MMA(0, 1, At, B1); PG8_BAR;
            PG8_LDA(At, 0, 1); PG8_STAGE(PG8_SA(0, 0), a2, voffA);
            PG8_BAR; PG8_WAIT_L(0); PG8_MMA(1, 0, At, B0); PG8_BAR; PG8_SCHED;
            PG8_STAGE(PG8_SB(0, 1), b2 + hstepB, voffB);
            PG8_WAIT_V(6); PG8_BAR; PG8_MMA(1, 1, At, B1); PG8_BAR;
            PG8_LDB(B0, 1, 0); PG8_SCHED; PG8_LDA(At, 1, 0); PG8_STAGE(PG8_SA(0, 1), a2 + hstepA, voffA);
            PG8_WAIT_L(8); PG8_BAR; PG8_WAIT_L(0); PG8_MMA(0, 0, At, B0); PG8_BAR; PG8_SCHED;
            PG8_LDB(B1, 1, 1); PG8_STAGE(PG8_SB(1, 0), b3, voffB);
            PG8_BAR; PG8_WAIT_L(0); PG8_MMA(0, 1, At, B1); PG8_BAR;
            PG8_LDA(At, 1, 1); PG8_STAGE(PG8_SA(1, 0), a3, voffA);
            PG8_BAR; PG8_WAIT_L(0); PG8_MMA(1, 0, At, B0); PG8_BAR; PG8_SCHED;
            PG8_STAGE(PG8_SB(1, 1), b3 + hstepB, voffB);
            PG8_WAIT_V(6); PG8_BAR; PG8_MMA(1, 1, At, B1); PG8_BAR;
            }
        }
        if constexpr (ALIGN_EPI) { if (wr == 0) PG8_BAR; }
        if constexpr (!Epi::AFTER_DRAIN) { E(acc, cur, wr, wc, fr, fq); S.done(cur); }
        if (!has_next) break;
#pragma unroll
        for (int a = 0; a < 2; ++a)
#pragma unroll
            for (int b = 0; b < 2; ++b)
#pragma unroll
                for (int m = 0; m < 4; ++m)
#pragma unroll
                    for (int n = 0; n < 2; ++n) acc[a][b][m][n] = (f32x4){0.f, 0.f, 0.f, 0.f};
        cur = nxt; cA = nA; cB = nB; ++ui;
        if constexpr (ALIGN_EPI) { if (wr == 1) PG8_BAR; }
    }
    PG8_WAIT_V(0);
    if constexpr (!ALIGN_EPI) { if (wr == 0) PG8_BAR; }
    PG8_BAR;
    if constexpr (Epi::AFTER_DRAIN) { E.fused(acc, cur, wr, wc, fr, fq, lds, wid, lane); S.done(cur); }
#undef PG8_SA
#undef PG8_SB
#undef PG8_STAGE
#undef PG8_LDA
#undef PG8_LDB
#undef PG8_LO
#undef PG8_HI
#undef PG8_MMA
#undef PG8_WAIT_V
#undef PG8_WAIT_L
#undef PG8_BAR
#undef PG8_SCHED
}
}
#define GAS __attribute__((address_space(1)))
#define LAS __attribute__((address_space(3)))
typedef unsigned short bf16;
typedef unsigned v4u __attribute__((ext_vector_type(4)));
typedef float f32x4 __attribute__((ext_vector_type(4)));
typedef short bf16x8 __attribute__((ext_vector_type(8)));
typedef GAS unsigned gu32;
typedef GAS unsigned long long gu64;
#define RLX_AGENT __ATOMIC_RELAXED, __HIP_MEMORY_SCOPE_AGENT
#define LDS_WAIT() asm volatile("s_waitcnt lgkmcnt(0)" ::: "memory")
#define VM_WAIT() asm volatile("s_waitcnt vmcnt(0)" ::: "memory")
__device__ __forceinline__ unsigned long long rt() { return __builtin_amdgcn_s_memrealtime(); }
__device__ __forceinline__ unsigned f2bf(float f) { unsigned u = __builtin_bit_cast(unsigned, f); return (u + 0x7fffu + ((u >> 16) & 1u)) >> 16; }
__device__ __forceinline__ unsigned pk2(float lo, float hi) { return f2bf(lo) | (f2bf(hi) << 16); }

#define XB_TMO      128
#define XB_XCNT(j)  (256  + 64 * (j))
#define XB_XSUB(j)  (1280 + 64 * (j))
#define XB_XGEN(j)  (2304 + 64 * (j))
#define XB_TOP      3328
#define XB_TOPGEN   3392
#define XCD_BAR_WORDS 3456
#define XB_SPIN_CAP (1u << 18)

__device__ __forceinline__ unsigned xb_ld(unsigned* p)              { return __hip_atomic_load(p, __ATOMIC_RELAXED, __HIP_MEMORY_SCOPE_AGENT); }
__device__ __forceinline__ unsigned xb_add(unsigned* p, unsigned v) { return __hip_atomic_fetch_add(p, v, __ATOMIC_RELAXED, __HIP_MEMORY_SCOPE_AGENT); }
__device__ __forceinline__ unsigned xb_xcc_id() { return (unsigned)__builtin_amdgcn_s_getreg((3 << 11) | 20) & 0xFu; }
#define XB_SPIN(cond, bar) do { unsigned _sp = 0; while (cond) { __builtin_amdgcn_s_sleep(1); \
    if ((++_sp & 255u) == 0u) { if (xb_ld(&(bar)[XB_TMO])) break; if (_sp > XB_SPIN_CAP) { atomicAdd(&(bar)[XB_TMO], 1u); break; } } } } while (0)

struct XcdBarrier {
    unsigned* bar; unsigned x;
    volatile LAS unsigned* st;
};

__device__ __forceinline__ XcdBarrier xcd_barrier_post(unsigned* bar, volatile LAS unsigned* st) {
    XcdBarrier b; b.bar = bar; b.x = xb_xcc_id(); b.st = st;
    if (threadIdx.x == 0) (void)xb_add(&bar[XB_XCNT(b.x)], 1u);
    return b;
}
__device__ __forceinline__ void xcd_barrier_complete(unsigned* bar, unsigned x, unsigned& nloc, unsigned& nx) {
    const unsigned G = gridDim.x * gridDim.y * gridDim.z;
    unsigned sum, cnt, mine, sp = 0u;
    for (;;) {
        sum = 0u; cnt = 0u; mine = 0u;
#pragma unroll
        for (unsigned j = 0; j < 16; ++j) { const unsigned c = xb_ld(&bar[XB_XCNT(j)]); sum += c; cnt += (c > 0u) ? 1u : 0u; mine = (j == x) ? c : mine; }
        if (sum == G) break;
        __builtin_amdgcn_s_sleep(1);
        if ((++sp & 255u) == 0u) { if (xb_ld(&bar[XB_TMO])) break; if (sp > XB_SPIN_CAP) { atomicAdd(&bar[XB_TMO], 1u); break; } }
    }
    nloc = mine > 0u ? mine : 1u; nx = cnt > 0u ? cnt : 1u;
}

__device__ __forceinline__ void xcd_barrier(const XcdBarrier& b) {
    asm volatile("s_waitcnt vmcnt(0)" ::: "memory");
    __syncthreads();
    if (threadIdx.x == 0) {
        unsigned* bar = b.bar;
        __builtin_amdgcn_s_waitcnt(0);
        unsigned nloc = b.st[0], nx = b.st[1];
        if (nloc == 0u) { xcd_barrier_complete(bar, b.x, nloc, nx); b.st[0] = nloc; b.st[1] = nx; }
        const unsigned old = xb_add(&bar[XB_XSUB(b.x)], 1u);
        const unsigned gen = old / nloc;
        if (old + 1u == (gen + 1u) * nloc) {
            __builtin_amdgcn_fence(__ATOMIC_RELEASE, "agent");
            asm volatile("s_waitcnt vmcnt(0)" ::: "memory");
            const unsigned og = xb_add(&bar[XB_TOP], 1u);
            const unsigned tg = og / nx;
            if (og + 1u == (tg + 1u) * nx) xb_add(&bar[XB_TOPGEN], 1u);
            else XB_SPIN(xb_ld(&bar[XB_TOPGEN]) == tg, bar);
            __builtin_amdgcn_fence(__ATOMIC_ACQUIRE, "agent");
            xb_add(&bar[XB_XGEN(b.x)], 1u);
            asm volatile("s_waitcnt vmcnt(0)" ::: "memory");
        } else {
            XB_SPIN(xb_ld(&bar[XB_XGEN(b.x)]) == gen, bar);
            __builtin_amdgcn_fence(__ATOMIC_ACQUIRE, "agent");
            asm volatile("s_waitcnt vmcnt(0)" ::: "memory");
        }
    }
    __syncthreads();
}

constexpr int NWAVES = 8, NTHR = 512;
constexpr int D = 4096, BATCH = 4, SEQ = 4096, M = BATCH * SEQ, MEML = 256, MROWS = BATCH * MEML, NIN = 14336;
constexpr int COL_DQ = 0, COL_DK = 2048, COL_DV = 4096, COL_HQ = 6144, COL_HF = 8192, COL_HI = 10240, COL_HG = 12288;
constexpr int NEXP = 16384, PEER_H = 8, PEER_K = 16, NSEL = PEER_H * PEER_K;
constexpr float EPS = 1e-6f, LOG2E = 1.4426950408889634f;
#ifndef Q8_INT
#define Q8_INT 1
#endif
constexpr float WIN_QS = Q8_INT ? 1344.0f : 2048.0f;
constexpr size_t MiB = 1u << 20;
constexpr size_t WS_CTL = 0, CTL_ZERO_BYTES = 1 * MiB;
constexpr size_t WS_SUBK = 1 * MiB;
constexpr size_t WS_XN = 2 * MiB;
constexpr size_t WS_WIN = 130 * MiB;
constexpr size_t WS_WOUT = 242 * MiB, WS_WCQ = 274 * MiB, WS_WCKV = 306 * MiB, WS_WCO = 370 * MiB, WS_WPQ = 402 * MiB;
constexpr size_t WS_PROJ = 418 * MiB;
constexpr size_t WS_H1F = WS_PROJ, WS_H1B = WS_PROJ + 256 * MiB, WS_PB = WS_PROJ + 384 * MiB;
constexpr size_t WS_MEMN = 866 * MiB, WS_KV = 874 * MiB, WS_WKP = 890 * MiB, WS_VP = 922 * MiB;
constexpr size_t WS_EIDX = 954 * MiB, WS_GATE = 962 * MiB, WS_HSSQ = 970 * MiB, WS_SSQ1 = 974 * MiB, WS_SSQ2 = 978 * MiB;
constexpr size_t WS_ATT = 982 * MiB;
constexpr size_t WS_DOWN = 1014 * MiB, WS_UP = 1078 * MiB, WS_WSEL = 1142 * MiB, WS_DSC = 1150 * MiB, WS_USC = 1151 * MiB, WS_END = 1152 * MiB;
constexpr size_t WS_SA2 = 1150 * MiB + 640 * 1024;
constexpr float KV_Q8 = 127.0f / 6.5f;
constexpr float MIX_CLIP = 8.0f, MIX_Q8 = 127.0f / MIX_CLIP;
constexpr size_t WS_XN8 = 1152 * MiB, WS_WIN8 = 1216 * MiB, WS_END2 = 1272 * MiB;
constexpr size_t WS_SA = 1150 * MiB + 512 * 1024;
constexpr int CW_AMAX = 8;
constexpr int CW_BAR = 4096;
constexpr int RING_BYTES = 131072, LDS_BYTES = 163840, LDSCTL_OFF = LDS_BYTES - 1024, MISC_OFF = LDSCTL_OFF + 320;

struct Args { const float* in[23]; float* out; unsigned char* ws; int ph_lo, ph_hi, use_bar, pad; };
struct Frame {
    LAS unsigned char* lds;
    volatile LAS unsigned* MISC;
    gu32* ctl;
    int tid, lane, wave, vcu, G;
    unsigned char* ws;
    const Args* ka;
    float* out;
};
__device__ __forceinline__ float bf2f(unsigned short b) { return __uint_as_float((unsigned)b << 16); }
__device__ __forceinline__ float bflo(unsigned w) { return __uint_as_float(w << 16); }
__device__ __forceinline__ float bfhi(unsigned w) { return __uint_as_float(w & 0xffff0000u); }
__device__ __forceinline__ float wave_sum(float v) {
#pragma unroll
    for (int o = 1; o < 64; o <<= 1) v += __shfl_xor(v, o);
    return v;
}
__device__ __forceinline__ void p0_transpose_item(const float* W, int K, int N, bf16* WT, const float* ks, LAS float* scr, int item, int lane) {
    const int nblk = N / 32, kb = item / nblk, nb = item % nblk, k0 = 64 * kb, n0 = 32 * nb;
#pragma unroll 8
    for (int i = 0; i < 32; ++i) { const int kk = 2 * i + (lane >> 5); float v = W[(size_t)(k0 + kk) * N + n0 + (lane & 31)]; if (ks) v *= ks[k0 + kk]; scr[kk * 33 + (lane & 31)] = v; }
    LDS_WAIT(); asm volatile("" ::: "memory");
    const int c = lane & 7;
#pragma unroll
    for (int j = 0; j < 4; ++j) { const int n = (lane >> 3) + 8 * j; const LAS float* s = scr + (8 * c) * 33 + n;
        v4u o; o.x = pk2(s[0 * 33], s[1 * 33]); o.y = pk2(s[2 * 33], s[3 * 33]); o.z = pk2(s[4 * 33], s[5 * 33]); o.w = pk2(s[6 * 33], s[7 * 33]);
        *(GAS v4u*)(WT + (size_t)(n0 + n) * K + k0 + 8 * c) = o; }
    LDS_WAIT(); asm volatile("" ::: "memory");
}
#ifndef FP8_SEGS
#define FP8_SEGS 0x7f
#endif
#ifndef Q8_INT
#define Q8_INT 1
#endif
__device__ __forceinline__ unsigned q8_pack4(float a, float b, float c, float d) {
    const int ia = (int)rintf(a), ib = (int)rintf(b), ic = (int)rintf(c), id = (int)rintf(d);
    return ((unsigned)ia & 255u) | (((unsigned)ib & 255u) << 8) | (((unsigned)ic & 255u) << 16) | ((unsigned)id << 24); }
__device__ __forceinline__ void p0_transpose_item_fp8(const float* W, int K, int N, unsigned char* WT, float qs, LAS float* scr, int item, int lane, const float* ks = nullptr) {
    const int nblk = N / 32, kb = item / nblk, nb = item % nblk, k0 = 64 * kb, n0 = 32 * nb;
    float wl_[32];
    { const float* wp_ = W + (size_t)(k0 + (lane >> 5)) * N + n0 + (lane & 31); const size_t st_ = (size_t)2 * N;
#pragma unroll
      for (int i = 0; i < 32; ++i) wl_[i] = wp_[i * st_]; }
    float kl_[32];
    if (ks) {
#pragma unroll
        for (int i = 0; i < 32; ++i) kl_[i] = ks[k0 + 2 * i + (lane >> 5)]; }
#pragma unroll
    for (int i = 0; i < 32; ++i) { const int kk = 2 * i + (lane >> 5); float wv_ = wl_[i] * qs; if (ks) wv_ *= kl_[i]; scr[kk * 33 + (lane & 31)] = __builtin_amdgcn_fmed3f(wv_, Q8_INT ? -127.0f : -448.0f, Q8_INT ? 127.0f : 448.0f); }
    LDS_WAIT(); asm volatile("" ::: "memory");
    const int c = lane & 3;
#pragma unroll
    for (int j = 0; j < 2; ++j) { const int n = (lane >> 2) + 16 * j; const LAS float* sp = scr + (16 * c) * 33 + n; v4u o; unsigned ow[4];
#pragma unroll
        for (int q = 0; q < 4; ++q) {
#if Q8_INT
            ow[q] = q8_pack4(sp[(4 * q) * 33], sp[(4 * q + 1) * 33], sp[(4 * q + 2) * 33], sp[(4 * q + 3) * 33]);
#else
            int w = __builtin_amdgcn_cvt_pk_fp8_f32(sp[(4 * q) * 33], sp[(4 * q + 1) * 33], 0, false); w = __builtin_amdgcn_cvt_pk_fp8_f32(sp[(4 * q + 2) * 33], sp[(4 * q + 3) * 33], w, true); ow[q] = (unsigned)w;
#endif
        }
        o.x = ow[0]; o.y = ow[1]; o.z = ow[2]; o.w = ow[3];
        *(GAS v4u*)(WT + (size_t)(n0 + n) * K + k0 + 16 * c) = o; }
    LDS_WAIT(); asm volatile("" ::: "memory");
}
__device__ __forceinline__ void row4096_norm_to_fp8(const float* src, const float* g, unsigned char* dst, bf16* dst16, float* sa_out, int lane) {
    const GAS f32x4* xr = (const GAS f32x4*)src + lane;
    f32x4 v[16]; float s = 0.f;
#pragma unroll
    for (int j = 0; j < 16; ++j) { v[j] = xr[64 * j]; s += (v[j].x * v[j].x + v[j].y * v[j].y) + (v[j].z * v[j].z + v[j].w * v[j].w); }
    const float r = __builtin_amdgcn_rsqf(wave_sum(s) * (1.f / 4096.f) + EPS);
    float am = 0.f;
#pragma unroll
    for (int j = 0; j < 16; ++j) { v[j] = v[j] * r * ((const GAS f32x4*)g)[64 * j + lane]; am = fmaxf(am, fmaxf(fmaxf(fabsf(v[j].x), fabsf(v[j].y)), fmaxf(fabsf(v[j].z), fabsf(v[j].w)))); }
#pragma unroll
    for (int o = 1; o < 64; o <<= 1) am = fmaxf(am, __shfl_xor(am, o));
    const float q = (am > 0.f) ? (Q8_INT ? 127.0f : 448.0f) / am : 1.0f;
    GAS unsigned* o4 = (GAS unsigned*)dst + lane; GAS unsigned long long* o8 = (GAS unsigned long long*)dst16 + lane;
#pragma unroll
    for (int j = 0; j < 16; ++j) {
#if Q8_INT
        o4[64 * j] = q8_pack4(v[j].x * q, v[j].y * q, v[j].z * q, v[j].w * q);
#else
        int w = __builtin_amdgcn_cvt_pk_fp8_f32(v[j].x * q, v[j].y * q, 0, false); w = __builtin_amdgcn_cvt_pk_fp8_f32(v[j].z * q, v[j].w * q, w, true); o4[64 * j] = (unsigned)w;
#endif
        if ((FP8_SEGS & 0x7f) != 0x7f) o8[64 * j] = (unsigned long long)pk2(v[j].x, v[j].y) | ((unsigned long long)pk2(v[j].z, v[j].w) << 32); }
    if (lane == 0) *sa_out = (am > 0.f) ? am * (1.0f / (Q8_INT ? 127.0f : 448.0f)) : 1.0f;
}
__device__ __forceinline__ void row4096_bf16_to_i8(const bf16* src, unsigned char* dst, float* sc_out, int lane) {
    typedef unsigned u32x2q __attribute__((ext_vector_type(2)));
    v4u v[8]; float am = 0.f;
#pragma unroll
    for (int j = 0; j < 8; ++j) { v[j] = *(const GAS v4u*)(src + 512 * j + 8 * lane);
        const unsigned wd[4] = {v[j].x, v[j].y, v[j].z, v[j].w};
#pragma unroll
        for (int e = 0; e < 4; ++e) am = fmaxf(am, fmaxf(fabsf(bflo(wd[e])), fabsf(bfhi(wd[e])))); }
#pragma unroll
    for (int o = 1; o < 64; o <<= 1) am = fmaxf(am, __shfl_xor(am, o));
    const float q = (am > 0.f) ? 127.0f / am : 1.0f;
#pragma unroll
    for (int j = 0; j < 8; ++j) { u32x2q o;
        o.x = q8_pack4(bflo(v[j].x) * q, bfhi(v[j].x) * q, bflo(v[j].y) * q, bfhi(v[j].y) * q); o.y = q8_pack4(bflo(v[j].z) * q, bfhi(v[j].z) * q, bflo(v[j].w) * q, bfhi(v[j].w) * q);
        *(GAS u32x2q*)(dst + 512 * j + 8 * lane) = o; }
    if (lane == 0) *sc_out = (am > 0.f) ? am * (1.0f / 127.0f) : 1.0f;
}
__device__ __forceinline__ void p0_absmax(Frame& F) {
    const GAS f32x4* W = (const GAS f32x4*)F.ka->in[3]; const size_t n4 = (size_t)D * NIN / 4, stride = (size_t)F.G * NTHR;
    float am = 0.f;
    for (size_t i = (size_t)F.vcu * NTHR + F.tid; i < n4; i += stride) { const f32x4 v = W[i]; am = fmaxf(am, fmaxf(fmaxf(fabsf(v.x), fabsf(v.y)), fmaxf(fabsf(v.z), fabsf(v.w)))); }
#pragma unroll
    for (int o = 1; o < 64; o <<= 1) am = fmaxf(am, __shfl_xor(am, o));
    if (F.lane == 0) (void)__hip_atomic_fetch_max((unsigned*)(F.ctl + CW_AMAX), __float_as_uint(am), __ATOMIC_RELAXED, __HIP_MEMORY_SCOPE_AGENT);
}
__device__ __forceinline__ void row4096_to_bf16(const float* src, bf16* dst, const float* g, float sc, int mode, int lane, unsigned char* dst8 = nullptr, float q8 = 0.f) {
    const GAS f32x4* xr = (const GAS f32x4*)src + lane;
    f32x4 v[16]; float s = 0.f;
#pragma unroll
    for (int j = 0; j < 16; ++j) { v[j] = xr[64 * j]; s += (v[j].x * v[j].x + v[j].y * v[j].y) + (v[j].z * v[j].z + v[j].w * v[j].w); }
    float r = sc;
    if (mode == 1) r = __builtin_amdgcn_rsqf(wave_sum(s) * (1.f / 4096.f) + EPS);
    GAS unsigned long long* o8 = (GAS unsigned long long*)dst + lane;
#pragma unroll
    for (int j = 0; j < 16; ++j) { f32x4 w = v[j] * r; if (mode == 1) w = w * ((const GAS f32x4*)g)[64 * j + lane];
        if (dst8) ((GAS unsigned*)dst8)[64 * j + lane] = pg8::pk_i8x4(w, q8);
        else o8[64 * j] = (unsigned long long)pk2(w.x, w.y) | ((unsigned long long)pk2(w.z, w.w) << 32); }
}
__device__ __forceinline__ void row4096_to_fp8(const float* src, unsigned char* dst, float* sc_out, int lane) {
    const GAS f32x4* xr = (const GAS f32x4*)src + lane;
    f32x4 v[16]; float am = 0.f;
#pragma unroll
    for (int j = 0; j < 16; ++j) { v[j] = xr[64 * j]; am = fmaxf(am, fmaxf(fmaxf(fabsf(v[j].x), fabsf(v[j].y)), fmaxf(fabsf(v[j].z), fabsf(v[j].w)))); }
#pragma unroll
    for (int o = 1; o < 64; o <<= 1) am = fmaxf(am, __shfl_xor(am, o));
    const float q = (am > 0.f) ? 448.0f / am : 1.0f;
    GAS unsigned* o4 = (GAS unsigned*)dst + lane;
#pragma unroll
    for (int j = 0; j < 16; ++j) { int w = __builtin_amdgcn_cvt_pk_fp8_f32(v[j].x * q, v[j].y * q, 0, false); w = __builtin_amdgcn_cvt_pk_fp8_f32(v[j].z * q, v[j].w * q, w, true); o4[64 * j] = (unsigned)w; }
    if (lane == 0) *sc_out = (am > 0.f) ? am * (1.0f / 448.0f) : 1.0f;
}
__device__ __forceinline__ void row4096_to_fp4(const float* src, unsigned char* dst, float* sc_out, int lane) {
    const GAS f32x4* xr = (const GAS f32x4*)src + lane;
    f32x4 v[16]; float am = 0.f;
#pragma unroll
    for (int j = 0; j < 16; ++j) { v[j] = xr[64 * j]; am = fmaxf(am, fmaxf(fmaxf(fabsf(v[j].x), fabsf(v[j].y)), fmaxf(fabsf(v[j].z), fabsf(v[j].w)))); }
#pragma unroll
    for (int o = 1; o < 64; o <<= 1) am = fmaxf(am, __shfl_xor(am, o));
    const float q = (am > 0.f) ? 6.0f / am : 1.0f;
    GAS unsigned short* o2 = (GAS unsigned short*)dst + lane;
#pragma unroll
    for (int j = 0; j < 16; ++j) { unsigned w = __builtin_amdgcn_cvt_scalef32_pk_fp4_f32(0u, v[j].x * q, v[j].y * q, 1.0f, 0); w = __builtin_amdgcn_cvt_scalef32_pk_fp4_f32(w, v[j].z * q, v[j].w * q, 1.0f, 1);
        o2[64 * j] = (unsigned short)w; }
    if (lane == 0) *sc_out = (am > 0.f) ? am * (1.0f / 6.0f) : 1.0f;
}
__device__ __forceinline__ unsigned pack_i8x4(float a, float b, float c, float d) {
    const int ia = (int)rintf(a), ib = (int)rintf(b), ic = (int)rintf(c), id = (int)rintf(d);
    return ((unsigned)ia & 255u) | (((unsigned)ib & 255u) << 8) | (((unsigned)ic & 255u) << 16) | ((unsigned)id << 24); }
__device__ __forceinline__ void row4096_to_i8(const float* src, unsigned char* dst, float* sc_out, int lane) {
    const GAS f32x4* xr = (const GAS f32x4*)src + lane;
    f32x4 v[16]; float am = 0.f;
#pragma unroll
    for (int j = 0; j < 16; ++j) { v[j] = xr[64 * j]; am = fmaxf(am, fmaxf(fmaxf(fabsf(v[j].x), fabsf(v[j].y)), fmaxf(fabsf(v[j].z), fabsf(v[j].w)))); }
#pragma unroll
    for (int o = 1; o < 64; o <<= 1) am = fmaxf(am, __shfl_xor(am, o));
    const float q = (am > 0.f) ? 127.0f / am : 1.0f;
    GAS unsigned* o4 = (GAS unsigned*)dst + lane;
#pragma unroll
    for (int j = 0; j < 16; ++j) o4[64 * j] = pack_i8x4(v[j].x * q, v[j].y * q, v[j].z * q, v[j].w * q);
    if (lane == 0) *sc_out = (am > 0.f) ? am * (1.0f / 127.0f) : 1.0f;
}
__device__ __forceinline__ void p0_prologue(Frame& F) {
    LAS float* scr = (LAS float*)(F.lds + F.wave * 16384);
    for (int r = F.vcu * NTHR + F.tid; r < M; r += F.G * NTHR) ((float*)(F.ws + WS_SA2))[r] = 1.0f / MIX_Q8;
    const int gw = F.vcu * NWAVES + F.wave, NGW = F.G * NWAVES;
    bf16* WS = (bf16*)F.ws;
    const float qs_in = WIN_QS;
    constexpr int I_IN = 64 * (NIN / 32), I_OUT = 64 * 128, I_CKV = 64 * 256, I_CO = 64 * 128, I_PQ = 64 * 64;
    constexpr int NITEMS = I_IN + I_OUT + I_CKV + I_CO + I_PQ;
    for (int it = gw; it < NITEMS; it += NGW) {
        int r = it;
        if (r < I_IN) { const int nb = r % (NIN / 32), kb = r / (NIN / 32), seg = nb >> 6;
            if ((FP8_SEGS >> seg) & 1) p0_transpose_item_fp8(F.ka->in[3], D, NIN, F.ws + WS_WIN8, qs_in, scr, kb * (NIN / 32) + nb, F.lane);
            else p0_transpose_item(F.ka->in[3], D, NIN, (bf16*)(F.ws + WS_WIN), nullptr, scr, kb * (NIN / 32) + nb, F.lane);
            continue; } r -= I_IN;
        if (r < I_OUT) { p0_transpose_item_fp8(F.ka->in[11], D, D, F.ws + WS_WOUT, WIN_QS, scr, r, F.lane); continue; } r -= I_OUT;
        if (r < I_CKV) { p0_transpose_item_fp8(F.ka->in[15], D, 2 * D, F.ws + WS_WCKV, WIN_QS, scr, r, F.lane); continue; } r -= I_CKV;
        if (r < I_CO) { p0_transpose_item_fp8(F.ka->in[16], D, D, F.ws + WS_WCO, WIN_QS, scr, r, F.lane); continue; } r -= I_CO;
        p0_transpose_item_fp8(F.ka->in[18], D, 2048, F.ws + WS_WPQ, WIN_QS, scr, r, F.lane, F.ka->in[17]);
    }
    (void)WS;
    constexpr int R_X = M, R_MEM = MROWS, R_CQ = D, R_DOWN = NEXP, R_UP = NEXP, R_SK = 64;
    constexpr int NROWS = R_X + R_MEM + R_CQ + R_DOWN + R_UP + R_SK;
    for (int it = gw; it < NROWS; it += NGW) {
        int r = it;
        if (r < R_X) { row4096_norm_to_fp8(F.ka->in[0] + (size_t)r * D, F.ka->in[2], F.ws + WS_XN8 + (size_t)r * D, (bf16*)(F.ws + WS_XN) + (size_t)r * D, (float*)(F.ws + WS_SA) + r, F.lane); continue; } r -= R_X;
        if (r < R_MEM) { row4096_to_bf16(F.ka->in[1] + (size_t)r * D, nullptr, F.ka->in[13], 1.f, 1, F.lane, F.ws + WS_MEMN + (size_t)r * D, KV_Q8); continue; } r -= R_MEM;
        if (r < R_CQ) { row4096_to_bf16(F.ka->in[14] + (size_t)r * D, nullptr, nullptr, F.ka->in[12][r], 0, F.lane, F.ws + WS_WCQ + (size_t)r * D, WIN_QS); continue; } r -= R_CQ;
        if (r < R_DOWN) { row4096_to_i8(F.ka->in[20] + (size_t)r * D, F.ws + WS_DOWN + (size_t)r * D, (float*)(F.ws + WS_DSC) + r, F.lane); continue; } r -= R_DOWN;
        if (r < R_UP) { row4096_to_fp4(F.ka->in[21] + (size_t)r * D, F.ws + WS_UP + (size_t)r * 2048, (float*)(F.ws + WS_USC) + r, F.lane); continue; }        r -= R_UP;
        row4096_to_bf16(F.ka->in[19] + (size_t)r * D, (bf16*)(F.ws + WS_SUBK) + (size_t)r * D, nullptr, 1.f, 0, F.lane);
    }
}

#define DPP_MUL(d, a, b, J) asm volatile("v_mul_f32_dpp %0, %1, %2 row_newbcast:" #J " row_mask:0xf bank_mask:0xf" : "=v"(d) : "v"(a), "v"(b))
#define DPP_FMAC(d, a, b, J) asm volatile("v_fmac_f32_dpp %0, %1, %2 row_newbcast:" #J " row_mask:0xf bank_mask:0xf" : "+v"(d) : "v"(a), "v"(b))
constexpr int HG_T = 32, HG_P = 36;
#define HG_STEP(QV, FV, KV, IV, TT) { float u0_, u1_, u2_, u3_, u4_, u5_, u6_, u7_, a0 = 0.f, a1 = 0.f; \
    asm volatile("s_nop 1\n\tv_mul_f32_dpp %0, %1, %2 row_newbcast:0 row_mask:0xf bank_mask:0xf" : "=v"(u0_) : "v"(FV), "v"(s[0]), "v"(QV), "v"(KV)); \
    DPP_MUL(u1_, FV, s[1], 1); DPP_MUL(u2_, FV, s[2], 2); DPP_MUL(u3_, FV, s[3], 3); DPP_MUL(u4_, FV, s[4], 4); DPP_MUL(u5_, FV, s[5], 5); DPP_MUL(u6_, FV, s[6], 6); DPP_MUL(u7_, FV, s[7], 7); \
    DPP_FMAC(u0_, KV, IV, 0); DPP_FMAC(u1_, KV, IV, 1); DPP_FMAC(u2_, KV, IV, 2); DPP_FMAC(u3_, KV, IV, 3); DPP_FMAC(u4_, KV, IV, 4); DPP_FMAC(u5_, KV, IV, 5); DPP_FMAC(u6_, KV, IV, 6); DPP_FMAC(u7_, KV, IV, 7); \
    DPP_FMAC(a0, QV, u0_, 0); DPP_FMAC(a1, QV, u1_, 1); DPP_FMAC(a0, QV, u2_, 2); DPP_FMAC(a1, QV, u3_, 3); DPP_FMAC(a0, QV, u4_, 4); DPP_FMAC(a1, QV, u5_, 5); DPP_FMAC(a0, QV, u6_, 6); DPP_FMAC(a1, QV, u7_, 7); \
    s[0] = u0_; s[1] = u1_; s[2] = u2_; s[3] = u3_; s[4] = u4_; s[5] = u5_; s[6] = u6_; s[7] = u7_; Pl[pslot + (TT) * 32] = a0 + a1; }
__device__ __forceinline__ void hgrn_unit(Frame& F, int b, int h, int vq) {
    const int tid = F.tid, lane = F.lane, w = F.wave;
    LAS float* Ql = (LAS float*)F.lds; LAS float* Fl = Ql + 128 * HG_P; LAS float* Kl = Fl + 128 * HG_P; LAS float* Il = Kl + 128 * HG_P; LAS float* Pl = Il + 32 * HG_P;
    const bf16* Pb = (const bf16*)(F.ws + WS_PROJ) + (size_t)b * SEQ * NIN;
    bf16* MIX = (bf16*)(F.ws + WS_XN); float* HSSQ = (float*)(F.ws + WS_HSSQ);
    const int lrow = tid & 31, lseg = tid >> 5;
    const bf16* qsrc = Pb + (size_t)lrow * NIN + COL_HQ + h * 128 + lseg * 8;
    const bf16* ksrc = Pb + (size_t)lrow * NIN + COL_HF + h * 128 + lseg * 8;
    const int iseg = (tid >> 5) & 3;
    const bf16* isrc = Pb + (size_t)lrow * NIN + COL_HI + h * 128 + vq * 32 + iseg * 8;
    float s[8];
#pragma unroll
    for (int j = 0; j < 8; ++j) s[j] = 0.f;
    v4u rq = *(const GAS v4u*)qsrc, rk = *(const GAS v4u*)ksrc, ri = (v4u){0u, 0u, 0u, 0u};
    if (tid < 128) ri = *(const GAS v4u*)isrc;
    const int idxq = (16 * w + 8 * (lane >> 5) + (lane & 7)) * HG_P, idxi = (lane & 31) * HG_P;
    const int pslot = (w * 2 + (lane >> 5)) * HG_T * 32 + (lane & 31);
    constexpr int NCH = SEQ / HG_T;
    __syncthreads();
    for (int c = 0; c < NCH; ++c) {
        {
            const unsigned qa[4] = {rq.x, rq.y, rq.z, rq.w}, ka[4] = {rk.x, rk.y, rk.z, rk.w}, ia[4] = {ri.x, ri.y, ri.z, ri.w};
            const int o = (lseg * 8) * HG_P + lrow;
#pragma unroll
            for (int j = 0; j < 4; ++j) { const float q0 = bflo(qa[j]), q1 = bfhi(qa[j]), k0 = bflo(ka[j]), k1 = bfhi(ka[j]);
                Ql[o + (2 * j) * HG_P] = q0; Ql[o + (2 * j + 1) * HG_P] = q1; Kl[o + (2 * j) * HG_P] = k0; Kl[o + (2 * j + 1) * HG_P] = k1; Fl[o + (2 * j) * HG_P] = 1.0f - k0; Fl[o + (2 * j + 1) * HG_P] = 1.0f - k1; }
            if (tid < 128) { const int oi = (iseg * 8) * HG_P + lrow;
#pragma unroll
                for (int j = 0; j < 4; ++j) { Il[oi + (2 * j) * HG_P] = bflo(ia[j]); Il[oi + (2 * j + 1) * HG_P] = bfhi(ia[j]); } }
        }
        if (c + 1 < NCH) { const size_t adv = (size_t)(c + 1) * HG_T * NIN; rq = *(const GAS v4u*)(qsrc + adv); rk = *(const GAS v4u*)(ksrc + adv); if (tid < 128) ri = *(const GAS v4u*)(isrc + adv); }
        __syncthreads();
        f32x4 qv = *(const LAS f32x4*)(Ql + idxq), fv = *(const LAS f32x4*)(Fl + idxq), kv = *(const LAS f32x4*)(Kl + idxq), iv = *(const LAS f32x4*)(Il + idxi);
#pragma unroll 2
        for (int t4 = 0; t4 < HG_T; t4 += 4) {
            const int tn = (t4 + 4 < HG_T) ? t4 + 4 : t4;
            const f32x4 qn = *(const LAS f32x4*)(Ql + idxq + tn), fn = *(const LAS f32x4*)(Fl + idxq + tn), kn = *(const LAS f32x4*)(Kl + idxq + tn), in_ = *(const LAS f32x4*)(Il + idxi + tn);
            HG_STEP(qv.x, fv.x, kv.x, iv.x, t4 + 0)
            HG_STEP(qv.y, fv.y, kv.y, iv.y, t4 + 1)
            HG_STEP(qv.z, fv.z, kv.z, iv.z, t4 + 2)
            HG_STEP(qv.w, fv.w, kv.w, iv.w, t4 + 3)
            qv = qn; fv = fn; kv = kn; iv = in_;
        }
        __syncthreads();
        {
            const int t = tid >> 4, vp = tid & 15; typedef float f32x2v __attribute__((ext_vector_type(2)));
            f32x2v o = {0.f, 0.f};
#pragma unroll
            for (int p = 0; p < 16; ++p) { const f32x2v x = *(LAS f32x2v*)(Pl + (p * HG_T + t) * 32 + 2 * vp); o += x; }
            const size_t grow = (size_t)b * SEQ + (size_t)c * HG_T + t;
            *(GAS unsigned*)(MIX + grow * D + 2048 + h * 128 + vq * 32 + 2 * vp) = pk2(o.x, o.y);
            float ss = o.x * o.x + o.y * o.y;
            ss += __shfl_xor(ss, 1); ss += __shfl_xor(ss, 2); ss += __shfl_xor(ss, 4); ss += __shfl_xor(ss, 8);
            if (vp == 0) HSSQ[grow * 64 + h * 4 + vq] = ss;
        }
    }
    __syncthreads();
}
#define DPPX(v, ctrl) __builtin_amdgcn_update_dpp(0, (v), (ctrl), 0xf, 0xf, false)
typedef short s16x4 __attribute__((ext_vector_type(4)));
#define MFMA16K16(a, b, c) __builtin_amdgcn_mfma_f32_16x16x16bf16_1k((a), (b), (c), 0, 0, 0)
#define MFMA16K32(a, b, c) __builtin_amdgcn_mfma_f32_16x16x32_bf16((a), (b), (c), 0, 0, 0)
constexpr int HM_P = 272;
constexpr int HM_NS = 4, HM_BLK = 39936;
__device__ __forceinline__ void hgrn_unit_mfma(Frame& F, int b, int h, int vq) {
    const int tid = F.tid, lane = F.lane, w = F.wave, l15 = lane & 15, kg = lane >> 4;
    const bf16* Pb = (const bf16*)(F.ws + WS_PROJ) + (size_t)b * SEQ * NIN;
    bf16* MIX = (bf16*)(F.ws + WS_XN); float* HSSQ = (float*)(F.ws + WS_HSSQ);
    const int lt = tid >> 5, ls = tid & 31;
    const bf16* qksrc = Pb + (size_t)lt * NIN + (ls < 16 ? COL_HQ : COL_HF) + h * 128 + (ls & 15) * 8;
    const bf16* isrc = Pb + (size_t)((tid >> 2) & 15) * NIN + COL_HI + h * 128 + vq * 32 + (tid & 3) * 8;
    v4u rqk[HM_NS], ri[HM_NS];
#pragma unroll
    for (int u = 0; u < HM_NS; ++u) { rqk[u] = *(const GAS v4u*)(qksrc + (size_t)u * 16 * NIN); ri[u] = (v4u){0u, 0u, 0u, 0u}; if (tid < 64) ri[u] = *(const GAS v4u*)(isrc + (size_t)u * 16 * NIN); }
    f32x4 S[2] = {(f32x4){0.f, 0.f, 0.f, 0.f}, (f32x4){0.f, 0.f, 0.f, 0.f}};
    constexpr int NIT = SEQ / (16 * HM_NS);
    __syncthreads();
    for (int c = 0; c < NIT; ++c) {
#pragma unroll
        for (int u = 0; u < HM_NS; ++u) { LAS unsigned char* L = F.lds + u * HM_BLK;
            *(LAS v4u*)((LAS unsigned short*)(L + (ls < 16 ? 0 : 4096)) + lt * 128 + (ls & 15) * 8) = rqk[u];
            if (tid < 64) *(LAS v4u*)((LAS unsigned short*)(L + 8192) + (tid >> 2) * 32 + (tid & 3) * 8) = ri[u]; }
        if (c + 1 < NIT) {
#pragma unroll
            for (int u = 0; u < HM_NS; ++u) { const size_t adv = (size_t)((c + 1) * HM_NS + u) * 16 * NIN; rqk[u] = *(const GAS v4u*)(qksrc + adv); if (tid < 64) ri[u] = *(const GAS v4u*)(isrc + adv); } }
        __syncthreads();
#pragma unroll
        for (int u = 0; u < HM_NS; ++u) {
            LAS unsigned char* L = F.lds + u * HM_BLK;
            LAS unsigned short* RAWQ = (LAS unsigned short*)L; LAS unsigned short* RAWK = (LAS unsigned short*)(L + 4096); LAS unsigned short* RAWI = (LAS unsigned short*)(L + 8192);
            LAS unsigned char* QT = L + 9216; LAS unsigned char* KT = L + 13568; LAS unsigned short* KH = (LAS unsigned short*)(L + 17920); LAS unsigned short* IT = (LAS unsigned short*)(L + 22016); LAS float* D16 = (LAS float*)(L + 23040);
            const int d = tid >> 2, tq = tid & 3;
            float qv[4], kv[4], cs[4]; float run = 0.f;
#pragma unroll
            for (int j = 0; j < 4; ++j) { const int t = 4 * tq + j; qv[j] = bf2f(RAWQ[t * 128 + d]); kv[j] = bf2f(RAWK[t * 128 + d]); run += __log2f(fmaxf(1.0f - kv[j], 1.0e-6f)); cs[j] = run; }
            const float t0 = __int_as_float(DPPX(__float_as_int(run), 0x00)), t1 = __int_as_float(DPPX(__float_as_int(run), 0x55)), t2 = __int_as_float(DPPX(__float_as_int(run), 0xAA)), t3 = __int_as_float(DPPX(__float_as_int(run), 0xFF));
            const float off = (tq > 0 ? t0 : 0.f) + (tq > 1 ? t1 : 0.f) + (tq > 2 ? t2 : 0.f), b16 = (t0 + t1) + (t2 + t3);
#pragma unroll
            for (int j = 0; j < 4; ++j) { const int t = 4 * tq + j; const float bt = off + cs[j];
                *(LAS unsigned short*)(QT + t * HM_P + d * 2) = (unsigned short)f2bf(qv[j] * __builtin_amdgcn_exp2f(bt));
                *(LAS unsigned short*)(KT + t * HM_P + d * 2) = (unsigned short)f2bf(kv[j] * __builtin_amdgcn_exp2f(-bt));
                KH[d * 16 + t] = (unsigned short)f2bf(kv[j] * __builtin_amdgcn_exp2f(b16 - bt)); }
            if (tq == 0) D16[d] = __builtin_amdgcn_exp2f(b16);
            IT[(tid & 31) * 16 + (tid >> 5)] = RAWI[(tid >> 5) * 32 + (tid & 31)];
        }
        __syncthreads();
#pragma unroll
        for (int u = 0; u < HM_NS; ++u) {
            LAS unsigned char* L = F.lds + u * HM_BLK;
            LAS unsigned char* QT = L + 9216; LAS unsigned char* KT = L + 13568; LAS unsigned short* KH = (LAS unsigned short*)(L + 17920); LAS unsigned short* IT = (LAS unsigned short*)(L + 22016); LAS float* D16 = (LAS float*)(L + 23040); LAS float* PART = (LAS float*)(L + 23552);
            typedef unsigned u32x2v __attribute__((ext_vector_type(2)));
            const s16x4 aq = *(const LAS s16x4*)(QT + l15 * HM_P + (16 * w + 4 * kg) * 2);
            const s16x4 bi0 = *(const LAS s16x4*)(IT + l15 * 16 + 4 * kg), bi1 = *(const LAS s16x4*)(IT + (16 + l15) * 16 + 4 * kg);
            f32x4 O0 = {0.f, 0.f, 0.f, 0.f}, O1 = O0;
            { const s16x4 bs0 = __builtin_bit_cast(s16x4, (u32x2v){pg8::cvt_pk_bf16(S[0][0], S[0][1]), pg8::cvt_pk_bf16(S[0][2], S[0][3])}), bs1 = __builtin_bit_cast(s16x4, (u32x2v){pg8::cvt_pk_bf16(S[1][0], S[1][1]), pg8::cvt_pk_bf16(S[1][2], S[1][3])});
              O0 = MFMA16K16(aq, bs0, O0); O1 = MFMA16K16(aq, bs1, O1); }
            if (w == u) {
                f32x4 at = {0.f, 0.f, 0.f, 0.f};
#pragma unroll
                for (int ks = 0; ks < 4; ++ks) { const bf16x8 ak = *(const LAS bf16x8*)(KT + l15 * HM_P + (32 * ks + 8 * kg) * 2), bq = *(const LAS bf16x8*)(QT + l15 * HM_P + (32 * ks + 8 * kg) * 2); at = MFMA16K32(ak, bq, at); }
#pragma unroll
                for (int r = 0; r < 4; ++r) if (4 * kg + r > l15) at[r] = 0.f;
                const s16x4 aA = __builtin_bit_cast(s16x4, (u32x2v){pg8::cvt_pk_bf16(at[0], at[1]), pg8::cvt_pk_bf16(at[2], at[3])});
                O0 = MFMA16K16(aA, bi0, O0); O1 = MFMA16K16(aA, bi1, O1);
            }
            LAS float* pp = PART + (w * 16 + 4 * kg) * 32 + l15;
#pragma unroll
            for (int r = 0; r < 4; ++r) { pp[r * 32] = O0[r]; pp[r * 32 + 16] = O1[r]; }
            const f32x4 d4 = *(const LAS f32x4*)(D16 + 16 * w + 4 * kg);
            const s16x4 akh = *(const LAS s16x4*)(KH + (16 * w + l15) * 16 + 4 * kg);
            S[0] = MFMA16K16(akh, bi0, S[0] * d4); S[1] = MFMA16K16(akh, bi1, S[1] * d4);
        }
        __syncthreads();
        {
            const int t = (tid >> 4) & 15, vp = tid & 15; typedef float f32x2v __attribute__((ext_vector_type(2)));
#pragma unroll
            for (int u = tid >> 8; u < HM_NS; u += 2) {
            const LAS float* PART = (const LAS float*)(F.lds + u * HM_BLK + 23552);
            f32x2v o = {0.f, 0.f};
#pragma unroll
            for (int p = 0; p < 8; ++p) { const f32x2v x = *(const LAS f32x2v*)(PART + (p * 16 + t) * 32 + 2 * vp); o += x; }
            const size_t grow = (size_t)b * SEQ + (size_t)(c * HM_NS + u) * 16 + t;
            *(GAS unsigned*)(MIX + grow * D + 2048 + h * 128 + vq * 32 + 2 * vp) = pk2(o.x, o.y);
            float ss = o.x * o.x + o.y * o.y;
            ss += __shfl_xor(ss, 1); ss += __shfl_xor(ss, 2); ss += __shfl_xor(ss, 4); ss += __shfl_xor(ss, 8);
            if (vp == 0) HSSQ[grow * 64 + h * 4 + vq] = ss;
            }
        }
    }
    __syncthreads();
}
#define HBAR() asm volatile("s_waitcnt lgkmcnt(0)\n\ts_barrier" ::: "memory")
constexpr int HH_NS = 4, HH_BLK = 37888;
__device__ __forceinline__ void hgrn_head_mfma(Frame& F, int b, int h) {
    const int tid = F.tid, lane = F.lane, w = F.wave, l15 = lane & 15, kg = lane >> 4;
    const bf16* Pb = (const bf16*)(F.ws + WS_PROJ) + (size_t)b * SEQ * NIN;
    bf16* MIX = (bf16*)(F.ws + WS_XN); const float* ng = F.ka->in[10];
    const int pp = tid & 255, pst = pp >> 4, psg = pp & 15;
    const bf16* qksrc = Pb + (size_t)pst * NIN + (tid < 256 ? COL_HQ : COL_HF) + h * 128 + psg * 8;
    const bf16* isrc = Pb + (size_t)pst * NIN + COL_HI + h * 128 + psg * 8;
    v4u rqk[HH_NS], ri[HH_NS];
#pragma unroll
    for (int u = 0; u < HH_NS; ++u) { rqk[u] = *(const GAS v4u*)(qksrc + (size_t)u * 16 * NIN); ri[u] = (v4u){0u, 0u, 0u, 0u}; if (tid < 256) ri[u] = *(const GAS v4u*)(isrc + (size_t)u * 16 * NIN); }
    f32x4 S[8];
#pragma unroll
    for (int j = 0; j < 8; ++j) S[j] = (f32x4){0.f, 0.f, 0.f, 0.f};
    f32x4 n0 = *(const GAS f32x4*)(ng + 8 * (tid & 15)), n1 = *(const GAS f32x4*)(ng + 8 * (tid & 15) + 4);
    asm volatile("" : "+v"(n0), "+v"(n1));
    constexpr int NIT = SEQ / (16 * HH_NS);
    __syncthreads();
    for (int c = 0; c < NIT; ++c) {
#pragma unroll
        for (int u = 0; u < HH_NS; ++u) { LAS unsigned char* L = F.lds + u * HH_BLK;
            *(LAS v4u*)((LAS unsigned short*)(L + (tid < 256 ? 0 : 4096)) + pst * 128 + psg * 8) = rqk[u];
            if (tid < 256) *(LAS v4u*)((LAS unsigned short*)(L + 8192) + pst * 128 + psg * 8) = ri[u]; }
#define HH_GLD(dst, ptr) asm volatile("global_load_dwordx4 %0, %1, off" : "=v"(dst) : "v"(ptr) : "memory")
        if (c + 1 < NIT) {
#pragma unroll
            for (int u = 0; u < HH_NS; ++u) { const size_t adv = (size_t)((c + 1) * HH_NS + u) * 16 * NIN; HH_GLD(rqk[u], qksrc + adv); if (tid < 256) HH_GLD(ri[u], isrc + adv); } }
        v4u gpre[2];
#pragma unroll
        for (int k = 0; k < 2; ++k) HH_GLD(gpre[k], Pb + ((size_t)(c * HH_NS + (tid >> 8) + 2 * k) * 16 + ((tid >> 4) & 15)) * NIN + COL_HG + h * 128 + 8 * (tid & 15));
#undef HH_GLD
        HBAR();
        {
            const int u = w >> 1, d = 64 * (w & 1) + lane;
            LAS unsigned char* L = F.lds + u * HH_BLK;
            LAS unsigned short* RAWQ = (LAS unsigned short*)L; LAS unsigned short* RAWK = (LAS unsigned short*)(L + 4096);
            LAS unsigned char* QT = L + 12288; LAS unsigned char* KT = L + 16640; LAS unsigned char* KHb = L + 20992; LAS float* D16 = (LAS float*)(L + 29184);
            float kv[16], cs[16]; float run = 0.f;
#pragma unroll
            for (int t = 0; t < 16; ++t) { kv[t] = bf2f(RAWK[t * 128 + d]); run += __log2f(fmaxf(1.0f - kv[t], 1.0e-6f)); cs[t] = run; }
            const float b16 = run;
            unsigned kh[8];
#pragma unroll
            for (int t = 0; t < 16; t += 2) {
                const float q0 = bf2f(RAWQ[t * 128 + d]), q1 = bf2f(RAWQ[(t + 1) * 128 + d]);
                *(LAS unsigned short*)(QT + t * HM_P + d * 2) = (unsigned short)f2bf(q0 * __builtin_amdgcn_exp2f(cs[t]));
                *(LAS unsigned short*)(QT + (t + 1) * HM_P + d * 2) = (unsigned short)f2bf(q1 * __builtin_amdgcn_exp2f(cs[t + 1]));
                *(LAS unsigned short*)(KT + t * HM_P + d * 2) = (unsigned short)f2bf(kv[t] * __builtin_amdgcn_exp2f(-cs[t]));
                *(LAS unsigned short*)(KT + (t + 1) * HM_P + d * 2) = (unsigned short)f2bf(kv[t + 1] * __builtin_amdgcn_exp2f(-cs[t + 1]));
                kh[t >> 1] = pk2(kv[t] * __builtin_amdgcn_exp2f(b16 - cs[t]), kv[t + 1] * __builtin_amdgcn_exp2f(b16 - cs[t + 1])); }
            *(LAS v4u*)(KHb + d * 32) = (v4u){kh[0], kh[1], kh[2], kh[3]}; *(LAS v4u*)(KHb + d * 32 + 16) = (v4u){kh[4], kh[5], kh[6], kh[7]};
            D16[d] = __builtin_amdgcn_exp2f(b16);
        }
        {
            const int u = tid >> 7, v = tid & 127;
            LAS unsigned char* L = F.lds + u * HH_BLK; LAS unsigned short* RAWI = (LAS unsigned short*)(L + 8192); LAS unsigned char* ITb = L + 25088;
            unsigned iw[8];
#pragma unroll
            for (int t = 0; t < 16; t += 2) iw[t >> 1] = (unsigned)RAWI[t * 128 + v] | ((unsigned)RAWI[(t + 1) * 128 + v] << 16);
            *(LAS v4u*)(ITb + v * 32) = (v4u){iw[0], iw[1], iw[2], iw[3]}; *(LAS v4u*)(ITb + v * 32 + 16) = (v4u){iw[4], iw[5], iw[6], iw[7]};
        }
        HBAR();
        typedef unsigned u32x2v __attribute__((ext_vector_type(2)));
        s16x4 aA[HH_NS];
#pragma unroll
        for (int u = 0; u < HH_NS; ++u) {
            LAS unsigned char* L = F.lds + u * HH_BLK; LAS unsigned char* QT = L + 12288; LAS unsigned char* KT = L + 16640;
            f32x4 at = {0.f, 0.f, 0.f, 0.f};
#pragma unroll
            for (int ks = 0; ks < 4; ++ks) { const bf16x8 ak = *(const LAS bf16x8*)(KT + l15 * HM_P + (32 * ks + 8 * kg) * 2), bq = *(const LAS bf16x8*)(QT + l15 * HM_P + (32 * ks + 8 * kg) * 2); at = MFMA16K32(ak, bq, at); }
#pragma unroll
            for (int r = 0; r < 4; ++r) if (4 * kg + r > l15) at[r] = 0.f;
            aA[u] = __builtin_bit_cast(s16x4, (u32x2v){pg8::cvt_pk_bf16(at[0], at[1]), pg8::cvt_pk_bf16(at[2], at[3])});
        }
#pragma unroll
        for (int u = 0; u < HH_NS; ++u) {
            LAS unsigned char* L = F.lds + u * HH_BLK;
            LAS unsigned char* QT = L + 12288; LAS unsigned short* KH = (LAS unsigned short*)(L + 20992); LAS unsigned short* IT = (LAS unsigned short*)(L + 25088); LAS float* D16 = (LAS float*)(L + 29184); LAS float* OUT = (LAS float*)(L + 29696);
            const s16x4 bi = *(const LAS s16x4*)(IT + (16 * w + l15) * 16 + 4 * kg);
            f32x4 O0 = {0.f, 0.f, 0.f, 0.f}, O1 = O0;
            O1 = MFMA16K16(aA[u], bi, O1);
#pragma unroll
            for (int j = 0; j < 8; j += 2) {
                const s16x4 aq0 = *(const LAS s16x4*)(QT + l15 * HM_P + (16 * j + 4 * kg) * 2), aq1 = *(const LAS s16x4*)(QT + l15 * HM_P + (16 * (j + 1) + 4 * kg) * 2);
                const s16x4 bs0 = __builtin_bit_cast(s16x4, (u32x2v){pg8::cvt_pk_bf16(S[j][0], S[j][1]), pg8::cvt_pk_bf16(S[j][2], S[j][3])});
                const s16x4 bs1 = __builtin_bit_cast(s16x4, (u32x2v){pg8::cvt_pk_bf16(S[j + 1][0], S[j + 1][1]), pg8::cvt_pk_bf16(S[j + 1][2], S[j + 1][3])});
                O0 = MFMA16K16(aq0, bs0, O0); O1 = MFMA16K16(aq1, bs1, O1); }
            const f32x4 O = O0 + O1;
            LAS float* op = OUT + (4 * kg) * 128 + 16 * w + l15;
#pragma unroll
            for (int r = 0; r < 4; ++r) op[r * 128] = O[r];
#pragma unroll
            for (int j = 0; j < 8; ++j) { const f32x4 d4 = *(const LAS f32x4*)(D16 + 16 * j + 4 * kg);
                const s16x4 akh = *(const LAS s16x4*)(KH + (16 * j + l15) * 16 + 4 * kg);
                S[j] = MFMA16K16(akh, bi, S[j] * d4); }
        }
        HBAR();
        asm volatile("s_waitcnt vmcnt(0)" ::: "memory");
        {
            const int t = (tid >> 4) & 15, vs = tid & 15;
#pragma unroll
            for (int k = 0; k < 2; ++k) { const int u = (tid >> 8) + 2 * k;
                const LAS float* OUT = (const LAS float*)(F.lds + u * HH_BLK + 29696);
                const size_t grow = (size_t)b * SEQ + (size_t)(c * HH_NS + u) * 16 + t;
                const v4u g = gpre[k];
                const f32x4 o0 = *(const LAS f32x4*)(OUT + t * 128 + 8 * vs), o1 = *(const LAS f32x4*)(OUT + t * 128 + 8 * vs + 4);
                float ss = ((o0.x * o0.x + o0.y * o0.y) + (o0.z * o0.z + o0.w * o0.w)) + ((o1.x * o1.x + o1.y * o1.y) + (o1.z * o1.z + o1.w * o1.w));
                ss += __shfl_xor(ss, 1); ss += __shfl_xor(ss, 2); ss += __shfl_xor(ss, 4); ss += __shfl_xor(ss, 8);
                const float rstd = __builtin_amdgcn_rsqf(ss * (1.f / 128.f) + EPS);
                typedef unsigned u32x2m __attribute__((ext_vector_type(2))); u32x2m r;
                r.x = pg8::pk_i8x4((f32x4){o0.x * rstd * n0.x * bflo(g.x), o0.y * rstd * n0.y * bfhi(g.x), o0.z * rstd * n0.z * bflo(g.y), o0.w * rstd * n0.w * bfhi(g.y)}, MIX_Q8);
                r.y = pg8::pk_i8x4((f32x4){o1.x * rstd * n1.x * bflo(g.z), o1.y * rstd * n1.y * bfhi(g.z), o1.z * rstd * n1.z * bflo(g.w), o1.w * rstd * n1.w * bfhi(g.w)}, MIX_Q8);
                *(GAS u32x2m*)(F.ws + WS_XN8 + grow * D + 2048 + h * 128 + 8 * vs) = r;
            }
        }
    }
    __syncthreads();
}
__device__ __forceinline__ void hgrn_fixup(Frame& F) {
    bf16* MIX = (bf16*)(F.ws + WS_XN); const float* HSSQ = (const float*)(F.ws + WS_HSSQ); const bf16* PROJ = (const bf16*)(F.ws + WS_PROJ); const float* ng = F.ka->in[10];
    const size_t total = (size_t)M * 256, stride = (size_t)F.G * NTHR;
    for (size_t idx = (size_t)F.vcu * NTHR + F.tid; idx < total; idx += stride) {
        const size_t row = idx >> 8; const int cg = (int)(idx & 255), hh = cg >> 4, col = cg * 8;
        const f32x4 q = *(const GAS f32x4*)(HSSQ + row * 64 + hh * 4);
        const float rstd = __builtin_amdgcn_rsqf(((q.x + q.y) + (q.z + q.w)) * (1.f / 128.f) + EPS);
        const v4u o = *(const GAS v4u*)(MIX + row * D + 2048 + col), g = *(const GAS v4u*)(PROJ + row * NIN + COL_HG + col);
        const f32x4 n0 = *(const GAS f32x4*)(ng + (col & 127)), n1 = *(const GAS f32x4*)(ng + (col & 127) + 4);
        v4u r;
        r.x = pk2(bflo(o.x) * rstd * n0.x * bflo(g.x), bfhi(o.x) * rstd * n0.y * bfhi(g.x)); r.y = pk2(bflo(o.y) * rstd * n0.z * bflo(g.y), bfhi(o.y) * rstd * n0.w * bfhi(g.y));
        r.z = pk2(bflo(o.z) * rstd * n1.x * bflo(g.z), bfhi(o.z) * rstd * n1.y * bfhi(g.z)); r.w = pk2(bflo(o.w) * rstd * n1.z * bflo(g.w), bfhi(o.w) * rstd * n1.w * bfhi(g.w));
        *(GAS v4u*)(MIX + row * D + 2048 + col) = r;
    }
}
typedef float f32x16 __attribute__((ext_vector_type(16)));
typedef short v4i16_t __attribute__((ext_vector_type(4)));
#define MFMA32(a, b, c) __builtin_amdgcn_mfma_f32_32x32x16_bf16((a), (b), (c), 0, 0, 0)
__device__ __forceinline__ int crow(int i, int hh) { return (i & 3) + 8 * (i >> 2) + 4 * hh; }
__device__ __forceinline__ float xhalf_max(float m) { auto rr = __builtin_amdgcn_permlane32_swap(__float_as_uint(m), __float_as_uint(m), false, false); return fmaxf(__uint_as_float(rr[0]), __uint_as_float(rr[1])); }
__device__ __forceinline__ float xhalf_sum(float m) { auto rr = __builtin_amdgcn_permlane32_swap(__float_as_uint(m), __float_as_uint(m), false, false); return __uint_as_float(rr[0]) + __uint_as_float(rr[1]); }
constexpr int AT_KP = 144, AT_VP = 320, AT_KB = 64 * AT_KP, AT_VB = 64 * AT_VP, AT_VOFF = 2 * AT_KB, AT_AOFF = AT_VOFF + 2 * AT_VB;
__device__ __forceinline__ void attn_unit(Frame& F, int b, int h, int qb, float lam) {
    const int tid = F.tid, lane = F.lane, w = F.wave, r = lane & 31, hh = lane >> 5;
    const bf16* Pb = (const bf16*)(F.ws + WS_PROJ) + (size_t)b * SEQ * NIN;
    LAS unsigned char* Kl = F.lds; LAS unsigned char* Vl = F.lds + AT_VOFF; LAS float* Al = (LAS float*)(F.lds + AT_AOFF) + w * 32;
    const int q0 = qb * 256 + w * 32, qpos = q0 + r;
    const float cs = exp2f(-0.5f * (float)(h + 1)) * LOG2E;
    const int NT = 4 * (qb + 1);
    float* scr = (float*)(F.ws + WS_ATT) + (size_t)blockIdx.x * 32768;
    const int i16 = lane & 15, q4 = i16 >> 2, p4 = i16 & 3, g16 = (lane >> 4) & 1;
    const int vrd = (4 * hh + q4) * AT_VP + 32 * g16 + 8 * p4;
    f32x16 O[4];
    for (int c = 0; c < 2; ++c) {
        bf16x8 qf[4];
#pragma unroll
        for (int s = 0; s < 4; ++s) qf[s] = *(const GAS bf16x8*)(Pb + (size_t)qpos * NIN + COL_DQ + h * 128 + c * 64 + 16 * s + 8 * hh);
#pragma unroll
        for (int d = 0; d < 4; ++d)
#pragma unroll
            for (int i = 0; i < 16; ++i) O[d][i] = 0.f;
        float mrun = -1.0e30f, lrun = 0.f;
        const int krow = tid >> 3, kseg = tid & 7, vrow = tid >> 4, vseg = tid & 15;
        const unsigned koff = (unsigned)(krow * NIN + kseg * 8) * 2u, voff = (unsigned)(vrow * NIN + vseg * 8) * 2u;
        const char* kbase = (const char*)(Pb + COL_DK + h * 128 + c * 64); const char* vbase = (const char*)(Pb + COL_DV + h * 128);
        const int kdst = krow * AT_KP + kseg * 16, vdst = vrow * AT_VP + vseg * 16;
        v4u rkA, rv0A, rv1A, rkB, rv0B, rv1B;
#define AT_LD(S, TT) do { const size_t adv_ = (size_t)(TT) * 64 * NIN * 2; const char* kb2_ = kbase + adv_; const char* vb2_ = vbase + adv_; rk##S = *(const GAS v4u*)(kb2_ + koff); rv0##S = *(const GAS v4u*)(vb2_ + voff); rv1##S = *(const GAS v4u*)(vb2_ + (size_t)32 * NIN * 2 + voff); } while (0)
#define AT_ST(S, BB) do { *(LAS v4u*)(Kl + (BB) * AT_KB + kdst) = rk##S; *(LAS v4u*)(Vl + (BB) * AT_VB + vdst) = rv0##S; *(LAS v4u*)(Vl + (BB) * AT_VB + vdst + 32 * AT_VP) = rv1##S; } while (0)
        AT_LD(A, NT - 1);
        AT_LD(B, NT - 2);
        __syncthreads();
        AT_ST(A, 0);
        __syncthreads();
#define AT_ITER(IT, SLD, SST) do { const int it = (IT); \
            const int t = NT - 1 - it, buf = it & 1; \
            if (it + 2 < NT) AT_LD(SLD, t - 2); \
            if (64 * t <= q0 + 31) { \
                f32x16 st[2]; \
            _Pragma("unroll") \
                for (int nb = 0; nb < 2; ++nb) { \
            _Pragma("unroll") \
                    for (int i = 0; i < 16; ++i) st[nb][i] = 0.f; \
            _Pragma("unroll") \
                    for (int s = 0; s < 4; ++s) { const bf16x8 kf = *(const LAS bf16x8*)(Kl + buf * AT_KB + (32 * nb + r) * AT_KP + (16 * s + 8 * hh) * 2); st[nb] = MFMA32(kf, qf[s], st[nb]); } \
                } \
                const bool band = (64 * t + 63 > q0); \
                float cs_ = cs; asm volatile("" : "+v"(cs_)); \
                const float basev = cs_ * (float)(64 * t - qpos + 4 * hh); \
                float mx = -3.0e38f; \
                if (band) { \
                    const int thr = qpos - 64 * t - 4 * hh; \
            _Pragma("unroll") \
                    for (int nb = 0; nb < 2; ++nb) \
            _Pragma("unroll") \
                        for (int i = 0; i < 16; ++i) { const int kc = 32 * nb + (i & 3) + 8 * (i >> 2); float v = fmaf(cs_, (float)kc, st[nb][i]); \
                            if (kc > thr) v = -1.0e30f; st[nb][i] = v; mx = fmaxf(mx, v); } \
                } else { \
            _Pragma("unroll") \
                    for (int nb = 0; nb < 2; ++nb) \
            _Pragma("unroll") \
                        for (int i = 0; i < 16; ++i) { const int kc = 32 * nb + (i & 3) + 8 * (i >> 2); const float v = fmaf(cs_, (float)kc, st[nb][i]); st[nb][i] = v; mx = fmaxf(mx, v); } \
                } \
                const float mxt = xhalf_max(mx + basev); \
                if (__builtin_amdgcn_ballot_w64(mxt > mrun + 8.0f) != 0ull) { \
                    const float mnew = fmaxf(mrun, mxt), alpha = __builtin_amdgcn_exp2f(mrun - mnew); mrun = mnew; lrun *= alpha; \
                    if (hh == 0) Al[r] = alpha; \
                    f32x4 a4[4]; \
            _Pragma("unroll") \
                    for (int g = 0; g < 4; ++g) a4[g] = *(const LAS f32x4*)(Al + 8 * g + 4 * hh); \
            _Pragma("unroll") \
                    for (int d = 0; d < 4; ++d) \
            _Pragma("unroll") \
                        for (int i = 0; i < 16; ++i) O[d][i] *= a4[i >> 2][i & 3]; \
                } \
                const float mref = mrun - basev; \
                float rs = 0.f; \
            _Pragma("unroll") \
                for (int nb = 0; nb < 2; ++nb) \
            _Pragma("unroll") \
                    for (int i = 0; i < 16; ++i) { const float p = __builtin_amdgcn_exp2f(st[nb][i] - mref); st[nb][i] = p; rs += p; } \
                rs = xhalf_sum(rs); lrun += rs; \
            _Pragma("unroll") \
                for (int nb = 0; nb < 2; ++nb) \
            _Pragma("unroll") \
                    for (int s2 = 0; s2 < 2; ++s2) { \
                        v4u pw; pw.x = pg8::cvt_pk_bf16(st[nb][8 * s2 + 0], st[nb][8 * s2 + 1]); pw.y = pg8::cvt_pk_bf16(st[nb][8 * s2 + 2], st[nb][8 * s2 + 3]); \
                        pw.z = pg8::cvt_pk_bf16(st[nb][8 * s2 + 4], st[nb][8 * s2 + 5]); pw.w = pg8::cvt_pk_bf16(st[nb][8 * s2 + 6], st[nb][8 * s2 + 7]); \
                        const bf16x8 pf = __builtin_bit_cast(bf16x8, pw); \
                        const LAS unsigned char* vb = Vl + buf * AT_VB + (32 * nb + 16 * s2) * AT_VP + vrd; \
            _Pragma("unroll") \
                        for (int d = 0; d < 4; ++d) { \
                            const v4i16_t lo = __builtin_amdgcn_ds_read_tr16_b64_v4i16((LAS v4i16_t*)(vb + d * 64)), hi = __builtin_amdgcn_ds_read_tr16_b64_v4i16((LAS v4i16_t*)(vb + d * 64 + 8 * AT_VP)); \
                            const bf16x8 vf = __builtin_shufflevector(lo, hi, 0, 1, 2, 3, 4, 5, 6, 7); \
                            O[d] = MFMA32(pf, vf, O[d]); \
                        } \
                    } \
            } \
            if (it + 1 < NT) AT_ST(SST, buf ^ 1); \
            HBAR(); } while (0)
#pragma unroll 1
        for (int it2 = 0; it2 < NT; it2 += 2) { AT_ITER(it2, A, B); AT_ITER(it2 + 1, B, A); }
#undef AT_ITER
#undef AT_LD
#undef AT_ST
        if (hh == 0) Al[r] = 1.0f / lrun;
        f32x4 a4[4];
#pragma unroll
        for (int g = 0; g < 4; ++g) a4[g] = *(const LAS f32x4*)(Al + 8 * g + 4 * hh);
        float* sp = scr + tid * 64; asm volatile("" : "+v"(sp));
        if (c == 0) {
#pragma unroll
            for (int d = 0; d < 4; ++d)
#pragma unroll
                for (int g = 0; g < 4; ++g) *(GAS f32x4*)(sp + d * 16 + 4 * g) = (f32x4){O[d][4 * g], O[d][4 * g + 1], O[d][4 * g + 2], O[d][4 * g + 3]} * a4[g];
        } else {
            asm volatile("s_waitcnt vmcnt(0)" ::: "memory");
#pragma unroll
            for (int d = 0; d < 4; ++d)
#pragma unroll
                for (int g = 0; g < 4; ++g) { const f32x4 o0 = *(const GAS f32x4*)(sp + d * 16 + 4 * g);
#pragma unroll
                    for (int j = 0; j < 4; ++j) O[d][4 * g + j] = o0[j] - lam * (O[d][4 * g + j] * a4[g][j]); }
        }
    }
    const float* sg = F.ka->in[8]; bf16* MIX = (bf16*)(F.ws + WS_XN);
    float gcol[4];
#pragma unroll
    for (int d = 0; d < 4; ++d) gcol[d] = sg[d * 32 + r] * 0.8f;
    unsigned char* obase = F.ws + WS_XN8 + ((size_t)b * SEQ + q0 + 4 * hh) * D + h * 128 + r; asm volatile("" : "+v"(obase));
#pragma unroll
    for (int i = 0; i < 16; ++i) {
        float p = (O[0][i] * O[0][i] + O[1][i] * O[1][i]) + (O[2][i] * O[2][i] + O[3][i] * O[3][i]);
        p += __shfl_xor(p, 1); p += __shfl_xor(p, 2); p += __shfl_xor(p, 4); p += __shfl_xor(p, 8); p += __shfl_xor(p, 16);
        const float rstd = __builtin_amdgcn_rsqf(p * (1.f / 128.f) + EPS);
        unsigned char* orow = obase + (size_t)((i & 3) + 8 * (i >> 2)) * D;
#pragma unroll
        for (int d = 0; d < 4; ++d) orow[d * 32] = (unsigned char)(int)rintf(__builtin_amdgcn_fmed3f(O[d][i] * rstd * gcol[d] * MIX_Q8, -127.f, 127.f));
    }
}
__device__ __forceinline__ int row16_max_i(int x) {
    x = max(x, DPPX(x, 0xB1)); x = max(x, DPPX(x, 0x4E)); x = max(x, DPPX(x, 0x141)); x = max(x, DPPX(x, 0x140)); return x; }
__device__ __forceinline__ float row16_sum_f(float x) {
    x += __int_as_float(DPPX(__float_as_int(x), 0xB1)); x += __int_as_float(DPPX(__float_as_int(x), 0x4E)); x += __int_as_float(DPPX(__float_as_int(x), 0x141)); x += __int_as_float(DPPX(__float_as_int(x), 0x140)); return x; }
__device__ __forceinline__ int f2sort(float f) { const int b = __float_as_int(f); return b ^ ((b >> 31) & 0x7fffffff); }
__device__ __forceinline__ float sort2f(int k) { return __int_as_float(k ^ ((k >> 31) & 0x7fffffff)); }
__device__ __forceinline__ void topk_phase(Frame& F) {
    const int tid = F.tid, lane = F.lane, w = F.wave, r = lane & 31, hh = lane >> 5, g16 = tid >> 4, l16 = tid & 15;
    LAS float* Sl = (LAS float*)F.lds;
    LAS float* SV = (LAS float*)(F.lds + 65536);
    LAS int* SI = (LAS int*)(F.lds + 65536 + 8192);
    const bf16* QP = (const bf16*)(F.ws + WS_WIN); const bf16* SUBK = (const bf16*)(F.ws + WS_SUBK);
    int* EIDX = (int*)(F.ws + WS_EIDX); float* GATE = (float*)(F.ws + WS_GATE);
#define TK_GLD(dst, ptr, off) asm volatile("global_load_dwordx4 %0, %1, off offset:" #off : "=v"(dst) : "v"(ptr) : "memory")
#define TK_LOADS(itx) do { const int head_ = (itx) & 7, tile_ = (itx) >> 3; \
        const bf16* Q_ = QP + (size_t)(tile_ * 64 + r) * 2048 + head_ * 256 + (w >> 2) * 128 + 8 * hh; const bf16* Q1_ = Q_ + (size_t)32 * 2048; \
        const bf16* SK_ = SUBK + ((size_t)(head_ * 2 + (w >> 2)) * 128 + 32 * (w & 3) + r) * 128 + 8 * hh; \
        TK_GLD(kf[0], SK_, 0); TK_GLD(q0[0], Q_, 0); TK_GLD(q1[0], Q1_, 0); TK_GLD(kf[1], SK_, 32); TK_GLD(q0[1], Q_, 32); TK_GLD(q1[1], Q1_, 32); \
        TK_GLD(kf[2], SK_, 64); TK_GLD(q0[2], Q_, 64); TK_GLD(q1[2], Q1_, 64); TK_GLD(kf[3], SK_, 96); TK_GLD(q0[3], Q_, 96); TK_GLD(q1[3], Q1_, 96); \
        TK_GLD(kf[4], SK_, 128); TK_GLD(q0[4], Q_, 128); TK_GLD(q1[4], Q1_, 128); TK_GLD(kf[5], SK_, 160); TK_GLD(q0[5], Q_, 160); TK_GLD(q1[5], Q1_, 160); \
        TK_GLD(kf[6], SK_, 192); TK_GLD(q0[6], Q_, 192); TK_GLD(q1[6], Q1_, 192); TK_GLD(kf[7], SK_, 224); TK_GLD(q0[7], Q_, 224); TK_GLD(q1[7], Q1_, 224); } while (0)
    bf16x8 kf[8], q0[8], q1[8];
    if (F.vcu < (M / 64) * PEER_H) TK_LOADS(F.vcu);
    for (int it = F.vcu; it < (M / 64) * PEER_H; it += F.G) {
        const int head = it & 7, tile = it >> 3;
        {
            const int c = w >> 2, kb = w & 3;
            f32x16 acc[2];
#pragma unroll
            for (int i = 0; i < 16; ++i) { acc[0][i] = 0.f; acc[1][i] = 0.f; }
            asm volatile("s_waitcnt vmcnt(0)" ::: "memory");
#pragma unroll
            for (int s = 0; s < 8; ++s) asm volatile("" : "+v"(kf[s]), "+v"(q0[s]), "+v"(q1[s]));
#pragma unroll
            for (int s = 0; s < 8; ++s) { acc[0] = MFMA32(q0[s], kf[s], acc[0]); acc[1] = MFMA32(q1[s], kf[s], acc[1]); }
            HBAR();
#pragma unroll
            for (int tb = 0; tb < 2; ++tb)
#pragma unroll
                for (int i = 0; i < 16; ++i) Sl[(32 * tb + crow(i, hh)) * 256 + c * 128 + 32 * kb + r] = acc[tb][i];
            if (it + F.G < (M / 64) * PEER_H) TK_LOADS(it + F.G);
        }
        HBAR();
#pragma unroll 1
        for (int rd = 0; rd < 4; ++rd) {
            const int row = rd * 32 + g16, tok = row >> 1, c = row & 1;
            int key[8];
#pragma unroll
            for (int s = 0; s < 8; ++s) { const int idx = s * 16 + l16; key[s] = (f2sort(Sl[tok * 256 + c * 128 + idx]) & ~127) | (127 - idx); }
#define TK_CE(i, j) do { const int hi_ = max(key[i], key[j]), lo_ = min(key[i], key[j]); key[i] = hi_; key[j] = lo_; } while (0)
            TK_CE(0, 1); TK_CE(2, 3); TK_CE(4, 5); TK_CE(6, 7); TK_CE(0, 2); TK_CE(1, 3); TK_CE(4, 6); TK_CE(5, 7); TK_CE(1, 2); TK_CE(5, 6); TK_CE(0, 4); TK_CE(3, 7);
            TK_CE(1, 5); TK_CE(2, 6); TK_CE(1, 4); TK_CE(3, 6); TK_CE(2, 4); TK_CE(3, 5); TK_CE(3, 4);
#undef TK_CE
            int mine = 0;
#pragma unroll 1
            for (int k = 0; k < 16; ++k) {
                const int m = row16_max_i(key[0]);
                if (l16 == k) mine = m;
                const bool pop = (key[0] == m);
#pragma unroll
                for (int s = 0; s < 7; ++s) key[s] = pop ? key[s + 1] : key[s];
                key[7] = pop ? (int)0x80000000 : key[7];
            }
            SV[(tok * 2 + c) * 16 + l16] = sort2f(mine & ~127); SI[(tok * 2 + c) * 16 + l16] = 127 - (mine & 127);
        }
        HBAR();
#pragma unroll 1
        for (int rd = 0; rd < 2; ++rd) {
            const int tok = rd * 32 + g16;
            const float sv0 = SV[(tok * 2) * 16 + l16];
            int ptr = 0;
            int key = (f2sort(sv0 + SV[(tok * 2 + 1) * 16]) & ~255) | (255 - (l16 * 16));
            int mine = 0;
#pragma unroll 1
            for (int k = 0; k < 16; ++k) {
                const int m = row16_max_i(key);
                if (l16 == k) mine = m;
                if (key == m) { ++ptr; key = (ptr < 16) ? ((f2sort(sv0 + SV[(tok * 2 + 1) * 16 + (ptr & 15)]) & ~255) | (255 - (l16 * 16 + ptr))) : (int)0x80000000; }
            }
            const int flat = 255 - (mine & 255), aw = flat >> 4, bw = flat & 15;
            const float best = sort2f(mine & ~255);
            const int e = SI[(tok * 2) * 16 + aw] * 128 + SI[(tok * 2 + 1) * 16 + bw];
            const float mx = sort2f(row16_max_i(mine) & ~255);
            const float ex = __expf(best - mx), sum = row16_sum_f(ex);
            const size_t o = (size_t)(tile * 64 + tok) * NSEL + head * 16 + l16;
            EIDX[o] = e; GATE[o] = ex / sum;
        }
    }
#undef TK_LOADS
#undef TK_GLD
    __syncthreads();
}
constexpr int PE_SH = 9, PE_NCH = NEXP >> PE_SH;
__device__ __forceinline__ int row16_sum_i(int x) { x += DPPX(x, 0xB1); x += DPPX(x, 0x4E); x += DPPX(x, 0x141); x += DPPX(x, 0x140); return x; }
__device__ __forceinline__ int wave_sum_i(int x) { x = row16_sum_i(x); return __builtin_amdgcn_readlane(x, 0) + __builtin_amdgcn_readlane(x, 16) + __builtin_amdgcn_readlane(x, 32) + __builtin_amdgcn_readlane(x, 48); }
__device__ __forceinline__ void peer_down_phase(Frame& F) {
    const int tid = F.tid, lane = F.lane, w = F.wave;
    LAS unsigned char* XQ = F.lds;
    LAS unsigned* LIST = (LAS unsigned*)(F.lds + 131072);
    LAS float* SX = (LAS float*)(F.lds + 131072 + 16384);
    LAS unsigned* CNT = (LAS unsigned*)(F.lds + 131072 + 16384 + 128);
    const float* gf = F.ka->in[17]; const float* SSQ2 = (const float*)(F.ws + WS_SSQ2); const unsigned char* DOWN = F.ws + WS_DOWN; const float* DSC = (const float*)(F.ws + WS_DSC);
    const int* EIDX = (const int*)(F.ws + WS_EIDX); const float* GATE = (const float*)(F.ws + WS_GATE); float* WSEL = (float*)(F.ws + WS_WSEL);
    for (int g = F.vcu; g < M / 32; g += F.G) {
        const int t0 = g * 32;
        __syncthreads();
        if (tid < 64) CNT[tid] = 0u;
#pragma unroll 1
        for (int k = 0; k < 4; ++k) {
            const int tl = w * 4 + k; const size_t t = (size_t)(t0 + tl);
            const float rstd = __builtin_amdgcn_rsqf(wave_sum(SSQ2[t * 64 + lane]) * (1.f / 4096.f) + EPS);
            const bf16* h2 = (const bf16*)(F.ws + WS_XN) + t * D;
            f32x4 x[16]; float am = 0.f;
#pragma unroll
            for (int i = 0; i < 4; ++i) { const int e0 = (i * 64 + lane) * 16; const v4u ha = *(const GAS v4u*)(h2 + e0), hb = *(const GAS v4u*)(h2 + e0 + 8);
                const f32x4 hv[4] = {(f32x4){bflo(ha.x), bfhi(ha.x), bflo(ha.y), bfhi(ha.y)}, (f32x4){bflo(ha.z), bfhi(ha.z), bflo(ha.w), bfhi(ha.w)}, (f32x4){bflo(hb.x), bfhi(hb.x), bflo(hb.y), bfhi(hb.y)}, (f32x4){bflo(hb.z), bfhi(hb.z), bflo(hb.w), bfhi(hb.w)}};
#pragma unroll
                for (int q = 0; q < 4; ++q) { const f32x4 v = hv[q] * *(const GAS f32x4*)(gf + e0 + 4 * q) * rstd; x[4 * i + q] = v;
                    am = fmaxf(am, fmaxf(fmaxf(fabsf(v.x), fabsf(v.y)), fmaxf(fabsf(v.z), fabsf(v.w)))); } }
#pragma unroll
            for (int o = 1; o < 64; o <<= 1) am = fmaxf(am, __shfl_xor(am, o));
            const float qs = (am > 0.f) ? 127.0f / am : 1.0f;
#pragma unroll
            for (int i = 0; i < 4; ++i) { v4u pk;
                pk.x = pack_i8x4(x[4 * i + 0].x * qs, x[4 * i + 0].y * qs, x[4 * i + 0].z * qs, x[4 * i + 0].w * qs); pk.y = pack_i8x4(x[4 * i + 1].x * qs, x[4 * i + 1].y * qs, x[4 * i + 1].z * qs, x[4 * i + 1].w * qs);
                pk.z = pack_i8x4(x[4 * i + 2].x * qs, x[4 * i + 2].y * qs, x[4 * i + 2].z * qs, x[4 * i + 2].w * qs); pk.w = pack_i8x4(x[4 * i + 3].x * qs, x[4 * i + 3].y * qs, x[4 * i + 3].z * qs, x[4 * i + 3].w * qs);
                *(LAS v4u*)(XQ + tl * 4096 + (i * 64 + lane) * 16) = pk; }
            if (lane == 0) SX[tl] = (am > 0.f) ? am * (1.0f / 127.0f) : 1.0f;
        }
        unsigned rec[8];
#pragma unroll
        for (int k = 0; k < 8; ++k) { const int r = tid + 512 * k, tl = r >> 7, j = r & 127; const unsigned e = (unsigned)EIDX[(size_t)(t0 + tl) * NSEL + j]; rec[k] = e | ((unsigned)tl << 14) | ((unsigned)j << 19); }
        __syncthreads();
#pragma unroll
        for (int k = 0; k < 8; ++k) (void)__hip_atomic_fetch_add((unsigned*)&CNT[(rec[k] & 16383u) >> PE_SH], 1u, __ATOMIC_RELAXED, __HIP_MEMORY_SCOPE_WORKGROUP);
        __syncthreads();
        if (tid == 0) { unsigned run = 0u; for (int c = 0; c < PE_NCH; ++c) { const unsigned n = CNT[c]; CNT[32 + c] = run; run += n; } }
        __syncthreads();
#pragma unroll
        for (int k = 0; k < 8; ++k) { const unsigned pos = __hip_atomic_fetch_add((unsigned*)&CNT[32 + ((rec[k] & 16383u) >> PE_SH)], 1u, __ATOMIC_RELAXED, __HIP_MEMORY_SCOPE_WORKGROUP); LIST[pos] = rec[k]; }
        __syncthreads();
#pragma unroll 1
        for (int p = w * 8; p < 4096; p += 64) {
            const unsigned myrec = LIST[p + (lane & 7)];
            const unsigned me = myrec & 16383u, mtl = (myrec >> 14) & 31u, mj = myrec >> 19;
            const size_t oidx = (size_t)(t0 + (int)mtl) * NSEL + mj;
            const float mg = GATE[oidx], md = DSC[me], ms = SX[mtl];
            v4u v[8][4];
#pragma unroll
            for (int k = 0; k < 8; ++k) { const unsigned e = (unsigned)__builtin_amdgcn_readlane((int)me, k); const unsigned char* rowp = DOWN + (size_t)e * D + lane * 16;
#pragma unroll
                for (int i = 0; i < 4; ++i) v[k][i] = *(const GAS v4u*)(rowp + i * 1024); }
            int res = 0;
#pragma unroll
            for (int k = 0; k < 8; ++k) { const unsigned tl = (unsigned)__builtin_amdgcn_readlane((int)mtl, k); const LAS unsigned char* xp = XQ + tl * 4096 + lane * 16; int a = 0;
#pragma unroll
                for (int i = 0; i < 4; ++i) { const v4u xv = *(const LAS v4u*)(xp + i * 1024);
                    a = __builtin_amdgcn_sdot4((int)v[k][i].x, (int)xv.x, a, false); a = __builtin_amdgcn_sdot4((int)v[k][i].y, (int)xv.y, a, false);
                    a = __builtin_amdgcn_sdot4((int)v[k][i].z, (int)xv.z, a, false); a = __builtin_amdgcn_sdot4((int)v[k][i].w, (int)xv.w, a, false); }
                const int tot = wave_sum_i(a);
                if (lane == k) res = tot; }
            if (lane < 8) { const float act = (float)res * ms * md; WSEL[oidx] = mg * 0.5f * act * (1.0f + erff(act * 0.70710678118654752f)); }
        }
    }
    __syncthreads();
}
__device__ __forceinline__ void peer_up_phase(Frame& F) {
    typedef float f32x2_ __attribute__((ext_vector_type(2)));
    const int tid = F.tid, lane = F.lane, w = F.wave;
    LAS float* ACC = (LAS float*)F.lds;
    LAS unsigned* LREC = (LAS unsigned*)(F.lds + 131072);
    LAS float* LW = (LAS float*)(F.lds + 131072 + 8192);
    LAS unsigned* CNT = (LAS unsigned*)(F.lds + 131072 + 16384);
    LAS unsigned* OFF = (LAS unsigned*)(F.lds + 131072 + 16384 + 1024);
    LAS unsigned* GS = (LAS unsigned*)(F.lds + 131072 + 16384 + 2048);
    LAS float* PR = (LAS float*)(F.lds + 131072 + 16384 + 2048 + 256);
    const unsigned char* UP = F.ws + WS_UP; const float* USC = (const float*)(F.ws + WS_USC); const int* EIDX = (const int*)(F.ws + WS_EIDX); const float* WSEL = (const float*)(F.ws + WS_WSEL); const float* fg = F.ka->in[22];
    LAS float* SSP = PR + 128;
    for (int g = F.vcu; g < M / 16; g += F.G) {
        const int t0 = g * 16;
        __syncthreads();
        if (tid < 256) CNT[tid] = 0u;
        unsigned rec[4]; float rw[4]; unsigned key[4];
#pragma unroll
        for (int k = 0; k < 4; ++k) { const int r = tid + 512 * k, tl = r >> 7, j = r & 127; const size_t o = (size_t)(t0 + tl) * NSEL + j; const unsigned e = (unsigned)EIDX[o];
            rec[k] = e | ((unsigned)tl << 14); key[k] = ((unsigned)(tl >> 1) << 5) | ((e >> 10) << 1) | (unsigned)(tl & 1); rw[k] = WSEL[o] * USC[e]; }
        __syncthreads();
#pragma unroll
        for (int k = 0; k < 4; ++k) (void)__hip_atomic_fetch_add((unsigned*)&CNT[key[k]], 1u, __ATOMIC_RELAXED, __HIP_MEMORY_SCOPE_WORKGROUP);
        __syncthreads();
        if (tid < 64) GS[tid] = (CNT[tid * 4] + CNT[tid * 4 + 1]) + (CNT[tid * 4 + 2] + CNT[tid * 4 + 3]);
        __syncthreads();
        if (tid == 0) { unsigned run = 0u; for (int c = 0; c < 64; ++c) { const unsigned n = GS[c]; GS[c] = run; run += n; } }
        __syncthreads();
        if (tid < 64) { unsigned run = GS[tid];
#pragma unroll
            for (int k = 0; k < 4; ++k) { OFF[tid * 4 + k] = run; run += CNT[tid * 4 + k]; } }
        __syncthreads();
#pragma unroll
        for (int k = 0; k < 4; ++k) { const unsigned pos = __hip_atomic_fetch_add((unsigned*)&OFF[key[k]], 1u, __ATOMIC_RELAXED, __HIP_MEMORY_SCOPE_WORKGROUP); LREC[pos] = rec[k]; LW[pos] = rw[k]; }
        __syncthreads();
        if (tid < 256 && CNT[tid] != 0u) LREC[OFF[tid] - 1u] |= 0x80000000u;
#pragma unroll 1
        for (int ch = 0; ch < 2; ++ch) {
            __syncthreads();
#pragma unroll
            for (int k = 0; k < 16; ++k) *(LAS f32x4*)(ACC + (k * 512 + tid) * 4) = (f32x4){0.f, 0.f, 0.f, 0.f};
            __syncthreads();
            {
                const LAS unsigned* HR = LREC + 256 * w; const LAS float* HW = LW + 256 * w;
                const unsigned char* ub = UP + ch * 1024 + lane * 16;
                float ra[32];
#pragma unroll
                for (int e = 0; e < 32; ++e) ra[e] = 0.f;
                v4u vn[8];
#pragma unroll
                for (int q = 0; q < 8; ++q) vn[q] = *(const GAS v4u*)(ub + (size_t)(HR[q] & 16383u) * 2048);
#pragma unroll 1
                for (int p = 0; p < 256; p += 8) {
                    v4u v[8];
#pragma unroll
                    for (int q = 0; q < 8; ++q) v[q] = vn[q];
                    { const int pn = (p + 8 < 256) ? p + 8 : p;
#pragma unroll
                      for (int q = 0; q < 8; ++q) vn[q] = *(const GAS v4u*)(ub + (size_t)(HR[pn + q] & 16383u) * 2048); }
#pragma unroll
                    for (int q = 0; q < 8; ++q) {
                        const unsigned rc = (unsigned)__builtin_amdgcn_readfirstlane((int)HR[p + q]); const float wv = HW[p + q];
                        const unsigned vw[4] = {v[q].x, v[q].y, v[q].z, v[q].w};
#pragma unroll
                        for (int d = 0; d < 4; ++d) {
                            const f32x2_ c0 = __builtin_amdgcn_cvt_scalef32_pk_f32_fp4(vw[d], 1.0f, 0), c1 = __builtin_amdgcn_cvt_scalef32_pk_f32_fp4(vw[d], 1.0f, 1), c2 = __builtin_amdgcn_cvt_scalef32_pk_f32_fp4(vw[d], 1.0f, 2), c3 = __builtin_amdgcn_cvt_scalef32_pk_f32_fp4(vw[d], 1.0f, 3);
                            ra[8 * d + 0] = fmaf(wv, c0.x, ra[8 * d + 0]); ra[8 * d + 1] = fmaf(wv, c0.y, ra[8 * d + 1]); ra[8 * d + 2] = fmaf(wv, c1.x, ra[8 * d + 2]); ra[8 * d + 3] = fmaf(wv, c1.y, ra[8 * d + 3]);
                            ra[8 * d + 4] = fmaf(wv, c2.x, ra[8 * d + 4]); ra[8 * d + 5] = fmaf(wv, c2.y, ra[8 * d + 5]); ra[8 * d + 6] = fmaf(wv, c3.x, ra[8 * d + 6]); ra[8 * d + 7] = fmaf(wv, c3.y, ra[8 * d + 7]); }
                        if (rc & 0x80000000u) { asm volatile("; run end: flush" ::: "memory");
                            LAS float* ap = ACC + ((rc >> 14) & 15u) * 2048 + lane * 4;
#pragma unroll
                            for (int d = 0; d < 8; ++d) { f32x4 t = *(LAS f32x4*)(ap + 256 * d); t += (f32x4){ra[4 * d], ra[4 * d + 1], ra[4 * d + 2], ra[4 * d + 3]}; *(LAS f32x4*)(ap + 256 * d) = t;
                                ra[4 * d] = 0.f; ra[4 * d + 1] = 0.f; ra[4 * d + 2] = 0.f; ra[4 * d + 3] = 0.f; } }
                    }
                }
            }
            __syncthreads();
            const int pg = tid >> 8, pl = (tid >> 2) & 63, pd = tid & 3;
            f32x4 y[16];
#pragma unroll
            for (int k = 0; k < 16; ++k) { typedef unsigned u32x2h __attribute__((ext_vector_type(2))); const u32x2h hb = *(const GAS u32x2h*)((const bf16*)(F.ws + WS_XN) + (size_t)(t0 + k) * D + ch * 2048 + tid * 4);
                y[k] = (f32x4){bflo(hb.x), bfhi(hb.x), bflo(hb.y), bfhi(hb.y)} + *(const LAS f32x4*)(ACC + k * 2048 + ((tid & 7) * 64 + (tid >> 3)) * 4);
                float ss = (y[k].x * y[k].x + y[k].y * y[k].y) + (y[k].z * y[k].z + y[k].w * y[k].w);
                ss = wave_sum(ss);
                if (lane == 0) PR[k * 8 + w] = ss; }
            __syncthreads();
            typedef unsigned u32x2s __attribute__((ext_vector_type(2)));
            int tq_ = tid; asm volatile("" : "+v"(tq_));
            GAS u32x2s* stash = (GAS u32x2s*)(F.ws + WS_XN8) + (size_t)t0 * 512 + tq_;
            if (ch == 0) {
#pragma unroll
                for (int k = 0; k < 16; ++k) { u32x2s o_; o_.x = pk2(y[k].x, y[k].y); o_.y = pk2(y[k].z, y[k].w); stash[k * 512] = o_; }
                if (tid < 16) { const f32x4 p0 = *(const LAS f32x4*)(PR + tid * 8), p1 = *(const LAS f32x4*)(PR + tid * 8 + 4); SSP[tid] = ((p0.x + p0.y) + (p0.z + p0.w)) + ((p1.x + p1.y) + (p1.z + p1.w)); }
            } else {
                const f32x4 ga = *(const GAS f32x4*)(fg + tid * 4), gb = *(const GAS f32x4*)(fg + 2048 + tid * 4);
#pragma unroll
                for (int k = 0; k < 16; ++k) { const f32x4 p0 = *(const LAS f32x4*)(PR + k * 8), p1 = *(const LAS f32x4*)(PR + k * 8 + 4);
                    const float tot = SSP[k] + (((p0.x + p0.y) + (p0.z + p0.w)) + ((p1.x + p1.y) + (p1.z + p1.w)));
                    const float rstd = __builtin_amdgcn_rsqf(tot * (1.f / 4096.f) + EPS);
                    float* orow = F.out + (size_t)(t0 + k) * D + tid * 4;
                    const u32x2s yb = stash[k * 512]; const f32x4 ya = (f32x4){bflo(yb.x), bfhi(yb.x), bflo(yb.y), bfhi(yb.y)};
                    *(GAS f32x4*)orow = ya * rstd * ga; *(GAS f32x4*)(orow + 2048) = y[k] * rstd * gb; }
            }
        }
    }
    __syncthreads();
}
constexpr int N_PHASES = 12;
__global__ void __launch_bounds__(NTHR, 2) hybrid_fwd(Args args) {
    extern __shared__ __attribute__((aligned(16))) unsigned char lds[];
    Frame F;
    F.lds = (LAS unsigned char*)lds;
    F.MISC = (volatile LAS unsigned*)(F.lds + MISC_OFF);
    F.tid = threadIdx.x; F.lane = F.tid & 63; F.wave = __builtin_amdgcn_readfirstlane(F.tid >> 6);
    F.G = gridDim.x; { const int bx = blockIdx.x; F.vcu = (F.G % 8 == 0) ? (bx % 8) * (F.G / 8) + bx / 8 : bx; }
    F.ws = args.ws; F.ctl = (gu32*)(args.ws + WS_CTL); F.out = args.out;
    F.ka = (const Args*)__builtin_amdgcn_kernarg_segment_ptr();
    for (int u = F.tid; u < (LDS_BYTES - LDSCTL_OFF) / 4; u += NTHR) ((LAS unsigned*)(F.lds + LDSCTL_OFF))[u] = 0u;
    __syncthreads();
    XcdBarrier bar; bar.bar = (unsigned*)(F.ctl + CW_BAR); bar.x = 0; bar.st = nullptr;
    if (args.use_bar) bar = xcd_barrier_post((unsigned*)(F.ctl + CW_BAR), F.MISC + 8);
    const int lo = args.ph_lo, hi = args.ph_hi;
#ifndef PH_MASK
#define PH_MASK 0xfff
#endif
#define IN(k) ((((PH_MASK) >> (k)) & 1) && lo <= (k) && (k) < hi)
#define SEAM(k) do { if (IN(k) && IN((k) + 1)) xcd_barrier(bar); } while (0)
    unsigned char* ws = args.ws;
    bf16* XN = (bf16*)(ws + WS_XN);


    if (IN(1)) { p0_prologue(F); } SEAM(1);

    if (IN(2)) {
        {
            constexpr unsigned segs8 = []{ unsigned m = 0; int n = 0; for (int sgi = 0; sgi < 7; ++sgi) if ((FP8_SEGS >> sgi) & 1) { m |= (unsigned)sgi << (3 * n); ++n; } return m; }();
            constexpr unsigned segs16 = []{ unsigned m = 0; int n = 0; for (int sgi = 0; sgi < 7; ++sgi) if (!((FP8_SEGS >> sgi) & 1)) { m |= (unsigned)sgi << (3 * n); ++n; } return m; }();
            constexpr int n8 = __builtin_popcount(FP8_SEGS & 0x7f), n16 = 7 - n8;
            if (n8 > 0) { pg8::Gemm g{(const bf16*)(ws + WS_XN8), (const bf16*)(ws + WS_WIN8), D / 2, D / 2, D / 2, 0, 0, 0, 0}; pg8::SegOrder S; S.init(M, n8, segs8, F.G, (int)blockIdx.x);
                pg8::EpiInproj E{(bf16*)(ws + WS_PROJ), NIN, F.ka->in[9], (const float*)(ws + WS_SA), 1.0f / WIN_QS};
                pg8::gemm_phase<pg8::EpiInproj, pg8::SegOrder, true, true, true>(F.lds, g, S, E); }
            if (n16 > 0) { pg8::Gemm g{XN, (const bf16*)(ws + WS_WIN), D, D, D, 0, 0, 0, 0}; pg8::SegOrder S; S.init(M, n16, segs16, F.G, (int)blockIdx.x);
                pg8::EpiInproj E{(bf16*)(ws + WS_PROJ), NIN, F.ka->in[9], nullptr, 1.0f};
                pg8::gemm_phase<pg8::EpiInproj, pg8::SegOrder, true, true, false>(F.lds, g, S, E); }
        }
    } SEAM(2);

    if (IN(3)) {
        const int s3 = F.vcu & 3;
        { const int kvc = (s3 == 1 || s3 == 2) ? (F.vcu >> 2) * 2 + (s3 - 1) : 128 + F.vcu;
          pg8::Gemm g{(const bf16*)(ws + WS_MEMN), (const bf16*)(ws + WS_WCKV), D / 2, D / 2, D / 2, 0, 0, 0, 0}; pg8::StaticOrder S; S.init(MROWS, 2 * D, F.G, kvc, 1 << 20);
          pg8::EpiBf16Z E{nullptr, 2 * D, 0, 0, ws + WS_KV, KV_Q8, 1.0f / (KV_Q8 * WIN_QS)};
          pg8::gemm_phase<pg8::EpiBf16Z, pg8::StaticOrder, true, true, true>(F.lds, g, S, E); }
#ifndef NO_HGRN
        if (s3 == 0) for (int u = F.vcu >> 2; u < 64; u += F.G / 4) hgrn_head_mfma(F, u >> 4, u & 15);
#endif
#ifndef NO_ATTN
        float lam;
        { int ln_ = F.lane; asm volatile("" : "+v"(ln_)); const float a = wave_sum(F.ka->in[4][ln_] * F.ka->in[5][ln_]), c = wave_sum(F.ka->in[6][ln_] * F.ka->in[7][ln_]); lam = __expf(a) - __expf(c) + 0.2f; }
        for (int u = F.vcu; u < 256; u += F.G) {
            const int bh = u >> 2, s = u & 3;
            const unsigned qlist = (s == 0) ? 0x013u : (s == 1) ? 0x48CDu : (s == 2) ? 0x267ABu : 0x59EFu; const int nq = (s == 0) ? 3 : (s == 2) ? 5 : 4;
#pragma unroll 1
            for (int k = 0; k < nq; ++k) { const int qb = (int)((qlist >> (4 * k)) & 15u); attn_unit(F, bh >> 4, bh & 15, qb, lam); }
        }
#endif
    } SEAM(3);


    if (IN(5)) {
        { pg8::Gemm g{(const bf16*)(ws + WS_KV), (const bf16*)(ws + WS_WCQ), 512, D, D / 2, (size_t)MEML * D, 512, 0, 512}; pg8::BatchOrder S; S.init(4, 4, 1, 16, F.G, (int)blockIdx.x);
          pg8::EpiBf16Z E{(bf16*)(ws + WS_WKP), D, (size_t)1024 * D, (size_t)256 * D, nullptr, 0.f, 1.0f / (KV_Q8 * WIN_QS)};
          pg8::gemm_phase<pg8::EpiBf16Z, pg8::BatchOrder, true, true, true>(F.lds, g, S, E); }
        { pg8::Gemm g{(const bf16*)(ws + WS_WCO), (const bf16*)(ws + WS_KV + D), 512, D / 2, D, 0, 512, (size_t)MEML * D, 512}; pg8::BatchOrder S; S.init(4, 4, 16, 1, F.G, (int)blockIdx.x);
          pg8::EpiBf16Z E{(bf16*)(ws + WS_VP), 1024, (size_t)D * 1024, 256, nullptr, 0.f, 1.0f / (KV_Q8 * WIN_QS)};
          pg8::gemm_phase<pg8::EpiBf16Z, pg8::BatchOrder, true, true, true>(F.lds, g, S, E); }
        pg8::Gemm g{(const bf16*)(ws + WS_XN8), (const bf16*)(ws + WS_WOUT), D / 2, D / 2, D / 2, 0, 0, 0, 0}; pg8::StaticOrder S; S.init(M, D, F.G, (int)blockIdx.x, 1 << 20);
        pg8::EpiResid<false> E{F.ka->in[0], (bf16*)(ws + WS_H1B), (float*)(ws + WS_SSQ1), (const float*)(ws + WS_SA2), 1.0f / WIN_QS};
        pg8::gemm_phase<pg8::EpiResid<false>, pg8::StaticOrder, true, true, true>(F.lds, g, S, E);
    } SEAM(5);

    if (IN(6)) {
        pg8::Gemm g{(const bf16*)(ws + WS_H1B), (const bf16*)(ws + WS_WKP), D, D, D, 0, 0, (size_t)1024 * D, 0}; pg8::StaticOrder S; S.init(M, 1024, F.G, (int)blockIdx.x, 16);
        pg8::EpiSoftmax E{(bf16*)(ws + WS_PB), 1024, (const float*)(ws + WS_SSQ1), 0.03125f * LOG2E};
        pg8::gemm_phase<pg8::EpiSoftmax, pg8::StaticOrder, false, true>(F.lds, g, S, E);
    } SEAM(6);

    if (IN(7)) {
        pg8::Gemm g{(const bf16*)(ws + WS_PB), (const bf16*)(ws + WS_VP), 1024, 1024, 1024, 0, 0, (size_t)D * 1024, 0}; pg8::StaticOrder S; S.init(M, D, F.G, (int)blockIdx.x, 16);
        pg8::EpiResid<true> E{(const bf16*)(ws + WS_H1B), XN, (float*)(ws + WS_SSQ2), nullptr, 1.0f, ws + WS_XN8, (const float*)(ws + WS_SSQ1)};
        pg8::gemm_phase<pg8::EpiResid<true>, pg8::StaticOrder, true, true>(F.lds, g, S, E);
    } SEAM(7);

    if (IN(8)) {
        pg8::Gemm g{(const bf16*)(ws + WS_XN8), (const bf16*)(ws + WS_WPQ), D / 2, D / 2, D / 2, 0, 0, 0, 0}; pg8::StaticOrder S; S.init(M, 2048, F.G, (int)blockIdx.x, 1 << 20);
        pg8::EpiRowScale E{(bf16*)(ws + WS_WIN), 2048, (const float*)(ws + WS_SSQ2), (const float*)(ws + WS_SSQ1), 1.0f / WIN_QS};
        pg8::gemm_phase<pg8::EpiRowScale, pg8::StaticOrder, true, true, true>(F.lds, g, S, E);
    } SEAM(8);

    if (IN(9)) { topk_phase(F); } SEAM(9);
    if (IN(10)) { peer_down_phase(F); } SEAM(10);
    if (IN(11)) { peer_up_phase(F); }
#undef IN
#undef SEAM
}

#ifndef MK_SPLIT
#define MK_SPLIT 0
#endif
#ifndef PROBE_REP_MASK
#define PROBE_REP_MASK 0x0
#endif
#ifndef MK_LAST_PHASE
#define MK_LAST_PHASE N_PHASES
#endif
extern "C" void kernel_launch(void* const* d_in, const int* in_sizes, int n_in, void* d_out, int out_size, void* d_ws, size_t ws_size, hipStream_t stream) {
    static int grid = 0;
    if (grid == 0) {
        if (n_in != 23 || out_size != M * D || ws_size < WS_END2) { fprintf(stderr, "kernel_launch: unexpected shapes (n_in %d out %d ws %zu)\n", n_in, out_size, ws_size); grid = -1; return; }
        int dev = 0, cus = 0, per_cu = 0;
        if (hipGetDevice(&dev) != hipSuccess || hipDeviceGetAttribute(&cus, hipDeviceAttributeMultiprocessorCount, dev) != hipSuccess) { grid = -1; return; }
        if (hipFuncSetAttribute((const void*)hybrid_fwd, hipFuncAttributeMaxDynamicSharedMemorySize, LDS_BYTES) != hipSuccess) { fprintf(stderr, "kernel_launch: hipFuncSetAttribute failed\n"); grid = -1; return; }
        if (hipOccupancyMaxActiveBlocksPerMultiprocessor(&per_cu, (const void*)hybrid_fwd, NTHR, LDS_BYTES) != hipSuccess || per_cu < 1) fprintf(stderr, "kernel_launch: occupancy query reports %d\n", per_cu);
        (void)hipGetLastError();
        grid = cus;
        if (grid != 256) { fprintf(stderr, "kernel_launch: built for 256 CUs, device has %d\n", cus); grid = -1; return; }
    }
    if (grid < 0) return;
    (void)hipMemsetAsync((char*)d_ws + WS_CTL, 0, CTL_ZERO_BYTES, stream);
    Args a{};
    for (int i = 0; i < 23; ++i) a.in[i] = (const float*)d_in[i];
    a.out = (float*)d_out; a.ws = (unsigned char*)d_ws; a.pad = 0;
#if MK_SPLIT
    for (int p = 0; p < MK_LAST_PHASE; ++p) { a.ph_lo = p; a.ph_hi = p + 1; a.use_bar = 0;
        for (int rep = 0; rep < 1 + ((PROBE_REP_MASK >> p) & 1); ++rep) hipLaunchKernelGGL(hybrid_fwd, dim3(grid), dim3(NTHR), LDS_BYTES, stream, a); }
#else
    a.ph_lo = 0; a.ph_hi = MK_LAST_PHASE; a.use_bar = 1;
    hipLaunchKernelGGL(hybrid_fwd, dim3(grid), dim3(NTHR), LDS_BYTES, stream, a);
#endif
}
```

```cpp
#include <hip/hip_runtime.h>
#include <cstdio>
#include <cstdint>

#ifndef Q8_INT
#define Q8_INT 1
#endif
constexpr bool Q8_INT_ = (Q8_INT != 0);
namespace pg8 {
#define PG8_LAS __attribute__((address_space(3)))
typedef unsigned short bf16_t;
typedef short bf16x8 __attribute__((ext_vector_type(8)));
typedef float f32x4 __attribute__((ext_vector_type(4)));
typedef unsigned u32x4 __attribute__((ext_vector_type(4)));
constexpr int BM = 256, BK = 64, HALF = 128, HTB = HALF * BK * 2  , STAGE_BYTES = 8 * HTB, NXCD = 8, WGM = 8;

__host__ __device__ __forceinline__ int lds_byte(int r, int c) { const int st = (r >> 4) * 2 + (c >> 5), rr = r & 15, cc = c & 31, ob = rr * 64 + cc * 2; return st * 1024 + (ob ^ (((ob >> 9) & 1) << 5)); }
__host__ __device__ __forceinline__ void stage_rc(int b, int& R, int& C) { const int st = b / 1024, sb = b % 1024, swz = sb ^ (((sb >> 9) & 1) << 5); R = (st >> 1) * 16 + swz / 64; C = (st & 1) * 32 + (swz % 64) / 2; }
__host__ __device__ __forceinline__ int perm32(int rho) { const int n = rho >> 4, i = rho & 15; return 8 * (i >> 2) + 4 * n + (i & 3); }

struct Unit { int pm, pn, zb, zh; };
struct Gemm {
    const bf16_t* A; const bf16_t* Bt; int K, lda, ldb; size_t a_zb, a_zh, b_zb, b_zh;
    __device__ __forceinline__ const char* a_ptr(const Unit& u) const { return (const char*)(A + (size_t)u.zb * a_zb + (size_t)u.zh * a_zh + (size_t)u.pm * BM * lda); }
    __device__ __forceinline__ const char* b_ptr(const Unit& u) const { return (const char*)(Bt + (size_t)u.zb * b_zb + (size_t)u.zh * b_zh + (size_t)u.pn * BM * ldb); }
};

struct StaticOrder {
    int nM, nN, nwg, G, c, zdiv;
    __host__ __device__ void init(int M, int N, int G_, int c_, int zdiv_) { nM = M / BM; nN = N / BM; nwg = nM * nN; G = G_; c = c_; zdiv = zdiv_; }
    __host__ __device__ bool next(int i, Unit& u) const {
        const long L = (long)i * G + c; if (L >= nwg) return false;
        int wgid = (int)L; { const int q = nwg / NXCD, r = nwg % NXCD, xcd = wgid % NXCD, off = wgid / NXCD; wgid = (xcd < r ? xcd * (q + 1) : r * (q + 1) + (xcd - r) * q) + off; }
        const int nig = WGM * nN, gid = wgid / nig, fm = gid * WGM, gsz = (nM - fm) < WGM ? (nM - fm) : WGM;
        u.pm = fm + ((wgid % nig) % gsz); u.pn = (wgid % nig) / gsz; u.zb = u.pm / zdiv; u.zh = 0; return true;
    }
    __device__ __forceinline__ void a_ready(const Unit&) const {}
    __device__ __forceinline__ void done(const Unit&) const {}
};
struct SegOrder {
    StaticOrder so; unsigned segs;
    __host__ __device__ void init(int M, int nseg, unsigned segs_, int G_, int c_) { so.init(M, nseg * 2048, G_, c_, 1 << 20); segs = segs_; }
    __host__ __device__ bool next(int i, Unit& u) const { if (!so.next(i, u)) return false; u.pn = (int)((segs >> (3 * (u.pn >> 3))) & 7u) * 8 + (u.pn & 7); return true; }
    __device__ __forceinline__ void a_ready(const Unit&) const {}
    __device__ __forceinline__ void done(const Unit&) const {}
};
struct BatchOrder {
    int nM, nN, nzh, ntot, G, c;
    __host__ __device__ void init(int nzb_, int nzh_, int nM_, int nN_, int G_, int c_) { nM = nM_; nN = nN_; nzh = nzh_; ntot = nzb_ * nzh_ * nM_ * nN_; G = G_; c = c_; }
    __host__ __device__ bool next(int i, Unit& u) const {
        const long L = (long)i * G + c; if (L >= ntot) return false;
        const int l = (int)L, per = nM * nN, z = l / per, r = l % per; u.zb = z / nzh; u.zh = z % nzh; u.pm = r / nN; u.pn = r % nN; return true;
    }
    __device__ __forceinline__ void a_ready(const Unit&) const {}
    __device__ __forceinline__ void done(const Unit&) const {}
};

__device__ __forceinline__ unsigned cvt_pk_bf16(float lo, float hi) { typedef float f2 __attribute__((ext_vector_type(2))); typedef __bf16 b2 __attribute__((ext_vector_type(2))); f2 v = {lo, hi}; b2 b = __builtin_convertvector(v, b2); return __builtin_bit_cast(unsigned, b); }
__device__ __forceinline__ u32x4 pack8(const f32x4& v0, const f32x4& v1) { u32x4 w; w.x = cvt_pk_bf16(v0[0], v0[1]); w.y = cvt_pk_bf16(v0[2], v0[3]); w.z = cvt_pk_bf16(v1[0], v1[1]); w.w = cvt_pk_bf16(v1[2], v1[3]); return w; }
__device__ __forceinline__ float sigm(float t) { return __builtin_amdgcn_rcpf(1.0f + __expf(-t)); }

constexpr float QK_SCALE_LOG2E = 0.125f * 1.4426950408889634f;
struct EpiInproj {
    static constexpr bool PERM = true, AFTER_DRAIN = false;
    bf16_t* O; int ldc; const float* gamma; const float* sa; float sbw;
    __device__ __forceinline__ void operator()(const f32x4 (&acc)[2][2][4][2], const Unit& u, int wr, int wc, int fr, int fq) const {
        asm volatile("" : "+v"(fr), "+v"(fq));
        const int seg = u.pn >> 3; const int row0 = u.pm * BM + wr * 64 + fr, col0 = u.pn * BM + wc * 32 + 8 * fq;
#pragma unroll
        for (int bj = 0; bj < 2; ++bj) {
            const int col = col0 + bj * HALF;
            f32x4 om0 = {1.f, 1.f, 1.f, 1.f}, om1 = om0;
            if (seg == 4) { const int c = col - 8192; const f32x4 g00 = *(const f32x4*)(gamma + c), g01 = *(const f32x4*)(gamma + c + 4), g10 = *(const f32x4*)(gamma + 2048 + c), g11 = *(const f32x4*)(gamma + 2048 + c + 4);
#pragma unroll
                for (int e = 0; e < 4; ++e) { om0[e] = sigm(g10[e] - g00[e]); om1[e] = sigm(g11[e] - g01[e]); } }
#pragma unroll
            for (int ai = 0; ai < 2; ++ai)
#pragma unroll
                for (int m = 0; m < 4; ++m) {
                    const float rs_ = sa ? sa[row0 + ai * HALF + m * 16] * sbw : 1.0f;
                    f32x4 v0 = acc[ai][bj][m][0], v1 = acc[ai][bj][m][1];
                    if (Q8_INT_ && sa) {
#pragma unroll
                        for (int e = 0; e < 4; ++e) { v0[e] = (float)__float_as_int(v0[e]); v1[e] = (float)__float_as_int(v1[e]); } }
                    v0 = v0 * rs_; v1 = v1 * rs_;
                    if (seg == 3 || seg == 6) {
#pragma unroll
                        for (int e = 0; e < 4; ++e) { v0[e] = v0[e] * sigm(v0[e]); v1[e] = v1[e] * sigm(v1[e]); }
                    } else if (seg == 4) {
#pragma unroll
                        for (int e = 0; e < 4; ++e) { v0[e] = om0[e] * sigm(-v0[e]); v1[e] = om1[e] * sigm(-v1[e]); }
                    } else if (seg == 0) { v0 = v0 * QK_SCALE_LOG2E; v1 = v1 * QK_SCALE_LOG2E; }
                    *(u32x4*)(O + (size_t)(row0 + ai * HALF + m * 16) * ldc + col) = pack8(v0, v1);
                }
        }
    }
};
__device__ __forceinline__ float row_rstd(const float* ssq, int row, int fq);
constexpr float H2Q_CLIP = 6.5f;
__device__ __forceinline__ unsigned pk_i8x4(f32x4 v, float q) {
    const int a = (int)rintf(__builtin_amdgcn_fmed3f(v[0] * q, -127.f, 127.f)), b = (int)rintf(__builtin_amdgcn_fmed3f(v[1] * q, -127.f, 127.f)), c = (int)rintf(__builtin_amdgcn_fmed3f(v[2] * q, -127.f, 127.f)), d = (int)rintf(__builtin_amdgcn_fmed3f(v[3] * q, -127.f, 127.f));
    return ((unsigned)a & 255u) | (((unsigned)b & 255u) << 8) | (((unsigned)c & 255u) << 16) | ((unsigned)d << 24); }
struct EpiBf16Z {
    static constexpr bool PERM = true, AFTER_DRAIN = false;
    bf16_t* O; int ldc; size_t c_zb, c_zh; unsigned char* O8 = nullptr; float q8 = 0.f; float deq = 0.f;
    __device__ __forceinline__ void operator()(const f32x4 (&acc)[2][2][4][2], const Unit& u, int wr, int wc, int fr, int fq) const {
        asm volatile("" : "+v"(fr), "+v"(fq));
        bf16_t* base = O + (size_t)u.zb * c_zb + (size_t)u.zh * c_zh; unsigned char* base8 = O8 + (size_t)u.zb * c_zb + (size_t)u.zh * c_zh; const int row0 = u.pm * BM + wr * 64 + fr, col0 = u.pn * BM + wc * 32 + 8 * fq;
#pragma unroll
        for (int ai = 0; ai < 2; ++ai)
#pragma unroll
            for (int m = 0; m < 4; ++m)
#pragma unroll
                for (int bj = 0; bj < 2; ++bj) { const size_t off = (size_t)(row0 + ai * HALF + m * 16) * ldc + col0 + bj * HALF;
                    f32x4 a0 = acc[ai][bj][m][0], a1 = acc[ai][bj][m][1];
                    if (Q8_INT_ && deq != 0.f) {
#pragma unroll
                        for (int e = 0; e < 4; ++e) { a0[e] = (float)__float_as_int(a0[e]) * deq; a1[e] = (float)__float_as_int(a1[e]) * deq; } }
                    if (O8) { typedef unsigned u32x2z __attribute__((ext_vector_type(2))); u32x2z o8_; o8_.x = pk_i8x4(a0, q8); o8_.y = pk_i8x4(a1, q8); *(u32x2z*)(base8 + off) = o8_; }
                    else *(u32x4*)(base + off) = pack8(a0, a1); }
    }
};
template <bool RESID_BF16> struct EpiResid {
    static constexpr bool PERM = true, AFTER_DRAIN = false;
    const void* resid; bf16_t* outb; float* ssq; const float* sa = nullptr; float sbw = 1.0f; unsigned char* out8 = nullptr; const float* ssq_q = nullptr;
    __device__ __forceinline__ void operator()(const f32x4 (&acc)[2][2][4][2], const Unit& u, int wr, int wc, int fr, int fq) const {
        asm volatile("" : "+v"(fr), "+v"(fq));
        const int row0 = u.pm * BM + wr * 64 + fr, col0 = u.pn * BM + wc * 32 + 8 * fq;
#pragma unroll
        for (int ai = 0; ai < 2; ++ai)
#pragma unroll
            for (int m = 0; m < 4; ++m) { const int row = row0 + ai * HALF + m * 16; float s = 0.f; const float rs_ = sa ? sa[row] * sbw : 1.0f; const float q8_ = out8 ? (127.0f / H2Q_CLIP) * row_rstd(ssq_q, row, fq) : 0.f;
#pragma unroll
                for (int bj = 0; bj < 2; ++bj) { const size_t off = (size_t)row * 4096 + col0 + bj * HALF;
                    f32x4 r0, r1;
                    if constexpr (RESID_BF16) { const u32x4 rb = *(const u32x4*)((const bf16_t*)resid + off);
                        r0 = (f32x4){__uint_as_float(rb.x << 16), __uint_as_float(rb.x & 0xffff0000u), __uint_as_float(rb.y << 16), __uint_as_float(rb.y & 0xffff0000u)};
                        r1 = (f32x4){__uint_as_float(rb.z << 16), __uint_as_float(rb.z & 0xffff0000u), __uint_as_float(rb.w << 16), __uint_as_float(rb.w & 0xffff0000u)}; }
                    else { r0 = *(const f32x4*)((const float*)resid + off); r1 = *(const f32x4*)((const float*)resid + off + 4); }
                    f32x4 a0 = acc[ai][bj][m][0], a1 = acc[ai][bj][m][1];
                    if (Q8_INT_ && sa) {
#pragma unroll
                        for (int e = 0; e < 4; ++e) { a0[e] = (float)__float_as_int(a0[e]) * rs_; a1[e] = (float)__float_as_int(a1[e]) * rs_; } }
                    const f32x4 v0 = a0 + r0, v1 = a1 + r1;
                    *(u32x4*)(outb + off) = pack8(v0, v1);
                    if (out8) { typedef unsigned u32x2r __attribute__((ext_vector_type(2))); u32x2r o8_; o8_.x = pk_i8x4(v0, q8_); o8_.y = pk_i8x4(v1, q8_); *(u32x2r*)(out8 + off) = o8_; }
                    s += ((v0[0] * v0[0] + v0[1] * v0[1]) + (v0[2] * v0[2] + v0[3] * v0[3])) + ((v1[0] * v1[0] + v1[1] * v1[1]) + (v1[2] * v1[2] + v1[3] * v1[3])); }
                s += __shfl_xor(s, 16); s += __shfl_xor(s, 32);
                if (fq == 0) ssq[(size_t)row * 64 + u.pn * 4 + wc] = s; }
    }
};
__device__ __forceinline__ float row_rstd(const float* ssq, int row, int fq) {
    const f32x4* p = (const f32x4*)(ssq + (size_t)row * 64 + fq * 16); float s = 0.f;
#pragma unroll
    for (int k = 0; k < 4; ++k) { const f32x4 v = p[k]; s += (v[0] + v[1]) + (v[2] + v[3]); }
    s += __shfl_xor(s, 16); s += __shfl_xor(s, 32);
    return __builtin_amdgcn_rsqf(s * (1.0f / 4096.0f) + 1e-6f);
}
struct EpiRowScale {
    static constexpr bool PERM = true, AFTER_DRAIN = false;
    bf16_t* O; int ldc; const float* ssq; const float* ssq_q = nullptr; float sbw = 1.0f;
    __device__ __forceinline__ void operator()(const f32x4 (&acc)[2][2][4][2], const Unit& u, int wr, int wc, int fr, int fq) const {
        const int row0 = u.pm * BM + wr * 64 + fr, col0 = u.pn * BM + wc * 32 + 8 * fq;
#pragma unroll
        for (int ai = 0; ai < 2; ++ai)
#pragma unroll
            for (int m = 0; m < 4; ++m) { const int row = row0 + ai * HALF + m * 16; float rs = row_rstd(ssq, row, fq);
                if (ssq_q) rs = rs * (H2Q_CLIP / 127.0f) * sbw / row_rstd(ssq_q, row, fq);
#pragma unroll
                for (int bj = 0; bj < 2; ++bj) { f32x4 a0 = acc[ai][bj][m][0], a1 = acc[ai][bj][m][1];
                    if (Q8_INT_ && ssq_q) {
#pragma unroll
                        for (int e = 0; e < 4; ++e) { a0[e] = (float)__float_as_int(a0[e]); a1[e] = (float)__float_as_int(a1[e]); } }
                    *(u32x4*)(O + (size_t)row * ldc + col0 + bj * HALF) = pack8(a0 * rs, a1 * rs); } }
    }
};
struct EpiSoftmax {
    static constexpr bool PERM = true, AFTER_DRAIN = true;
    bf16_t* O; int ldc; const float* ssq; float scale_log2e;
    __device__ __forceinline__ void fused(f32x4 (&acc)[2][2][4][2], const Unit& u, int wr, int wc, int fr, int fq, PG8_LAS unsigned char* lds, int wid, int lane) const {
        typedef float f32x2v __attribute__((ext_vector_type(2)));
        PG8_LAS f32x2v* X = (PG8_LAS f32x2v*)lds;
        float mwv[2][4];
#pragma unroll
        for (int ai = 0; ai < 2; ++ai)
#pragma unroll
            for (int m = 0; m < 4; ++m) { const int rl = ai * HALF + wr * 64 + m * 16 + fr; const float rs = row_rstd(ssq, u.pm * BM + rl, fq) * scale_log2e;
                float mx = -3.0e38f;
#pragma unroll
                for (int bj = 0; bj < 2; ++bj)
#pragma unroll
                    for (int n = 0; n < 2; ++n) { acc[ai][bj][m][n] = acc[ai][bj][m][n] * rs; const f32x4 v = acc[ai][bj][m][n]; mx = fmaxf(mx, fmaxf(fmaxf(v[0], v[1]), fmaxf(v[2], v[3]))); }
                mx = fmaxf(mx, __shfl_xor(mx, 16)); mx = fmaxf(mx, __shfl_xor(mx, 32));
                float sm = 0.f;
#pragma unroll
                for (int bj = 0; bj < 2; ++bj)
#pragma unroll
                    for (int n = 0; n < 2; ++n) { f32x4 v = acc[ai][bj][m][n];
#pragma unroll
                        for (int e = 0; e < 4; ++e) { v[e] = __builtin_amdgcn_exp2f(v[e] - mx); sm += v[e]; } acc[ai][bj][m][n] = v; }
                sm += __shfl_xor(sm, 16); sm += __shfl_xor(sm, 32);
                mwv[ai][m] = mx;
                if (fq == 0) X[rl * 4 + wc] = (f32x2v){mx, sm}; }
        asm volatile("s_waitcnt lgkmcnt(0)" ::: "memory"); __builtin_amdgcn_s_barrier(); asm volatile("" ::: "memory");
        const int col0 = u.pn * BM + wc * 32 + 8 * fq;
#pragma unroll
        for (int ai = 0; ai < 2; ++ai)
#pragma unroll
            for (int m = 0; m < 4; ++m) { const int rl = ai * HALF + wr * 64 + m * 16 + fr;
                const f32x2v a = X[rl * 4 + 0], b = X[rl * 4 + 1], c = X[rl * 4 + 2], d = X[rl * 4 + 3];
                const float Mx = fmaxf(fmaxf(a.x, b.x), fmaxf(c.x, d.x));
                const float S = a.y * __builtin_amdgcn_exp2f(a.x - Mx) + b.y * __builtin_amdgcn_exp2f(b.x - Mx) + c.y * __builtin_amdgcn_exp2f(c.x - Mx) + d.y * __builtin_amdgcn_exp2f(d.x - Mx);
                const float f = __builtin_amdgcn_exp2f(mwv[ai][m] - Mx) / S;
#pragma unroll
                for (int bj = 0; bj < 2; ++bj) *(u32x4*)(O + (size_t)(u.pm * BM + rl) * ldc + col0 + bj * HALF) = pack8(acc[ai][bj][m][0] * f, acc[ai][bj][m][1] * f); }
    }
};

template <class Epi, class Sched, bool ALIGN_EPI = false, bool SP2 = false, bool FP8 = false>
__device__ __forceinline__ void gemm_phase(PG8_LAS unsigned char* lds, const Gemm g, const Sched& S, const Epi& E) {
    int tid_ = threadIdx.x; asm volatile("" : "+v"(tid_));
    const int tid = tid_, wid = __builtin_amdgcn_readfirstlane(tid >> 6), lane = tid & 63, wr = wid >> 2, wc = wid & 3, fr = lane & 15, fq = lane >> 4;
    const int K = g.K, nt = K / BK;
    unsigned voffA[2], voffB[2];
#pragma unroll
    for (int i = 0; i < 2; ++i) { int R, C; stage_rc(tid * 16 + i * 8192, R, C); const int Rb = Epi::PERM ? ((R & ~31) + perm32(R & 31)) : R;
        voffA[i] = (unsigned)(R * g.lda + C) * 2u; voffB[i] = (unsigned)(Rb * g.ldb + C) * 2u; }
    const size_t kstep = (size_t)(BK * 2);
    const size_t hstepA = (size_t)HALF * g.lda * 2, hstepB = (size_t)HALF * g.ldb * 2;

    const unsigned ldsw = (unsigned)wid * 1024u;
    const int aoff = lds_byte(wr * 64 + fr, fq * 8), boff = lds_byte(wc * 32 + fr, fq * 8);
#define PG8_SA(b, h) (((b) * 2 + (h)) * HTB)
#define PG8_SB(b, h) ((4 + (b) * 2 + (h)) * HTB)
#define PG8_STAGE(bufoff, gbase, voff) do { _Pragma("unroll") for (int _i = 0; _i < 2; ++_i) { unsigned keep_; \
        asm volatile("s_mov_b32 %0, m0\n\ts_mov_b32 m0, %3\n\ts_nop 0\n\tglobal_load_lds_dwordx4 %1, %2\n\ts_mov_b32 m0, %0" : "=&s"(keep_) \
            : "v"((voff)[_i]), "s"((const char*)(gbase)), "s"((unsigned)(size_t)(lds + (bufoff) + ldsw + _i * 8192)) : "memory"); } } while (0)
#define PG8_LDA(dst, b, h) do { _Pragma("unroll") for (int m = 0; m < 4; ++m) dst[m] = __builtin_shufflevector(*(const PG8_LAS v4i_*)(lds + PG8_SA(b, h) + aoff + m * 2048), *(const PG8_LAS v4i_*)(lds + PG8_SA(b, h) + aoff + m * 2048 + 1024), 0, 1, 2, 3, 4, 5, 6, 7); } while (0)
#define PG8_LDB(dst, b, h) do { _Pragma("unroll") for (int n = 0; n < 2; ++n) dst[n] = __builtin_shufflevector(*(const PG8_LAS v4i_*)(lds + PG8_SB(b, h) + boff + n * 2048), *(const PG8_LAS v4i_*)(lds + PG8_SB(b, h) + boff + n * 2048 + 1024), 0, 1, 2, 3, 4, 5, 6, 7); } while (0)
#define PG8_LO4(x) __builtin_shufflevector(x, x, 0, 1, 2, 3)
#define PG8_HI4(x) __builtin_shufflevector(x, x, 4, 5, 6, 7)
#define PG8_LO(x) __builtin_bit_cast(bf16x8, __builtin_shufflevector(x, x, 0, 1, 2, 3))
#define PG8_HI(x) __builtin_bit_cast(bf16x8, __builtin_shufflevector(x, x, 4, 5, 6, 7))
#define PG8_MMA(ai, bj, At, Bt) do { __builtin_amdgcn_s_setprio(1); _Pragma("unroll") for (int m = 0; m < 4; ++m) _Pragma("unroll") for (int n = 0; n < 2; ++n) { \
        if constexpr (FP8) { if constexpr (Q8_INT_) { \
                acc[ai][bj][m][n] = __builtin_bit_cast(f32x4, __builtin_amdgcn_mfma_i32_16x16x64_i8(PG8_LO4(Bt[n]), PG8_LO4(At[m]), __builtin_bit_cast(v4i_, acc[ai][bj][m][n]), 0, 0, 0)); \
                acc[ai][bj][m][n] = __builtin_bit_cast(f32x4, __builtin_amdgcn_mfma_i32_16x16x64_i8(PG8_HI4(Bt[n]), PG8_HI4(At[m]), __builtin_bit_cast(v4i_, acc[ai][bj][m][n]), 0, 0, 0)); \
            } else acc[ai][bj][m][n] = __builtin_amdgcn_mfma_scale_f32_16x16x128_f8f6f4(Bt[n], At[m], acc[ai][bj][m][n], 0, 0, 0, 0, 0, 0); } \
        else { acc[ai][bj][m][n] = __builtin_amdgcn_mfma_f32_16x16x32_bf16(PG8_LO(Bt[n]), PG8_LO(At[m]), acc[ai][bj][m][n], 0, 0, 0); acc[ai][bj][m][n] = __builtin_amdgcn_mfma_f32_16x16x32_bf16(PG8_HI(Bt[n]), PG8_HI(At[m]), acc[ai][bj][m][n], 0, 0, 0); } } \
        __builtin_amdgcn_s_setprio(0); } while (0)
#define PG8_WAIT_V(n) asm volatile("s_waitcnt vmcnt(" #n ")" ::: "memory")
#define PG8_WAIT_L(n) asm volatile("s_waitcnt lgkmcnt(" #n ")" ::: "memory")
#define PG8_BAR __builtin_amdgcn_s_barrier()
#define PG8_SCHED __builtin_amdgcn_sched_barrier(0)
    Unit cur, nxt; int ui = 0;
    if (!S.next(0, cur)) return;
    f32x4 acc[2][2][4][2];
#pragma unroll
    for (int a = 0; a < 2; ++a)
#pragma unroll
        for (int b = 0; b < 2; ++b)
#pragma unroll
            for (int m = 0; m < 4; ++m)
#pragma unroll
                for (int n = 0; n < 2; ++n) acc[a][b][m][n] = (f32x4){0.f, 0.f, 0.f, 0.f};
    typedef int v4i_ __attribute__((ext_vector_type(4))); typedef int v8i_ __attribute__((ext_vector_type(8)));
    v8i_ At[4], B0[2], B1[2];
    const char* cA = g.a_ptr(cur); const char* cB = g.b_ptr(cur);
    S.a_ready(cur);
    if constexpr (SP2) {
        PG8_STAGE(PG8_SB(0, 0), cB, voffB); PG8_STAGE(PG8_SB(0, 1), cB + hstepB, voffB); PG8_STAGE(PG8_SA(0, 0), cA, voffA); PG8_STAGE(PG8_SA(0, 1), cA + hstepA, voffA);
        if (wr == 1) PG8_BAR;
        PG8_WAIT_V(2); PG8_BAR;
        PG8_STAGE(PG8_SB(1, 0), cB + kstep, voffB); PG8_STAGE(PG8_SA(1, 0), cA + kstep, voffA); PG8_STAGE(PG8_SB(1, 1), cB + hstepB + kstep, voffB);
        PG8_WAIT_V(6); PG8_BAR;
    } else {
        PG8_STAGE(PG8_SB(0, 0), cB, voffB); PG8_STAGE(PG8_SA(0, 0), cA, voffA); PG8_STAGE(PG8_SB(0, 1), cB + hstepB, voffB); PG8_STAGE(PG8_SA(0, 1), cA + hstepA, voffA);
        if (wr == 1) PG8_BAR;
        PG8_WAIT_V(4); PG8_BAR;
        PG8_STAGE(PG8_SB(1, 0), cB + kstep, voffB); PG8_STAGE(PG8_SA(1, 0), cA + kstep, voffA); PG8_STAGE(PG8_SB(1, 1), cB + hstepB + kstep, voffB);
        PG8_WAIT_V(6); PG8_BAR;
    }
    for (;;) {
        const bool has_next = S.next(ui + 1, nxt);
        const char* nA = has_next ? g.a_ptr(nxt) : cA; const char* nB = has_next ? g.b_ptr(nxt) : cB;
        for (int t = 0; t < nt; t += 2) {
            const bool last = (t == nt - 2);
            const char* a1 = cA + (size_t)(t + 1) * kstep;
            const char* a2 = last ? nA : cA + (size_t)(t + 2) * kstep; const char* b2 = last ? nB : cB + (size_t)(t + 2) * kstep;
            const char* a3 = a2 + kstep; const char* b3 = b2 + kstep;
            if (last && has_next) S.a_ready(nxt);
            if constexpr (SP2) {
            PG8_LDB(B0, 0, 0); PG8_LDB(B1, 0, 1); PG8_SCHED; PG8_LDA(At, 0, 0); PG8_STAGE(PG8_SA(1, 1), a1 + hstepA, voffA);
            PG8_WAIT_V(8); PG8_WAIT_L(0); PG8_BAR; PG8_MMA(0, 0, At, B0); PG8_MMA(0, 1, At, B1); PG8_BAR; PG8_SCHED;
            PG8_LDA(At, 0, 1); PG8_STAGE(PG8_SB(0, 0), b2, voffB); PG8_STAGE(PG8_SB(0, 1), b2 + hstepB, voffB); PG8_STAGE(PG8_SA(0, 0), a2, voffA);
            PG8_WAIT_V(8); PG8_WAIT_L(0); PG8_BAR; PG8_MMA(1, 0, At, B0); PG8_MMA(1, 1, At, B1); PG8_BAR; PG8_SCHED;
            PG8_LDB(B0, 1, 0); PG8_LDB(B1, 1, 1); PG8_SCHED; PG8_LDA(At, 1, 0); PG8_STAGE(PG8_SA(0, 1), a2 + hstepA, voffA);
            PG8_WAIT_V(8); PG8_WAIT_L(0); PG8_BAR; PG8_MMA(0, 0, At, B0); PG8_MMA(0, 1, At, B1); PG8_BAR; PG8_SCHED;
            PG8_LDA(At, 1, 1); PG8_STAGE(PG8_SB(1, 0), b3, voffB); PG8_STAGE(PG8_SB(1, 1), b3 + hstepB, voffB); PG8_STAGE(PG8_SA(1, 0), a3, voffA);
            PG8_WAIT_V(8); PG8_WAIT_L(0); PG8_BAR; PG8_MMA(1, 0, At, B0); PG8_MMA(1, 1, At, B1); PG8_BAR; PG8_SCHED;
            } else {
            PG8_LDB(B0, 0, 0); PG8_SCHED; PG8_LDA(At, 0, 0); PG8_STAGE(PG8_SA(1, 1), a1 + hstepA, voffA);
            PG8_WAIT_L(8); PG8_BAR; PG8_WAIT_L(0); PG8_MMA(0, 0, At, B0); PG8_BAR; PG8_SCHED;
            PG8_LDB(B1, 0, 1); PG8_STAGE(PG8_SB(0, 0), b2, voffB);
            PG8_BAR; PG8_WAIT_L(0); PG8_MMA(0, 1, At, B1); PG8_BAR;
            PG8_LDA(At, 0, 1); PG8_STAGE(PG8_SA(0, 0), a2, voffA);
            PG8_BAR; PG8_WAIT_L(0); PG8_MMA(1, 0, At, B0); PG8_BAR; PG8_SCHED;
            PG8_STAGE(PG8_SB(0, 1), b2 + hstepB, voffB);
            PG8_WAIT_V(6); PG8_BAR; PG8_MMA(1, 1, At, B1); PG8_BAR;
            PG8_LDB(B0, 1, 0); PG8_SCHED; PG8_LDA(At, 1, 0); PG8_STAGE(PG8_SA(0, 1), a2 + hstepA, voffA);
            PG8_WAIT_L(8); PG8_BAR; PG8_WAIT_L(0); PG8_MMA(0, 0, At, B0); PG8_BAR; PG8_SCHED;
            PG8_LDB(B1, 1, 1); PG8_STAGE(PG8_SB(1, 0), b3, voffB);
            PG8_BAR; PG8_WAIT_L(0); PG8_MMA(0, 1, At, B1); PG8_BAR;
            PG8_LDA(At, 1, 1); PG8_STAGE(PG8_SA(1, 0), a3, voffA);
            PG8_BAR; PG8_WAIT_L(0); PG8_MMA(1, 0, At, B0); PG8_BAR; PG8_SCHED;
            PG8_STAGE(PG8_SB(1, 1), b3 + hstepB, voffB);
            PG8_WAIT_V(6); PG8_BAR; PG8_MMA(1, 1, At, B1); PG8_BAR;
            }
        }
        if constexpr (ALIGN_EPI) { if (wr == 0) PG8_BAR; }
        if constexpr (!Epi::AFTER_DRAIN) { E(acc, cur, wr, wc, fr, fq); S.done(cur); }
        if (!has_next) break;
#pragma unroll
        for (int a = 0; a < 2; ++a)
#pragma unroll
            for (int b = 0; b < 2; ++b)
#pragma unroll
                for (int m = 0; m < 4; ++m)
#pragma unroll
                    for (int n = 0; n < 2; ++n) acc[a][b][m][n] = (f32x4){0.f, 0.f, 0.f, 0.f};
        cur = nxt; cA = nA; cB = nB; ++ui;
        if constexpr (ALIGN_EPI) { if (wr == 1) PG8_BAR; }
    }
    PG8_WAIT_V(0);
    if constexpr (!ALIGN_EPI) { if (wr == 0) PG8_BAR; }
    PG8_BAR;
    if constexpr (Epi::AFTER_DRAIN) { E.fused(acc, cur, wr, wc, fr, fq, lds, wid, lane); S.done(cur); }
#undef PG8_SA
#undef PG8_SB
#undef PG8_STAGE
#undef PG8_LDA
#undef PG8_LDB
#undef PG8_LO
#undef PG8_HI
#undef PG8_MMA
#undef PG8_WAIT_V
#undef PG8_WAIT_L
#undef PG8_BAR
#undef PG8_SCHED
}
}
#define GAS __attribute__((address_space(1)))
#define LAS __attribute__((address_space(3)))
typedef unsigned short bf16;
typedef unsigned v4u __attribute__((ext_vector_type(4)));
typedef float f32x4 __attribute__((ext_vector_type(4)));
typedef short bf16x8 __attribute__((ext_vector_type(8)));
typedef GAS unsigned gu32;
typedef GAS unsigned long long gu64;
#define RLX_AGENT __ATOMIC_RELAXED, __HIP_MEMORY_SCOPE_AGENT
#define LDS_WAIT() asm volatile("s_waitcnt lgkmcnt(0)" ::: "memory")
#define VM_WAIT() asm volatile("s_waitcnt vmcnt(0)" ::: "memory")
__device__ __forceinline__ unsigned long long rt() { return __builtin_amdgcn_s_memrealtime(); }
__device__ __forceinline__ unsigned f2bf(float f) { unsigned u = __builtin_bit_cast(unsigned, f); return (u + 0x7fffu + ((u >> 16) & 1u)) >> 16; }
__device__ __forceinline__ unsigned pk2(float lo, float hi) { return f2bf(lo) | (f2bf(hi) << 16); }

#define XB_TMO      128
#define XB_XCNT(j)  (256  + 64 * (j))
#define XB_XSUB(j)  (1280 + 64 * (j))
#define XB_XGEN(j)  (2304 + 64 * (j))
#define XB_TOP      3328
#define XB_TOPGEN   3392
#define XCD_BAR_WORDS 3456
#define XB_SPIN_CAP (1u << 18)

__device__ __forceinline__ unsigned xb_ld(unsigned* p)              { return __hip_atomic_load(p, __ATOMIC_RELAXED, __HIP_MEMORY_SCOPE_AGENT); }
__device__ __forceinline__ unsigned xb_add(unsigned* p, unsigned v) { return __hip_atomic_fetch_add(p, v, __ATOMIC_RELAXED, __HIP_MEMORY_SCOPE_AGENT); }
__device__ __forceinline__ unsigned xb_xcc_id() { return (unsigned)__builtin_amdgcn_s_getreg((3 << 11) | 20) & 0xFu; }
#define XB_SPIN(cond, bar) do { unsigned _sp = 0; while (cond) { __builtin_amdgcn_s_sleep(1); \
    if ((++_sp & 255u) == 0u) { if (xb_ld(&(bar)[XB_TMO])) break; if (_sp > XB_SPIN_CAP) { atomicAdd(&(bar)[XB_TMO], 1u); break; } } } } while (0)

struct XcdBarrier {
    unsigned* bar; unsigned x;
    volatile LAS unsigned* st;
};

__device__ __forceinline__ XcdBarrier xcd_barrier_post(unsigned* bar, volatile LAS unsigned* st) {
    XcdBarrier b; b.bar = bar; b.x = xb_xcc_id(); b.st = st;
    if (threadIdx.x == 0) (void)xb_add(&bar[XB_XCNT(b.x)], 1u);
    return b;
}
__device__ __forceinline__ void xcd_barrier_complete(unsigned* bar, unsigned x, unsigned& nloc, unsigned& nx) {
    const unsigned G = gridDim.x * gridDim.y * gridDim.z;
    unsigned sum, cnt, mine, sp = 0u;
    for (;;) {
        sum = 0u; cnt = 0u; mine = 0u;
#pragma unroll
        for (unsigned j = 0; j < 16; ++j) { const unsigned c = xb_ld(&bar[XB_XCNT(j)]); sum += c; cnt += (c > 0u) ? 1u : 0u; mine = (j == x) ? c : mine; }
        if (sum == G) break;
        __builtin_amdgcn_s_sleep(1);
        if ((++sp & 255u) == 0u) { if (xb_ld(&bar[XB_TMO])) break; if (sp > XB_SPIN_CAP) { atomicAdd(&bar[XB_TMO], 1u); break; } }
    }
    nloc = mine > 0u ? mine : 1u; nx = cnt > 0u ? cnt : 1u;
}

__device__ __forceinline__ void xcd_barrier(const XcdBarrier& b) {
    asm volatile("s_waitcnt vmcnt(0)" ::: "memory");
    __syncthreads();
    if (threadIdx.x == 0) {
        unsigned* bar = b.bar;
        __builtin_amdgcn_s_waitcnt(0);
        unsigned nloc = b.st[0], nx = b.st[1];
        if (nloc == 0u) { xcd_barrier_complete(bar, b.x, nloc, nx); b.st[0] = nloc; b.st[1] = nx; }
        const unsigned old = xb_add(&bar[XB_XSUB(b.x)], 1u);
        const unsigned gen = old / nloc;
        if (old + 1u == (gen + 1u) * nloc) {
            __builtin_amdgcn_fence(__ATOMIC_RELEASE, "agent");
            asm volatile("s_waitcnt vmcnt(0)" ::: "memory");
            const unsigned og = xb_add(&bar[XB_TOP], 1u);
            const unsigned tg = og / nx;
            if (og + 1u == (tg + 1u) * nx) xb_add(&bar[XB_TOPGEN], 1u);
            else XB_SPIN(xb_ld(&bar[XB_TOPGEN]) == tg, bar);
            __builtin_amdgcn_fence(__ATOMIC_ACQUIRE, "agent");
            xb_add(&bar[XB_XGEN(b.x)], 1u);
            asm volatile("s_waitcnt vmcnt(0)" ::: "memory");
        } else {
            XB_SPIN(xb_ld(&bar[XB_XGEN(b.x)]) == gen, bar);
            __builtin_amdgcn_fence(__ATOMIC_ACQUIRE, "agent");
            asm volatile("s_waitcnt vmcnt(0)" ::: "memory");
        }
    }
    __syncthreads();
}

constexpr int NWAVES = 8, NTHR = 512;
constexpr int D = 4096, BATCH = 4, SEQ = 4096, M = BATCH * SEQ, MEML = 256, MROWS = BATCH * MEML, NIN = 14336;
constexpr int COL_DQ = 0, COL_DK = 2048, COL_DV = 4096, COL_HQ = 6144, COL_HF = 8192, COL_HI = 10240, COL_HG = 12288;
constexpr int NEXP = 16384, PEER_H = 8, PEER_K = 16, NSEL = PEER_H * PEER_K;
constexpr float EPS = 1e-6f, LOG2E = 1.4426950408889634f;
#ifndef Q8_INT
#define Q8_INT 1
#endif
constexpr float WIN_QS = Q8_INT ? 1344.0f : 2048.0f;
constexpr size_t MiB = 1u << 20;
constexpr size_t WS_CTL = 0, CTL_ZERO_BYTES = 1 * MiB;
constexpr size_t WS_SUBK = 1 * MiB;
constexpr size_t WS_XN = 2 * MiB;
constexpr size_t WS_WIN = 130 * MiB;
constexpr size_t WS_WOUT = 242 * MiB, WS_WCQ = 274 * MiB, WS_WCKV = 306 * MiB, WS_WCO = 370 * MiB, WS_WPQ = 402 * MiB;
constexpr size_t WS_PROJ = 418 * MiB;
constexpr size_t WS_H1F = WS_PROJ, WS_H1B = WS_PROJ + 256 * MiB, WS_PB = WS_PROJ + 384 * MiB;
constexpr size_t WS_MEMN = 866 * MiB, WS_KV = 874 * MiB, WS_WKP = 890 * MiB, WS_VP = 922 * MiB;
constexpr size_t WS_EIDX = 954 * MiB, WS_GATE = 962 * MiB, WS_HSSQ = 970 * MiB, WS_SSQ1 = 974 * MiB, WS_SSQ2 = 978 * MiB;
constexpr size_t WS_ATT = 982 * MiB;
constexpr size_t WS_DOWN = 1014 * MiB, WS_UP = 1078 * MiB, WS_WSEL = 1142 * MiB, WS_DSC = 1150 * MiB, WS_USC = 1151 * MiB, WS_END = 1152 * MiB;
constexpr float KV_Q8 = 127.0f / 6.5f;
constexpr float MIX_CLIP = 8.0f, MIX_Q8 = 127.0f / MIX_CLIP;
constexpr size_t WS_XN8 = 1152 * MiB, WS_WIN8 = 1216 * MiB, WS_END2 = 1272 * MiB;
constexpr size_t WS_SA = 1150 * MiB + 512 * 1024;
constexpr int CW_AMAX = 8;
constexpr int CW_BAR = 4096;
constexpr int RING_BYTES = 131072, LDS_BYTES = 163840, LDSCTL_OFF = LDS_BYTES - 1024, MISC_OFF = LDSCTL_OFF + 320;

struct Args { const float* in[23]; float* out; unsigned char* ws; int ph_lo, ph_hi, use_bar, pad; };
struct Frame {
    LAS unsigned char* lds;
    volatile LAS unsigned* MISC;
    gu32* ctl;
    int tid, lane, wave, vcu, G;
    unsigned char* ws;
    const Args* ka;
    float* out;
};
__device__ __forceinline__ float bf2f(unsigned short b) { return __uint_as_float((unsigned)b << 16); }
__device__ __forceinline__ float bflo(unsigned w) { return __uint_as_float(w << 16); }
__device__ __forceinline__ float bfhi(unsigned w) { return __uint_as_float(w & 0xffff0000u); }
__device__ __forceinline__ float wave_sum(float v) {
#pragma unroll
    for (int o = 1; o < 64; o <<= 1) v += __shfl_xor(v, o);
    return v;
}
__device__ __forceinline__ void p0_transpose_item(const float* W, int K, int N, bf16* WT, const float* ks, LAS float* scr, int item, int lane) {
    const int nblk = N / 32, kb = item / nblk, nb = item % nblk, k0 = 64 * kb, n0 = 32 * nb;
#pragma unroll 8
    for (int i = 0; i < 32; ++i) { const int kk = 2 * i + (lane >> 5); float v = W[(size_t)(k0 + kk) * N + n0 + (lane & 31)]; if (ks) v *= ks[k0 + kk]; scr[kk * 33 + (lane & 31)] = v; }
    LDS_WAIT(); asm volatile("" ::: "memory");
    const int c = lane & 7;
#pragma unroll
    for (int j = 0; j < 4; ++j) { const int n = (lane >> 3) + 8 * j; const LAS float* s = scr + (8 * c) * 33 + n;
        v4u o; o.x = pk2(s[0 * 33], s[1 * 33]); o.y = pk2(s[2 * 33], s[3 * 33]); o.z = pk2(s[4 * 33], s[5 * 33]); o.w = pk2(s[6 * 33], s[7 * 33]);
        *(GAS v4u*)(WT + (size_t)(n0 + n) * K + k0 + 8 * c) = o; }
    LDS_WAIT(); asm volatile("" ::: "memory");
}
#ifndef FP8_SEGS
#define FP8_SEGS 0x7f
#endif
#ifndef Q8_INT
#define Q8_INT 1
#endif
__device__ __forceinline__ unsigned q8_pack4(float a, float b, float c, float d) {
    const int ia = (int)rintf(a), ib = (int)rintf(b), ic = (int)rintf(c), id = (int)rintf(d);
    return ((unsigned)ia & 255u) | (((unsigned)ib & 255u) << 8) | (((unsigned)ic & 255u) << 16) | ((unsigned)id << 24); }
__device__ __forceinline__ void p0_transpose_item_fp8(const float* W, int K, int N, unsigned char* WT, float qs, LAS float* scr, int item, int lane, const float* ks = nullptr) {
    const int nblk = N / 32, kb = item / nblk, nb = item % nblk, k0 = 64 * kb, n0 = 32 * nb;
    float wl_[32];
    { const float* wp_ = W + (size_t)(k0 + (lane >> 5)) * N + n0 + (lane & 31); const size_t st_ = (size_t)2 * N;
#pragma unroll
      for (int i = 0; i < 32; ++i) wl_[i] = wp_[i * st_]; }
    float kl_[32];
    if (ks) {
#pragma unroll
        for (int i = 0; i < 32; ++i) kl_[i] = ks[k0 + 2 * i + (lane >> 5)]; }
#pragma unroll
    for (int i = 0; i < 32; ++i) { const int kk = 2 * i + (lane >> 5); float wv_ = wl_[i] * qs; if (ks) wv_ *= kl_[i]; scr[kk * 33 + (lane & 31)] = __builtin_amdgcn_fmed3f(wv_, Q8_INT ? -127.0f : -448.0f, Q8_INT ? 127.0f : 448.0f); }
    LDS_WAIT(); asm volatile("" ::: "memory");
    const int c = lane & 3;
#pragma unroll
    for (int j = 0; j < 2; ++j) { const int n = (lane >> 2) + 16 * j; const LAS float* sp = scr + (16 * c) * 33 + n; v4u o; unsigned ow[4];
#pragma unroll
        for (int q = 0; q < 4; ++q) {
#if Q8_INT
            ow[q] = q8_pack4(sp[(4 * q) * 33], sp[(4 * q + 1) * 33], sp[(4 * q + 2) * 33], sp[(4 * q + 3) * 33]);
#else
            int w = __builtin_amdgcn_cvt_pk_fp8_f32(sp[(4 * q) * 33], sp[(4 * q + 1) * 33], 0, false); w = __builtin_amdgcn_cvt_pk_fp8_f32(sp[(4 * q + 2) * 33], sp[(4 * q + 3) * 33], w, true); ow[q] = (unsigned)w;
#endif
        }
        o.x = ow[0]; o.y = ow[1]; o.z = ow[2]; o.w = ow[3];
        *(GAS v4u*)(WT + (size_t)(n0 + n) * K + k0 + 16 * c) = o; }
    LDS_WAIT(); asm volatile("" ::: "memory");
}
__device__ __forceinline__ void row4096_norm_to_fp8(const float* src, const float* g, unsigned char* dst, bf16* dst16, float* sa_out, int lane) {
    const GAS f32x4* xr = (const GAS f32x4*)src + lane;
    f32x4 v[16]; float s = 0.f;
#pragma unroll
    for (int j = 0; j < 16; ++j) { v[j] = xr[64 * j]; s += (v[j].x * v[j].x + v[j].y * v[j].y) + (v[j].z * v[j].z + v[j].w * v[j].w); }
    const float r = __builtin_amdgcn_rsqf(wave_sum(s) * (1.f / 4096.f) + EPS);
    float am = 0.f;
#pragma unroll
    for (int j = 0; j < 16; ++j) { v[j] = v[j] * r * ((const GAS f32x4*)g)[64 * j + lane]; am = fmaxf(am, fmaxf(fmaxf(fabsf(v[j].x), fabsf(v[j].y)), fmaxf(fabsf(v[j].z), fabsf(v[j].w)))); }
#pragma unroll
    for (int o = 1; o < 64; o <<= 1) am = fmaxf(am, __shfl_xor(am, o));
    const float q = (am > 0.f) ? (Q8_INT ? 127.0f : 448.0f) / am : 1.0f;
    GAS unsigned* o4 = (GAS unsigned*)dst + lane; GAS unsigned long long* o8 = (GAS unsigned long long*)dst16 + lane;
#pragma unroll
    for (int j = 0; j < 16; ++j) {
#if Q8_INT
        o4[64 * j] = q8_pack4(v[j].x * q, v[j].y * q, v[j].z * q, v[j].w * q);
#else
        int w = __builtin_amdgcn_cvt_pk_fp8_f32(v[j].x * q, v[j].y * q, 0, false); w = __builtin_amdgcn_cvt_pk_fp8_f32(v[j].z * q, v[j].w * q, w, true); o4[64 * j] = (unsigned)w;
#endif
        if ((FP8_SEGS & 0x7f) != 0x7f) o8[64 * j] = (unsigned long long)pk2(v[j].x, v[j].y) | ((unsigned long long)pk2(v[j].z, v[j].w) << 32); }
    if (lane == 0) *sa_out = (am > 0.f) ? am * (1.0f / (Q8_INT ? 127.0f : 448.0f)) : 1.0f;
}
__device__ __forceinline__ void row4096_bf16_to_i8(const bf16* src, unsigned char* dst, float* sc_out, int lane) {
    typedef unsigned u32x2q __attribute__((ext_vector_type(2)));
    v4u v[8]; float am = 0.f;
#pragma unroll
    for (int j = 0; j < 8; ++j) { v[j] = *(const GAS v4u*)(src + 512 * j + 8 * lane);
        const unsigned wd[4] = {v[j].x, v[j].y, v[j].z, v[j].w};
#pragma unroll
        for (int e = 0; e < 4; ++e) am = fmaxf(am, fmaxf(fabsf(bflo(wd[e])), fabsf(bfhi(wd[e])))); }
#pragma unroll
    for (int o = 1; o < 64; o <<= 1) am = fmaxf(am, __shfl_xor(am, o));
    const float q = (am > 0.f) ? 127.0f / am : 1.0f;
#pragma unroll
    for (int j = 0; j < 8; ++j) { u32x2q o;
        o.x = q8_pack4(bflo(v[j].x) * q, bfhi(v[j].x) * q, bflo(v[j].y) * q, bfhi(v[j].y) * q); o.y = q8_pack4(bflo(v[j].z) * q, bfhi(v[j].z) * q, bflo(v[j].w) * q, bfhi(v[j].w) * q);
        *(GAS u32x2q*)(dst + 512 * j + 8 * lane) = o; }
    if (lane == 0) *sc_out = (am > 0.f) ? am * (1.0f / 127.0f) : 1.0f;
}
__device__ __forceinline__ void p0_absmax(Frame& F) {
    const GAS f32x4* W = (const GAS f32x4*)F.ka->in[3]; const size_t n4 = (size_t)D * NIN / 4, stride = (size_t)F.G * NTHR;
    float am = 0.f;
    for (size_t i = (size_t)F.vcu * NTHR + F.tid; i < n4; i += stride) { const f32x4 v = W[i]; am = fmaxf(am, fmaxf(fmaxf(fabsf(v.x), fabsf(v.y)), fmaxf(fabsf(v.z), fabsf(v.w)))); }
#pragma unroll
    for (int o = 1; o < 64; o <<= 1) am = fmaxf(am, __shfl_xor(am, o));
    if (F.lane == 0) (void)__hip_atomic_fetch_max((unsigned*)(F.ctl + CW_AMAX), __float_as_uint(am), __ATOMIC_RELAXED, __HIP_MEMORY_SCOPE_AGENT);
}
__device__ __forceinline__ void row4096_to_bf16(const float* src, bf16* dst, const float* g, float sc, int mode, int lane, unsigned char* dst8 = nullptr, float q8 = 0.f) {
    const GAS f32x4* xr = (const GAS f32x4*)src + lane;
    f32x4 v[16]; float s = 0.f;
#pragma unroll
    for (int j = 0; j < 16; ++j) { v[j] = xr[64 * j]; s += (v[j].x * v[j].x + v[j].y * v[j].y) + (v[j].z * v[j].z + v[j].w * v[j].w); }
    float r = sc;
    if (mode == 1) r = __builtin_amdgcn_rsqf(wave_sum(s) * (1.f / 4096.f) + EPS);
    GAS unsigned long long* o8 = (GAS unsigned long long*)dst + lane;
#pragma unroll
    for (int j = 0; j < 16; ++j) { f32x4 w = v[j] * r; if (mode == 1) w = w * ((const GAS f32x4*)g)[64 * j + lane];
        if (dst8) ((GAS unsigned*)dst8)[64 * j + lane] = pg8::pk_i8x4(w, q8);
        else o8[64 * j] = (unsigned long long)pk2(w.x, w.y) | ((unsigned long long)pk2(w.z, w.w) << 32); }
}
__device__ __forceinline__ void row4096_to_fp8(const float* src, unsigned char* dst, float* sc_out, int lane) {
    const GAS f32x4* xr = (const GAS f32x4*)src + lane;
    f32x4 v[16]; float am = 0.f;
#pragma unroll
    for (int j = 0; j < 16; ++j) { v[j] = xr[64 * j]; am = fmaxf(am, fmaxf(fmaxf(fabsf(v[j].x), fabsf(v[j].y)), fmaxf(fabsf(v[j].z), fabsf(v[j].w)))); }
#pragma unroll
    for (int o = 1; o < 64; o <<= 1) am = fmaxf(am, __shfl_xor(am, o));
    const float q = (am > 0.f) ? 448.0f / am : 1.0f;
    GAS unsigned* o4 = (GAS unsigned*)dst + lane;
#pragma unroll
    for (int j = 0; j < 16; ++j) { int w = __builtin_amdgcn_cvt_pk_fp8_f32(v[j].x * q, v[j].y * q, 0, false); w = __builtin_amdgcn_cvt_pk_fp8_f32(v[j].z * q, v[j].w * q, w, true); o4[64 * j] = (unsigned)w; }
    if (lane == 0) *sc_out = (am > 0.f) ? am * (1.0f / 448.0f) : 1.0f;
}
__device__ __forceinline__ void row4096_to_fp4(const float* src, unsigned char* dst, float* sc_out, int lane) {
    const GAS f32x4* xr = (const GAS f32x4*)src + lane;
    f32x4 v[16]; float am = 0.f;
#pragma unroll
    for (int j = 0; j < 16; ++j) { v[j] = xr[64 * j]; am = fmaxf(am, fmaxf(fmaxf(fabsf(v[j].x), fabsf(v[j].y)), fmaxf(fabsf(v[j].z), fabsf(v[j].w)))); }
#pragma unroll
    for (int o = 1; o < 64; o <<= 1) am = fmaxf(am, __shfl_xor(am, o));
    const float q = (am > 0.f) ? 6.0f / am : 1.0f;
#pragma unroll
    for (int j = 0; j < 16; ++j) { unsigned w = __builtin_amdgcn_cvt_scalef32_pk_fp4_f32(0u, v[j].x * q, v[j].y * q, 1.0f, 0); w = __builtin_amdgcn_cvt_scalef32_pk_fp4_f32(w, v[j].z * q, v[j].w * q, 1.0f, 1);
        *(GAS unsigned short*)(dst + 1024 * (j >> 3) + 16 * (32 * (j & 1) + (lane >> 1)) + 4 * ((j >> 1) & 3) + 2 * (lane & 1)) = (unsigned short)w; }
    if (lane == 0) *sc_out = (am > 0.f) ? am * (1.0f / 6.0f) : 1.0f;
}
__device__ __forceinline__ unsigned pack_i8x4(float a, float b, float c, float d) {
    const int ia = (int)rintf(a), ib = (int)rintf(b), ic = (int)rintf(c), id = (int)rintf(d);
    return ((unsigned)ia & 255u) | (((unsigned)ib & 255u) << 8) | (((unsigned)ic & 255u) << 16) | ((unsigned)id << 24); }
__device__ __forceinline__ void row4096_to_i8(const float* src, unsigned char* dst, float* sc_out, int lane) {
    const GAS f32x4* xr = (const GAS f32x4*)src + lane;
    f32x4 v[16]; float am = 0.f;
#pragma unroll
    for (int j = 0; j < 16; ++j) { v[j] = xr[64 * j]; am = fmaxf(am, fmaxf(fmaxf(fabsf(v[j].x), fabsf(v[j].y)), fmaxf(fabsf(v[j].z), fabsf(v[j].w)))); }
#pragma unroll
    for (int o = 1; o < 64; o <<= 1) am = fmaxf(am, __shfl_xor(am, o));
    const float q = (am > 0.f) ? 127.0f / am : 1.0f;
    GAS unsigned* o4 = (GAS unsigned*)dst + lane;
#pragma unroll
    for (int j = 0; j < 16; ++j) o4[64 * j] = pack_i8x4(v[j].x * q, v[j].y * q, v[j].z * q, v[j].w * q);
    if (lane == 0) *sc_out = (am > 0.f) ? am * (1.0f / 127.0f) : 1.0f;
}
__device__ __forceinline__ void p0_prologue(Frame& F) {
    LAS float* scr = (LAS float*)(F.lds + F.wave * 16384);
    const int gw = F.vcu * NWAVES + F.wave, NGW = F.G * NWAVES;
    bf16* WS = (bf16*)F.ws;
    const float qs_in = WIN_QS;
    constexpr int I_IN = 64 * (NIN / 32), I_OUT = 64 * 128, I_CKV = 64 * 256, I_CO = 64 * 128, I_PQ = 64 * 64;
    constexpr int NITEMS = I_IN + I_OUT + I_CKV + I_CO + I_PQ;
    for (int it = gw; it < NITEMS; it += NGW) {
        int r = it;
        if (r < I_IN) { const int nb = r % (NIN / 32), kb = r / (NIN / 32), seg = nb >> 6;
            if ((FP8_SEGS >> seg) & 1) p0_transpose_item_fp8(F.ka->in[3], D, NIN, F.ws + WS_WIN8, qs_in, scr, kb * (NIN / 32) + nb, F.lane);
            else p0_transpose_item(F.ka->in[3], D, NIN, (bf16*)(F.ws + WS_WIN), nullptr, scr, kb * (NIN / 32) + nb, F.lane);
            continue; } r -= I_IN;
        if (r < I_OUT) { p0_transpose_item_fp8(F.ka->in[11], D, D, F.ws + WS_WOUT, WIN_QS, scr, r, F.lane); continue; } r -= I_OUT;
        if (r < I_CKV) { p0_transpose_item_fp8(F.ka->in[15], D, 2 * D, F.ws + WS_WCKV, WIN_QS, scr, r, F.lane); continue; } r -= I_CKV;
        if (r < I_CO) { p0_transpose_item_fp8(F.ka->in[16], D, D, F.ws + WS_WCO, WIN_QS, scr, r, F.lane); continue; } r -= I_CO;
        p0_transpose_item_fp8(F.ka->in[18], D, 2048, F.ws + WS_WPQ, WIN_QS, scr, r, F.lane, F.ka->in[17]);
    }
    (void)WS;
    constexpr int R_X = M, R_MEM = MROWS, R_CQ = D, R_DOWN = NEXP, R_UP = NEXP, R_SK = 64;
    constexpr int NROWS = R_X + R_MEM + R_CQ + R_DOWN + R_UP + R_SK;
    for (int it = gw; it < NROWS; it += NGW) {
        int r = it;
        if (r < R_X) { row4096_norm_to_fp8(F.ka->in[0] + (size_t)r * D, F.ka->in[2], F.ws + WS_XN8 + (size_t)r * D, (bf16*)(F.ws + WS_XN) + (size_t)r * D, (float*)(F.ws + WS_SA) + r, F.lane); continue; } r -= R_X;
        if (r < R_MEM) { row4096_to_bf16(F.ka->in[1] + (size_t)r * D, nullptr, F.ka->in[13], 1.f, 1, F.lane, F.ws + WS_MEMN + (size_t)r * D, KV_Q8); continue; } r -= R_MEM;
        if (r < R_CQ) { row4096_to_bf16(F.ka->in[14] + (size_t)r * D, nullptr, nullptr, F.ka->in[12][r], 0, F.lane, F.ws + WS_WCQ + (size_t)r * D, WIN_QS); continue; } r -= R_CQ;
        if (r < R_DOWN) { row4096_to_i8(F.ka->in[20] + (size_t)r * D, F.ws + WS_DOWN + (size_t)r * D, (float*)(F.ws + WS_DSC) + r, F.lane); continue; } r -= R_DOWN;
        if (r < R_UP) { row4096_to_fp4(F.ka->in[21] + (size_t)r * D, F.ws + WS_UP + (size_t)r * 2048, (float*)(F.ws + WS_USC) + r, F.lane); continue; }        r -= R_UP;
        row4096_to_bf16(F.ka->in[19] + (size_t)r * D, (bf16*)(F.ws + WS_SUBK) + (size_t)r * D, nullptr, 1.f, 0, F.lane);
    }
}

#define DPP_MUL(d, a, b, J) asm volatile("v_mul_f32_dpp %0, %1, %2 row_newbcast:" #J " row_mask:0xf bank_mask:0xf" : "=v"(d) : "v"(a), "v"(b))
#define DPP_FMAC(d, a, b, J) asm volatile("v_fmac_f32_dpp %0, %1, %2 row_newbcast:" #J " row_mask:0xf bank_mask:0xf" : "+v"(d) : "v"(a), "v"(b))
constexpr int HG_T = 32, HG_P = 36;
#define HG_STEP(QV, FV, KV, IV, TT) { float u0_, u1_, u2_, u3_, u4_, u5_, u6_, u7_, a0 = 0.f, a1 = 0.f; \
    asm volatile("s_nop 1\n\tv_mul_f32_dpp %0, %1, %2 row_newbcast:0 row_mask:0xf bank_mask:0xf" : "=v"(u0_) : "v"(FV), "v"(s[0]), "v"(QV), "v"(KV)); \
    DPP_MUL(u1_, FV, s[1], 1); DPP_MUL(u2_, FV, s[2], 2); DPP_MUL(u3_, FV, s[3], 3); DPP_MUL(u4_, FV, s[4], 4); DPP_MUL(u5_, FV, s[5], 5); DPP_MUL(u6_, FV, s[6], 6); DPP_MUL(u7_, FV, s[7], 7); \
    DPP_FMAC(u0_, KV, IV, 0); DPP_FMAC(u1_, KV, IV, 1); DPP_FMAC(u2_, KV, IV, 2); DPP_FMAC(u3_, KV, IV, 3); DPP_FMAC(u4_, KV, IV, 4); DPP_FMAC(u5_, KV, IV, 5); DPP_FMAC(u6_, KV, IV, 6); DPP_FMAC(u7_, KV, IV, 7); \
    DPP_FMAC(a0, QV, u0_, 0); DPP_FMAC(a1, QV, u1_, 1); DPP_FMAC(a0, QV, u2_, 2); DPP_FMAC(a1, QV, u3_, 3); DPP_FMAC(a0, QV, u4_, 4); DPP_FMAC(a1, QV, u5_, 5); DPP_FMAC(a0, QV, u6_, 6); DPP_FMAC(a1, QV, u7_, 7); \
    s[0] = u0_; s[1] = u1_; s[2] = u2_; s[3] = u3_; s[4] = u4_; s[5] = u5_; s[6] = u6_; s[7] = u7_; Pl[pslot + (TT) * 32] = a0 + a1; }
__device__ __forceinline__ void hgrn_unit(Frame& F, int b, int h, int vq) {
    const int tid = F.tid, lane = F.lane, w = F.wave;
    LAS float* Ql = (LAS float*)F.lds; LAS float* Fl = Ql + 128 * HG_P; LAS float* Kl = Fl + 128 * HG_P; LAS float* Il = Kl + 128 * HG_P; LAS float* Pl = Il + 32 * HG_P;
    const bf16* Pb = (const bf16*)(F.ws + WS_PROJ) + (size_t)b * SEQ * NIN;
    bf16* MIX = (bf16*)(F.ws + WS_XN); float* HSSQ = (float*)(F.ws + WS_HSSQ);
    const int lrow = tid & 31, lseg = tid >> 5;
    const bf16* qsrc = Pb + (size_t)lrow * NIN + COL_HQ + h * 128 + lseg * 8;
    const bf16* ksrc = Pb + (size_t)lrow * NIN + COL_HF + h * 128 + lseg * 8;
    const int iseg = (tid >> 5) & 3;
    const bf16* isrc = Pb + (size_t)lrow * NIN + COL_HI + h * 128 + vq * 32 + iseg * 8;
    float s[8];
#pragma unroll
    for (int j = 0; j < 8; ++j) s[j] = 0.f;
    v4u rq = *(const GAS v4u*)qsrc, rk = *(const GAS v4u*)ksrc, ri = (v4u){0u, 0u, 0u, 0u};
    if (tid < 128) ri = *(const GAS v4u*)isrc;
    const int idxq = (16 * w + 8 * (lane >> 5) + (lane & 7)) * HG_P, idxi = (lane & 31) * HG_P;
    const int pslot = (w * 2 + (lane >> 5)) * HG_T * 32 + (lane & 31);
    constexpr int NCH = SEQ / HG_T;
    __syncthreads();
    for (int c = 0; c < NCH; ++c) {
        {
            const unsigned qa[4] = {rq.x, rq.y, rq.z, rq.w}, ka[4] = {rk.x, rk.y, rk.z, rk.w}, ia[4] = {ri.x, ri.y, ri.z, ri.w};
            const int o = (lseg * 8) * HG_P + lrow;
#pragma unroll
            for (int j = 0; j < 4; ++j) { const float q0 = bflo(qa[j]), q1 = bfhi(qa[j]), k0 = bflo(ka[j]), k1 = bfhi(ka[j]);
                Ql[o + (2 * j) * HG_P] = q0; Ql[o + (2 * j + 1) * HG_P] = q1; Kl[o + (2 * j) * HG_P] = k0; Kl[o + (2 * j + 1) * HG_P] = k1; Fl[o + (2 * j) * HG_P] = 1.0f - k0; Fl[o + (2 * j + 1) * HG_P] = 1.0f - k1; }
            if (tid < 128) { const int oi = (iseg * 8) * HG_P + lrow;
#pragma unroll
                for (int j = 0; j < 4; ++j) { Il[oi + (2 * j) * HG_P] = bflo(ia[j]); Il[oi + (2 * j + 1) * HG_P] = bfhi(ia[j]); } }
        }
        if (c + 1 < NCH) { const size_t adv = (size_t)(c + 1) * HG_T * NIN; rq = *(const GAS v4u*)(qsrc + adv); rk = *(const GAS v4u*)(ksrc + adv); if (tid < 128) ri = *(const GAS v4u*)(isrc + adv); }
        __syncthreads();
        f32x4 qv = *(const LAS f32x4*)(Ql + idxq), fv = *(const LAS f32x4*)(Fl + idxq), kv = *(const LAS f32x4*)(Kl + idxq), iv = *(const LAS f32x4*)(Il + idxi);
#pragma unroll 2
        for (int t4 = 0; t4 < HG_T; t4 += 4) {
            const int tn = (t4 + 4 < HG_T) ? t4 + 4 : t4;
            const f32x4 qn = *(const LAS f32x4*)(Ql + idxq + tn), fn = *(const LAS f32x4*)(Fl + idxq + tn), kn = *(const LAS f32x4*)(Kl + idxq + tn), in_ = *(const LAS f32x4*)(Il + idxi + tn);
            HG_STEP(qv.x, fv.x, kv.x, iv.x, t4 + 0)
            HG_STEP(qv.y, fv.y, kv.y, iv.y, t4 + 1)
            HG_STEP(qv.z, fv.z, kv.z, iv.z, t4 + 2)
            HG_STEP(qv.w, fv.w, kv.w, iv.w, t4 + 3)
            qv = qn; fv = fn; kv = kn; iv = in_;
        }
        __syncthreads();
        {
            const int t = tid >> 4, vp = tid & 15; typedef float f32x2v __attribute__((ext_vector_type(2)));
            f32x2v o = {0.f, 0.f};
#pragma unroll
            for (int p = 0; p < 16; ++p) { const f32x2v x = *(LAS f32x2v*)(Pl + (p * HG_T + t) * 32 + 2 * vp); o += x; }
            const size_t grow = (size_t)b * SEQ + (size_t)c * HG_T + t;
            *(GAS unsigned*)(MIX + grow * D + 2048 + h * 128 + vq * 32 + 2 * vp) = pk2(o.x, o.y);
            float ss = o.x * o.x + o.y * o.y;
            ss += __shfl_xor(ss, 1); ss += __shfl_xor(ss, 2); ss += __shfl_xor(ss, 4); ss += __shfl_xor(ss, 8);
            if (vp == 0) HSSQ[grow * 64 + h * 4 + vq] = ss;
        }
    }
    __syncthreads();
}
#define DPPX(v, ctrl) __builtin_amdgcn_update_dpp(0, (v), (ctrl), 0xf, 0xf, false)
typedef short s16x4 __attribute__((ext_vector_type(4)));
#define MFMA16K16(a, b, c) __builtin_amdgcn_mfma_f32_16x16x16bf16_1k((a), (b), (c), 0, 0, 0)
#define MFMA16K32(a, b, c) __builtin_amdgcn_mfma_f32_16x16x32_bf16((a), (b), (c), 0, 0, 0)
constexpr int HM_P = 272;
constexpr int HM_NS = 4, HM_BLK = 39936;
__device__ __forceinline__ void hgrn_unit_mfma(Frame& F, int b, int h, int vq) {
    const int tid = F.tid, lane = F.lane, w = F.wave, l15 = lane & 15, kg = lane >> 4;
    const bf16* Pb = (const bf16*)(F.ws + WS_PROJ) + (size_t)b * SEQ * NIN;
    bf16* MIX = (bf16*)(F.ws + WS_XN); float* HSSQ = (float*)(F.ws + WS_HSSQ);
    const int lt = tid >> 5, ls = tid & 31;
    const bf16* qksrc = Pb + (size_t)lt * NIN + (ls < 16 ? COL_HQ : COL_HF) + h * 128 + (ls & 15) * 8;
    const bf16* isrc = Pb + (size_t)((tid >> 2) & 15) * NIN + COL_HI + h * 128 + vq * 32 + (tid & 3) * 8;
    v4u rqk[HM_NS], ri[HM_NS];
#pragma unroll
    for (int u = 0; u < HM_NS; ++u) { rqk[u] = *(const GAS v4u*)(qksrc + (size_t)u * 16 * NIN); ri[u] = (v4u){0u, 0u, 0u, 0u}; if (tid < 64) ri[u] = *(const GAS v4u*)(isrc + (size_t)u * 16 * NIN); }
    f32x4 S[2] = {(f32x4){0.f, 0.f, 0.f, 0.f}, (f32x4){0.f, 0.f, 0.f, 0.f}};
    constexpr int NIT = SEQ / (16 * HM_NS);
    __syncthreads();
    for (int c = 0; c < NIT; ++c) {
#pragma unroll
        for (int u = 0; u < HM_NS; ++u) { LAS unsigned char* L = F.lds + u * HM_BLK;
            *(LAS v4u*)((LAS unsigned short*)(L + (ls < 16 ? 0 : 4096)) + lt * 128 + (ls & 15) * 8) = rqk[u];
            if (tid < 64) *(LAS v4u*)((LAS unsigned short*)(L + 8192) + (tid >> 2) * 32 + (tid & 3) * 8) = ri[u]; }
        if (c + 1 < NIT) {
#pragma unroll
            for (int u = 0; u < HM_NS; ++u) { const size_t adv = (size_t)((c + 1) * HM_NS + u) * 16 * NIN; rqk[u] = *(const GAS v4u*)(qksrc + adv); if (tid < 64) ri[u] = *(const GAS v4u*)(isrc + adv); } }
        __syncthreads();
#pragma unroll
        for (int u = 0; u < HM_NS; ++u) {
            LAS unsigned char* L = F.lds + u * HM_BLK;
            LAS unsigned short* RAWQ = (LAS unsigned short*)L; LAS unsigned short* RAWK = (LAS unsigned short*)(L + 4096); LAS unsigned short* RAWI = (LAS unsigned short*)(L + 8192);
            LAS unsigned char* QT = L + 9216; LAS unsigned char* KT = L + 13568; LAS unsigned short* KH = (LAS unsigned short*)(L + 17920); LAS unsigned short* IT = (LAS unsigned short*)(L + 22016); LAS float* D16 = (LAS float*)(L + 23040);
            const int d = tid >> 2, tq = tid & 3;
            float qv[4], kv[4], cs[4]; float run = 0.f;
#pragma unroll
            for (int j = 0; j < 4; ++j) { const int t = 4 * tq + j; qv[j] = bf2f(RAWQ[t * 128 + d]); kv[j] = bf2f(RAWK[t * 128 + d]); run += __log2f(fmaxf(1.0f - kv[j], 1.0e-6f)); cs[j] = run; }
            const float t0 = __int_as_float(DPPX(__float_as_int(run), 0x00)), t1 = __int_as_float(DPPX(__float_as_int(run), 0x55)), t2 = __int_as_float(DPPX(__float_as_int(run), 0xAA)), t3 = __int_as_float(DPPX(__float_as_int(run), 0xFF));
            const float off = (tq > 0 ? t0 : 0.f) + (tq > 1 ? t1 : 0.f) + (tq > 2 ? t2 : 0.f), b16 = (t0 + t1) + (t2 + t3);
#pragma unroll
            for (int j = 0; j < 4; ++j) { const int t = 4 * tq + j; const float bt = off + cs[j];
                *(LAS unsigned short*)(QT + t * HM_P + d * 2) = (unsigned short)f2bf(qv[j] * __builtin_amdgcn_exp2f(bt));
                *(LAS unsigned short*)(KT + t * HM_P + d * 2) = (unsigned short)f2bf(kv[j] * __builtin_amdgcn_exp2f(-bt));
                KH[d * 16 + t] = (unsigned short)f2bf(kv[j] * __builtin_amdgcn_exp2f(b16 - bt)); }
            if (tq == 0) D16[d] = __builtin_amdgcn_exp2f(b16);
            IT[(tid & 31) * 16 + (tid >> 5)] = RAWI[(tid >> 5) * 32 + (tid & 31)];
        }
        __syncthreads();
#pragma unroll
        for (int u = 0; u < HM_NS; ++u) {
            LAS unsigned char* L = F.lds + u * HM_BLK;
            LAS unsigned char* QT = L + 9216; LAS unsigned char* KT = L + 13568; LAS unsigned short* KH = (LAS unsigned short*)(L + 17920); LAS unsigned short* IT = (LAS unsigned short*)(L + 22016); LAS float* D16 = (LAS float*)(L + 23040); LAS float* PART = (LAS float*)(L + 23552);
            typedef unsigned u32x2v __attribute__((ext_vector_type(2)));
            const s16x4 aq = *(const LAS s16x4*)(QT + l15 * HM_P + (16 * w + 4 * kg) * 2);
            const s16x4 bi0 = *(const LAS s16x4*)(IT + l15 * 16 + 4 * kg), bi1 = *(const LAS s16x4*)(IT + (16 + l15) * 16 + 4 * kg);
            f32x4 O0 = {0.f, 0.f, 0.f, 0.f}, O1 = O0;
            { const s16x4 bs0 = __builtin_bit_cast(s16x4, (u32x2v){pg8::cvt_pk_bf16(S[0][0], S[0][1]), pg8::cvt_pk_bf16(S[0][2], S[0][3])}), bs1 = __builtin_bit_cast(s16x4, (u32x2v){pg8::cvt_pk_bf16(S[1][0], S[1][1]), pg8::cvt_pk_bf16(S[1][2], S[1][3])});
              O0 = MFMA16K16(aq, bs0, O0); O1 = MFMA16K16(aq, bs1, O1); }
            if (w == u) {
                f32x4 at = {0.f, 0.f, 0.f, 0.f};
#pragma unroll
                for (int ks = 0; ks < 4; ++ks) { const bf16x8 ak = *(const LAS bf16x8*)(KT + l15 * HM_P + (32 * ks + 8 * kg) * 2), bq = *(const LAS bf16x8*)(QT + l15 * HM_P + (32 * ks + 8 * kg) * 2); at = MFMA16K32(ak, bq, at); }
#pragma unroll
                for (int r = 0; r < 4; ++r) if (4 * kg + r > l15) at[r] = 0.f;
                const s16x4 aA = __builtin_bit_cast(s16x4, (u32x2v){pg8::cvt_pk_bf16(at[0], at[1]), pg8::cvt_pk_bf16(at[2], at[3])});
                O0 = MFMA16K16(aA, bi0, O0); O1 = MFMA16K16(aA, bi1, O1);
            }
            LAS float* pp = PART + (w * 16 + 4 * kg) * 32 + l15;
#pragma unroll
            for (int r = 0; r < 4; ++r) { pp[r * 32] = O0[r]; pp[r * 32 + 16] = O1[r]; }
            const f32x4 d4 = *(const LAS f32x4*)(D16 + 16 * w + 4 * kg);
            const s16x4 akh = *(const LAS s16x4*)(KH + (16 * w + l15) * 16 + 4 * kg);
            S[0] = MFMA16K16(akh, bi0, S[0] * d4); S[1] = MFMA16K16(akh, bi1, S[1] * d4);
        }
        __syncthreads();
        {
            const int t = (tid >> 4) & 15, vp = tid & 15; typedef float f32x2v __attribute__((ext_vector_type(2)));
#pragma unroll
            for (int u = tid >> 8; u < HM_NS; u += 2) {
            const LAS float* PART = (const LAS float*)(F.lds + u * HM_BLK + 23552);
            f32x2v o = {0.f, 0.f};
#pragma unroll
            for (int p = 0; p < 8; ++p) { const f32x2v x = *(const LAS f32x2v*)(PART + (p * 16 + t) * 32 + 2 * vp); o += x; }
            const size_t grow = (size_t)b * SEQ + (size_t)(c * HM_NS + u) * 16 + t;
            *(GAS unsigned*)(MIX + grow * D + 2048 + h * 128 + vq * 32 + 2 * vp) = pk2(o.x, o.y);
            float ss = o.x * o.x + o.y * o.y;
            ss += __shfl_xor(ss, 1); ss += __shfl_xor(ss, 2); ss += __shfl_xor(ss, 4); ss += __shfl_xor(ss, 8);
            if (vp == 0) HSSQ[grow * 64 + h * 4 + vq] = ss;
            }
        }
    }
    __syncthreads();
}
#define HBAR() asm volatile("s_waitcnt lgkmcnt(0)\n\ts_barrier" ::: "memory")
constexpr int HH_NS = 4, HH_BLK = 37888;
__device__ __forceinline__ void hgrn_head_mfma(Frame& F, int b, int h) {
    const int tid = F.tid, lane = F.lane, w = F.wave, l15 = lane & 15, kg = lane >> 4;
    const bf16* Pb = (const bf16*)(F.ws + WS_PROJ) + (size_t)b * SEQ * NIN;
    bf16* MIX = (bf16*)(F.ws + WS_XN); const float* ng = F.ka->in[10];
    const int pp = tid & 255, pst = pp >> 4, psg = pp & 15;
    const bf16* qksrc = Pb + (size_t)pst * NIN + (tid < 256 ? COL_HQ : COL_HF) + h * 128 + psg * 8;
    const bf16* isrc = Pb + (size_t)pst * NIN + COL_HI + h * 128 + psg * 8;
    v4u rqk[HH_NS], ri[HH_NS];
#pragma unroll
    for (int u = 0; u < HH_NS; ++u) { rqk[u] = *(const GAS v4u*)(qksrc + (size_t)u * 16 * NIN); ri[u] = (v4u){0u, 0u, 0u, 0u}; if (tid < 256) ri[u] = *(const GAS v4u*)(isrc + (size_t)u * 16 * NIN); }
    f32x4 S[8];
#pragma unroll
    for (int j = 0; j < 8; ++j) S[j] = (f32x4){0.f, 0.f, 0.f, 0.f};
    f32x4 n0 = *(const GAS f32x4*)(ng + 8 * (tid & 15)), n1 = *(const GAS f32x4*)(ng + 8 * (tid & 15) + 4);
    asm volatile("" : "+v"(n0), "+v"(n1));
    constexpr int NIT = SEQ / (16 * HH_NS);
    __syncthreads();
    for (int c = 0; c < NIT; ++c) {
#pragma unroll
        for (int u = 0; u < HH_NS; ++u) { LAS unsigned char* L = F.lds + u * HH_BLK;
            *(LAS v4u*)((LAS unsigned short*)(L + (tid < 256 ? 0 : 4096)) + pst * 128 + psg * 8) = rqk[u];
            if (tid < 256) *(LAS v4u*)((LAS unsigned short*)(L + 8192) + pst * 128 + psg * 8) = ri[u]; }
#define HH_GLD(dst, ptr) asm volatile("global_load_dwordx4 %0, %1, off" : "=v"(dst) : "v"(ptr) : "memory")
        if (c + 1 < NIT) {
#pragma unroll
            for (int u = 0; u < HH_NS; ++u) { const size_t adv = (size_t)((c + 1) * HH_NS + u) * 16 * NIN; HH_GLD(rqk[u], qksrc + adv); if (tid < 256) HH_GLD(ri[u], isrc + adv); } }
        v4u gpre[2];
#pragma unroll
        for (int k = 0; k < 2; ++k) HH_GLD(gpre[k], Pb + ((size_t)(c * HH_NS + (tid >> 8) + 2 * k) * 16 + ((tid >> 4) & 15)) * NIN + COL_HG + h * 128 + 8 * (tid & 15));
#undef HH_GLD
        HBAR();
        {
            const int u = w >> 1, d = 64 * (w & 1) + lane;
            LAS unsigned char* L = F.lds + u * HH_BLK;
            LAS unsigned short* RAWQ = (LAS unsigned short*)L; LAS unsigned short* RAWK = (LAS unsigned short*)(L + 4096);
            LAS unsigned char* QT = L + 12288; LAS unsigned char* KT = L + 16640; LAS unsigned char* KHb = L + 20992; LAS float* D16 = (LAS float*)(L + 29184);
            float kv[16], cs[16]; float run = 0.f;
#pragma unroll
            for (int t = 0; t < 16; ++t) { kv[t] = bf2f(RAWK[t * 128 + d]); run += __log2f(fmaxf(1.0f - kv[t], 1.0e-6f)); cs[t] = run; }
            const float b16 = run;
            unsigned kh[8];
#pragma unroll
            for (int t = 0; t < 16; t += 2) {
                const float q0 = bf2f(RAWQ[t * 128 + d]), q1 = bf2f(RAWQ[(t + 1) * 128 + d]);
                *(LAS unsigned short*)(QT + t * HM_P + d * 2) = (unsigned short)f2bf(q0 * __builtin_amdgcn_exp2f(cs[t]));
                *(LAS unsigned short*)(QT + (t + 1) * HM_P + d * 2) = (unsigned short)f2bf(q1 * __builtin_amdgcn_exp2f(cs[t + 1]));
                *(LAS unsigned short*)(KT + t * HM_P + d * 2) = (unsigned short)f2bf(kv[t] * __builtin_amdgcn_exp2f(-cs[t]));
                *(LAS unsigned short*)(KT + (t + 1) * HM_P + d * 2) = (unsigned short)f2bf(kv[t + 1] * __builtin_amdgcn_exp2f(-cs[t + 1]));
                kh[t >> 1] = pk2(kv[t] * __builtin_amdgcn_exp2f(b16 - cs[t]), kv[t + 1] * __builtin_amdgcn_exp2f(b16 - cs[t + 1])); }
            *(LAS v4u*)(KHb + d * 32) = (v4u){kh[0], kh[1], kh[2], kh[3]}; *(LAS v4u*)(KHb + d * 32 + 16) = (v4u){kh[4], kh[5], kh[6], kh[7]};
            D16[d] = __builtin_amdgcn_exp2f(b16);
        }
        {
            const int u = tid >> 7, v = tid & 127;
            LAS unsigned char* L = F.lds + u * HH_BLK; LAS unsigned short* RAWI = (LAS unsigned short*)(L + 8192); LAS unsigned char* ITb = L + 25088;
            unsigned iw[8];
#pragma unroll
            for (int t = 0; t < 16; t += 2) iw[t >> 1] = (unsigned)RAWI[t * 128 + v] | ((unsigned)RAWI[(t + 1) * 128 + v] << 16);
            *(LAS v4u*)(ITb + v * 32) = (v4u){iw[0], iw[1], iw[2], iw[3]}; *(LAS v4u*)(ITb + v * 32 + 16) = (v4u){iw[4], iw[5], iw[6], iw[7]};
        }
        HBAR();
        typedef unsigned u32x2v __attribute__((ext_vector_type(2)));
        s16x4 aA[HH_NS];
#pragma unroll
        for (int u = 0; u < HH_NS; ++u) {
            LAS unsigned char* L = F.lds + u * HH_BLK; LAS unsigned char* QT = L + 12288; LAS unsigned char* KT = L + 16640;
            f32x4 at = {0.f, 0.f, 0.f, 0.f};
#pragma unroll
            for (int ks = 0; ks < 4; ++ks) { const bf16x8 ak = *(const LAS bf16x8*)(KT + l15 * HM_P + (32 * ks + 8 * kg) * 2), bq = *(const LAS bf16x8*)(QT + l15 * HM_P + (32 * ks + 8 * kg) * 2); at = MFMA16K32(ak, bq, at); }
#pragma unroll
            for (int r = 0; r < 4; ++r) if (4 * kg + r > l15) at[r] = 0.f;
            aA[u] = __builtin_bit_cast(s16x4, (u32x2v){pg8::cvt_pk_bf16(at[0], at[1]), pg8::cvt_pk_bf16(at[2], at[3])});
        }
#pragma unroll
        for (int u = 0; u < HH_NS; ++u) {
            LAS unsigned char* L = F.lds + u * HH_BLK;
            LAS unsigned char* QT = L + 12288; LAS unsigned short* KH = (LAS unsigned short*)(L + 20992); LAS unsigned short* IT = (LAS unsigned short*)(L + 25088); LAS float* D16 = (LAS float*)(L + 29184); LAS float* OUT = (LAS float*)(L + 29696);
            const s16x4 bi = *(const LAS s16x4*)(IT + (16 * w + l15) * 16 + 4 * kg);
            f32x4 O0 = {0.f, 0.f, 0.f, 0.f}, O1 = O0;
            O1 = MFMA16K16(aA[u], bi, O1);
#pragma unroll
            for (int j = 0; j < 8; j += 2) {
                const s16x4 aq0 = *(const LAS s16x4*)(QT + l15 * HM_P + (16 * j + 4 * kg) * 2), aq1 = *(const LAS s16x4*)(QT + l15 * HM_P + (16 * (j + 1) + 4 * kg) * 2);
                const s16x4 bs0 = __builtin_bit_cast(s16x4, (u32x2v){pg8::cvt_pk_bf16(S[j][0], S[j][1]), pg8::cvt_pk_bf16(S[j][2], S[j][3])});
                const s16x4 bs1 = __builtin_bit_cast(s16x4, (u32x2v){pg8::cvt_pk_bf16(S[j + 1][0], S[j + 1][1]), pg8::cvt_pk_bf16(S[j + 1][2], S[j + 1][3])});
                O0 = MFMA16K16(aq0, bs0, O0); O1 = MFMA16K16(aq1, bs1, O1); }
            const f32x4 O = O0 + O1;
            LAS float* op = OUT + (4 * kg) * 128 + 16 * w + l15;
#pragma unroll
            for (int r = 0; r < 4; ++r) op[r * 128] = O[r];
#pragma unroll
            for (int j = 0; j < 8; ++j) { const f32x4 d4 = *(const LAS f32x4*)(D16 + 16 * j + 4 * kg);
                const s16x4 akh = *(const LAS s16x4*)(KH + (16 * j + l15) * 16 + 4 * kg);
                S[j] = MFMA16K16(akh, bi, S[j] * d4); }
        }
        HBAR();
        asm volatile("s_waitcnt vmcnt(0)" ::: "memory");
        {
            const int t = (tid >> 4) & 15, vs = tid & 15;
#pragma unroll
            for (int k = 0; k < 2; ++k) { const int u = (tid >> 8) + 2 * k;
                const LAS float* OUT = (const LAS float*)(F.lds + u * HH_BLK + 29696);
                const size_t grow = (size_t)b * SEQ + (size_t)(c * HH_NS + u) * 16 + t;
                const v4u g = gpre[k];
                const f32x4 o0 = *(const LAS f32x4*)(OUT + t * 128 + 8 * vs), o1 = *(const LAS f32x4*)(OUT + t * 128 + 8 * vs + 4);
                float ss = ((o0.x * o0.x + o0.y * o0.y) + (o0.z * o0.z + o0.w * o0.w)) + ((o1.x * o1.x + o1.y * o1.y) + (o1.z * o1.z + o1.w * o1.w));
                ss += __shfl_xor(ss, 1); ss += __shfl_xor(ss, 2); ss += __shfl_xor(ss, 4); ss += __shfl_xor(ss, 8);
                const float rstd = __builtin_amdgcn_rsqf(ss * (1.f / 128.f) + EPS);
                typedef unsigned u32x2m __attribute__((ext_vector_type(2))); u32x2m r;
                r.x = pg8::pk_i8x4((f32x4){o0.x * rstd * n0.x * bflo(g.x), o0.y * rstd * n0.y * bfhi(g.x), o0.z * rstd * n0.z * bflo(g.y), o0.w * rstd * n0.w * bfhi(g.y)}, MIX_Q8);
                r.y = pg8::pk_i8x4((f32x4){o1.x * rstd * n1.x * bflo(g.z), o1.y * rstd * n1.y * bfhi(g.z), o1.z * rstd * n1.z * bflo(g.w), o1.w * rstd * n1.w * bfhi(g.w)}, MIX_Q8);
                *(GAS u32x2m*)(F.ws + WS_XN8 + grow * D + 2048 + h * 128 + 8 * vs) = r;
            }
        }
    }
    __syncthreads();
}
__device__ __forceinline__ void hgrn_fixup(Frame& F) {
    bf16* MIX = (bf16*)(F.ws + WS_XN); const float* HSSQ = (const float*)(F.ws + WS_HSSQ); const bf16* PROJ = (const bf16*)(F.ws + WS_PROJ); const float* ng = F.ka->in[10];
    const size_t total = (size_t)M * 256, stride = (size_t)F.G * NTHR;
    for (size_t idx = (size_t)F.vcu * NTHR + F.tid; idx < total; idx += stride) {
        const size_t row = idx >> 8; const int cg = (int)(idx & 255), hh = cg >> 4, col = cg * 8;
        const f32x4 q = *(const GAS f32x4*)(HSSQ + row * 64 + hh * 4);
        const float rstd = __builtin_amdgcn_rsqf(((q.x + q.y) + (q.z + q.w)) * (1.f / 128.f) + EPS);
        const v4u o = *(const GAS v4u*)(MIX + row * D + 2048 + col), g = *(const GAS v4u*)(PROJ + row * NIN + COL_HG + col);
        const f32x4 n0 = *(const GAS f32x4*)(ng + (col & 127)), n1 = *(const GAS f32x4*)(ng + (col & 127) + 4);
        v4u r;
        r.x = pk2(bflo(o.x) * rstd * n0.x * bflo(g.x), bfhi(o.x) * rstd * n0.y * bfhi(g.x)); r.y = pk2(bflo(o.y) * rstd * n0.z * bflo(g.y), bfhi(o.y) * rstd * n0.w * bfhi(g.y));
        r.z = pk2(bflo(o.z) * rstd * n1.x * bflo(g.z), bfhi(o.z) * rstd * n1.y * bfhi(g.z)); r.w = pk2(bflo(o.w) * rstd * n1.z * bflo(g.w), bfhi(o.w) * rstd * n1.w * bfhi(g.w));
        *(GAS v4u*)(MIX + row * D + 2048 + col) = r;
    }
}
typedef float f32x16 __attribute__((ext_vector_type(16)));
typedef short v4i16_t __attribute__((ext_vector_type(4)));
#define MFMA32(a, b, c) __builtin_amdgcn_mfma_f32_32x32x16_bf16((a), (b), (c), 0, 0, 0)
__device__ __forceinline__ int crow(int i, int hh) { return (i & 3) + 8 * (i >> 2) + 4 * hh; }
__device__ __forceinline__ float xhalf_max(float m) { auto rr = __builtin_amdgcn_permlane32_swap(__float_as_uint(m), __float_as_uint(m), false, false); return fmaxf(__uint_as_float(rr[0]), __uint_as_float(rr[1])); }
__device__ __forceinline__ float xhalf_sum(float m) { auto rr = __builtin_amdgcn_permlane32_swap(__float_as_uint(m), __float_as_uint(m), false, false); return __uint_as_float(rr[0]) + __uint_as_float(rr[1]); }
constexpr int AT_KP = 144, AT_VP = 320, AT_KB = 64 * AT_KP, AT_VB = 64 * AT_VP, AT_VOFF = 2 * AT_KB, AT_AOFF = AT_VOFF + 2 * AT_VB;
__device__ __forceinline__ void attn_unit(Frame& F, int b, int h, int qb, float lam) {
    const int tid = F.tid, lane = F.lane, w = F.wave, r = lane & 31, hh = lane >> 5;
    const bf16* Pb = (const bf16*)(F.ws + WS_PROJ) + (size_t)b * SEQ * NIN;
    LAS unsigned char* Kl = F.lds; LAS unsigned char* Vl = F.lds + AT_VOFF; LAS float* Al = (LAS float*)(F.lds + AT_AOFF) + w * 32;
    const int q0 = qb * 256 + w * 32, qpos = q0 + r;
    const float cs = exp2f(-0.5f * (float)(h + 1)) * LOG2E;
    const int NT = 4 * (qb + 1);
    float* scr = (float*)(F.ws + WS_ATT) + (size_t)blockIdx.x * 32768;
    const int i16 = lane & 15, q4 = i16 >> 2, p4 = i16 & 3, g16 = (lane >> 4) & 1;
    const int vrd = (4 * hh + q4) * AT_VP + 32 * g16 + 8 * p4;
    f32x16 O[4];
    for (int c = 0; c < 2; ++c) {
        bf16x8 qf[4];
#pragma unroll
        for (int s = 0; s < 4; ++s) qf[s] = *(const GAS bf16x8*)(Pb + (size_t)qpos * NIN + COL_DQ + h * 128 + c * 64 + 16 * s + 8 * hh);
#pragma unroll
        for (int d = 0; d < 4; ++d)
#pragma unroll
            for (int i = 0; i < 16; ++i) O[d][i] = 0.f;
        float mrun = -1.0e30f, lrun = 0.f;
        const int krow = tid >> 3, kseg = tid & 7, vrow = tid >> 4, vseg = tid & 15;
        const unsigned koff = (unsigned)(krow * NIN + kseg * 8) * 2u, voff = (unsigned)(vrow * NIN + vseg * 8) * 2u;
        const char* kbase = (const char*)(Pb + COL_DK + h * 128 + c * 64); const char* vbase = (const char*)(Pb + COL_DV + h * 128);
        const int kdst = krow * AT_KP + kseg * 16, vdst = vrow * AT_VP + vseg * 16;
        v4u rkA, rv0A, rv1A, rkB, rv0B, rv1B;
#define AT_LD(S, TT) do { const size_t adv_ = (size_t)(TT) * 64 * NIN * 2; const char* kb2_ = kbase + adv_; const char* vb2_ = vbase + adv_; rk##S = *(const GAS v4u*)(kb2_ + koff); rv0##S = *(const GAS v4u*)(vb2_ + voff); rv1##S = *(const GAS v4u*)(vb2_ + (size_t)32 * NIN * 2 + voff); } while (0)
#define AT_ST(S, BB) do { *(LAS v4u*)(Kl + (BB) * AT_KB + kdst) = rk##S; *(LAS v4u*)(Vl + (BB) * AT_VB + vdst) = rv0##S; *(LAS v4u*)(Vl + (BB) * AT_VB + vdst + 32 * AT_VP) = rv1##S; } while (0)
        AT_LD(A, NT - 1);
        AT_LD(B, NT - 2);
        __syncthreads();
        AT_ST(A, 0);
        __syncthreads();
#define AT_ITER(IT, SLD, SST) do { const int it = (IT); \
            const int t = NT - 1 - it, buf = it & 1; \
            if (it + 2 < NT) AT_LD(SLD, t - 2); \
            if (64 * t <= q0 + 31) { \
                f32x16 st[2]; \
            _Pragma("unroll") \
                for (int nb = 0; nb < 2; ++nb) { \
            _Pragma("unroll") \
                    for (int i = 0; i < 16; ++i) st[nb][i] = 0.f; \
            _Pragma("unroll") \
                    for (int s = 0; s < 4; ++s) { const bf16x8 kf = *(const LAS bf16x8*)(Kl + buf * AT_KB + (32 * nb + r) * AT_KP + (16 * s + 8 * hh) * 2); st[nb] = MFMA32(kf, qf[s], st[nb]); } \
                } \
                const bool band = (64 * t + 63 > q0); \
                float cs_ = cs; asm volatile("" : "+v"(cs_)); \
                const float basev = cs_ * (float)(64 * t - qpos + 4 * hh); \
                float mx = -3.0e38f; \
                if (band) { \
                    const int thr = qpos - 64 * t - 4 * hh; \
            _Pragma("unroll") \
                    for (int nb = 0; nb < 2; ++nb) \
            _Pragma("unroll") \
                        for (int i = 0; i < 16; ++i) { const int kc = 32 * nb + (i & 3) + 8 * (i >> 2); float v = fmaf(cs_, (float)kc, st[nb][i]); \
                            if (kc > thr) v = -1.0e30f; st[nb][i] = v; mx = fmaxf(mx, v); } \
                } else { \
            _Pragma("unroll") \
                    for (int nb = 0; nb < 2; ++nb) \
            _Pragma("unroll") \
                        for (int i = 0; i < 16; ++i) { const int kc = 32 * nb + (i & 3) + 8 * (i >> 2); const float v = fmaf(cs_, (float)kc, st[nb][i]); st[nb][i] = v; mx = fmaxf(mx, v); } \
                } \
                const float mxt = xhalf_max(mx + basev); \
                if (__builtin_amdgcn_ballot_w64(mxt > mrun + 8.0f) != 0ull) { \
                    const float mnew = fmaxf(mrun, mxt), alpha = __builtin_amdgcn_exp2f(mrun - mnew); mrun = mnew; lrun *= alpha; \
                    if (hh == 0) Al[r] = alpha; \
                    f32x4 a4[4]; \
            _Pragma("unroll") \
                    for (int g = 0; g < 4; ++g) a4[g] = *(const LAS f32x4*)(Al + 8 * g + 4 * hh); \
            _Pragma("unroll") \
                    for (int d = 0; d < 4; ++d) \
            _Pragma("unroll") \
                        for (int i = 0; i < 16; ++i) O[d][i] *= a4[i >> 2][i & 3]; \
                } \
                const float mref = mrun - basev; \
                float rs = 0.f; \
            _Pragma("unroll") \
                for (int nb = 0; nb < 2; ++nb) \
            _Pragma("unroll") \
                    for (int i = 0; i < 16; ++i) { const float p = __builtin_amdgcn_exp2f(st[nb][i] - mref); st[nb][i] = p; rs += p; } \
                rs = xhalf_sum(rs); lrun += rs; \
            _Pragma("unroll") \
                for (int nb = 0; nb < 2; ++nb) \
            _Pragma("unroll") \
                    for (int s2 = 0; s2 < 2; ++s2) { \
                        v4u pw; pw.x = pg8::cvt_pk_bf16(st[nb][8 * s2 + 0], st[nb][8 * s2 + 1]); pw.y = pg8::cvt_pk_bf16(st[nb][8 * s2 + 2], st[nb][8 * s2 + 3]); \
                        pw.z = pg8::cvt_pk_bf16(st[nb][8 * s2 + 4], st[nb][8 * s2 + 5]); pw.w = pg8::cvt_pk_bf16(st[nb][8 * s2 + 6], st[nb][8 * s2 + 7]); \
                        const bf16x8 pf = __builtin_bit_cast(bf16x8, pw); \
                        const LAS unsigned char* vb = Vl + buf * AT_VB + (32 * nb + 16 * s2) * AT_VP + vrd; \
            _Pragma("unroll") \
                        for (int d = 0; d < 4; ++d) { \
                            const v4i16_t lo = __builtin_amdgcn_ds_read_tr16_b64_v4i16((LAS v4i16_t*)(vb + d * 64)), hi = __builtin_amdgcn_ds_read_tr16_b64_v4i16((LAS v4i16_t*)(vb + d * 64 + 8 * AT_VP)); \
                            const bf16x8 vf = __builtin_shufflevector(lo, hi, 0, 1, 2, 3, 4, 5, 6, 7); \
                            O[d] = MFMA32(pf, vf, O[d]); \
                        } \
                    } \
            } \
            if (it + 1 < NT) AT_ST(SST, buf ^ 1); \
            HBAR(); } while (0)
#pragma unroll 1
        for (int it2 = 0; it2 < NT; it2 += 2) { AT_ITER(it2, A, B); AT_ITER(it2 + 1, B, A); }
#undef AT_ITER
#undef AT_LD
#undef AT_ST
        if (hh == 0) Al[r] = 1.0f / lrun;
        f32x4 a4[4];
#pragma unroll
        for (int g = 0; g < 4; ++g) a4[g] = *(const LAS f32x4*)(Al + 8 * g + 4 * hh);
        float* sp = scr + tid * 64; asm volatile("" : "+v"(sp));
        if (c == 0) {
#pragma unroll
            for (int d = 0; d < 4; ++d)
#pragma unroll
                for (int g = 0; g < 4; ++g) *(GAS f32x4*)(sp + d * 16 + 4 * g) = (f32x4){O[d][4 * g], O[d][4 * g + 1], O[d][4 * g + 2], O[d][4 * g + 3]} * a4[g];
        } else {
            asm volatile("s_waitcnt vmcnt(0)" ::: "memory");
#pragma unroll
            for (int d = 0; d < 4; ++d)
#pragma unroll
                for (int g = 0; g < 4; ++g) { const f32x4 o0 = *(const GAS f32x4*)(sp + d * 16 + 4 * g);
#pragma unroll
                    for (int j = 0; j < 4; ++j) O[d][4 * g + j] = o0[j] - lam * (O[d][4 * g + j] * a4[g][j]); }
        }
    }
    const float* sg = F.ka->in[8]; bf16* MIX = (bf16*)(F.ws + WS_XN);
    float gcol[4];
#pragma unroll
    for (int d = 0; d < 4; ++d) gcol[d] = sg[d * 32 + r] * 0.8f;
    unsigned char* obase = F.ws + WS_XN8 + ((size_t)b * SEQ + q0 + 4 * hh) * D + h * 128 + r; asm volatile("" : "+v"(obase));
#pragma unroll
    for (int i = 0; i < 16; ++i) {
        float p = (O[0][i] * O[0][i] + O[1][i] * O[1][i]) + (O[2][i] * O[2][i] + O[3][i] * O[3][i]);
        p += __shfl_xor(p, 1); p += __shfl_xor(p, 2); p += __shfl_xor(p, 4); p += __shfl_xor(p, 8); p += __shfl_xor(p, 16);
        const float rstd = __builtin_amdgcn_rsqf(p * (1.f / 128.f) + EPS);
        unsigned char* orow = obase + (size_t)((i & 3) + 8 * (i >> 2)) * D;
#pragma unroll
        for (int d = 0; d < 4; ++d) orow[d * 32] = (unsigned char)(int)rintf(__builtin_amdgcn_fmed3f(O[d][i] * rstd * gcol[d] * MIX_Q8, -127.f, 127.f));
    }
}
__device__ __forceinline__ int row16_max_i(int x) {
    x = max(x, DPPX(x, 0xB1)); x = max(x, DPPX(x, 0x4E)); x = max(x, DPPX(x, 0x141)); x = max(x, DPPX(x, 0x140)); return x; }
__device__ __forceinline__ float row16_sum_f(float x) {
    x += __int_as_float(DPPX(__float_as_int(x), 0xB1)); x += __int_as_float(DPPX(__float_as_int(x), 0x4E)); x += __int_as_float(DPPX(__float_as_int(x), 0x141)); x += __int_as_float(DPPX(__float_as_int(x), 0x140)); return x; }
__device__ __forceinline__ int f2sort(float f) { const int b = __float_as_int(f); return b ^ ((b >> 31) & 0x7fffffff); }
__device__ __forceinline__ float sort2f(int k) { return __int_as_float(k ^ ((k >> 31) & 0x7fffffff)); }
__device__ __forceinline__ void topk_phase(Frame& F) {
    const int tid = F.tid, lane = F.lane, w = F.wave, r = lane & 31, hh = lane >> 5, g16 = tid >> 4, l16 = tid & 15;
    LAS float* Sl = (LAS float*)F.lds;
    LAS float* SV = (LAS float*)(F.lds + 65536);
    LAS int* SI = (LAS int*)(F.lds + 65536 + 8192);
    const bf16* QP = (const bf16*)(F.ws + WS_WIN); const bf16* SUBK = (const bf16*)(F.ws + WS_SUBK);
    int* EIDX = (int*)(F.ws + WS_EIDX); float* GATE = (float*)(F.ws + WS_GATE);
#define TK_GLD(dst, ptr, off) asm volatile("global_load_dwordx4 %0, %1, off offset:" #off : "=v"(dst) : "v"(ptr) : "memory")
#define TK_LOADS(itx) do { const int head_ = (itx) & 7, tile_ = (itx) >> 3; \
        const bf16* Q_ = QP + (size_t)(tile_ * 64 + r) * 2048 + head_ * 256 + (w >> 2) * 128 + 8 * hh; const bf16* Q1_ = Q_ + (size_t)32 * 2048; \
        const bf16* SK_ = SUBK + ((size_t)(head_ * 2 + (w >> 2)) * 128 + 32 * (w & 3) + r) * 128 + 8 * hh; \
        TK_GLD(kf[0], SK_, 0); TK_GLD(q0[0], Q_, 0); TK_GLD(q1[0], Q1_, 0); TK_GLD(kf[1], SK_, 32); TK_GLD(q0[1], Q_, 32); TK_GLD(q1[1], Q1_, 32); \
        TK_GLD(kf[2], SK_, 64); TK_GLD(q0[2], Q_, 64); TK_GLD(q1[2], Q1_, 64); TK_GLD(kf[3], SK_, 96); TK_GLD(q0[3], Q_, 96); TK_GLD(q1[3], Q1_, 96); \
        TK_GLD(kf[4], SK_, 128); TK_GLD(q0[4], Q_, 128); TK_GLD(q1[4], Q1_, 128); TK_GLD(kf[5], SK_, 160); TK_GLD(q0[5], Q_, 160); TK_GLD(q1[5], Q1_, 160); \
        TK_GLD(kf[6], SK_, 192); TK_GLD(q0[6], Q_, 192); TK_GLD(q1[6], Q1_, 192); TK_GLD(kf[7], SK_, 224); TK_GLD(q0[7], Q_, 224); TK_GLD(q1[7], Q1_, 224); } while (0)
    bf16x8 kf[8], q0[8], q1[8];
    if (F.vcu < (M / 64) * PEER_H) TK_LOADS(F.vcu);
    for (int it = F.vcu; it < (M / 64) * PEER_H; it += F.G) {
        const int head = it & 7, tile = it >> 3;
        {
            const int c = w >> 2, kb = w & 3;
            f32x16 acc[2];
#pragma unroll
            for (int i = 0; i < 16; ++i) { acc[0][i] = 0.f; acc[1][i] = 0.f; }
            asm volatile("s_waitcnt vmcnt(0)" ::: "memory");
#pragma unroll
            for (int s = 0; s < 8; ++s) asm volatile("" : "+v"(kf[s]), "+v"(q0[s]), "+v"(q1[s]));
#pragma unroll
            for (int s = 0; s < 8; ++s) { acc[0] = MFMA32(q0[s], kf[s], acc[0]); acc[1] = MFMA32(q1[s], kf[s], acc[1]); }
            HBAR();
#pragma unroll
            for (int tb = 0; tb < 2; ++tb)
#pragma unroll
                for (int i = 0; i < 16; ++i) Sl[(32 * tb + crow(i, hh)) * 256 + c * 128 + 32 * kb + r] = acc[tb][i];
            if (it + F.G < (M / 64) * PEER_H) TK_LOADS(it + F.G);
        }
        HBAR();
#pragma unroll 1
        for (int rd = 0; rd < 4; ++rd) {
            const int row = rd * 32 + g16, tok = row >> 1, c = row & 1;
            int key[8];
#pragma unroll
            for (int s = 0; s < 8; ++s) { const int idx = s * 16 + l16; key[s] = (f2sort(Sl[tok * 256 + c * 128 + idx]) & ~127) | (127 - idx); }
#define TK_CE(i, j) do { const int hi_ = max(key[i], key[j]), lo_ = min(key[i], key[j]); key[i] = hi_; key[j] = lo_; } while (0)
            TK_CE(0, 1); TK_CE(2, 3); TK_CE(4, 5); TK_CE(6, 7); TK_CE(0, 2); TK_CE(1, 3); TK_CE(4, 6); TK_CE(5, 7); TK_CE(1, 2); TK_CE(5, 6); TK_CE(0, 4); TK_CE(3, 7);
            TK_CE(1, 5); TK_CE(2, 6); TK_CE(1, 4); TK_CE(3, 6); TK_CE(2, 4); TK_CE(3, 5); TK_CE(3, 4);
#undef TK_CE
            int mine = 0;
#pragma unroll 1
            for (int k = 0; k < 16; ++k) {
                const int m = row16_max_i(key[0]);
                if (l16 == k) mine = m;
                const bool pop = (key[0] == m);
#pragma unroll
                for (int s = 0; s < 7; ++s) key[s] = pop ? key[s + 1] : key[s];
                key[7] = pop ? (int)0x80000000 : key[7];
            }
            SV[(tok * 2 + c) * 16 + l16] = sort2f(mine & ~127); SI[(tok * 2 + c) * 16 + l16] = 127 - (mine & 127);
        }
        HBAR();
#pragma unroll 1
        for (int rd = 0; rd < 2; ++rd) {
            const int tok = rd * 32 + g16;
            const float sv0 = SV[(tok * 2) * 16 + l16];
            int ptr = 0;
            int key = (f2sort(sv0 + SV[(tok * 2 + 1) * 16]) & ~255) | (255 - (l16 * 16));
            int mine = 0;
#pragma unroll 1
            for (int k = 0; k < 16; ++k) {
                const int m = row16_max_i(key);
                if (l16 == k) mine = m;
                if (key == m) { ++ptr; key = (ptr < 16) ? ((f2sort(sv0 + SV[(tok * 2 + 1) * 16 + (ptr & 15)]) & ~255) | (255 - (l16 * 16 + ptr))) : (int)0x80000000; }
            }
            const int flat = 255 - (mine & 255), aw = flat >> 4, bw = flat & 15;
            const float best = sort2f(mine & ~255);
            const int e = SI[(tok * 2) * 16 + aw] * 128 + SI[(tok * 2 + 1) * 16 + bw];
            const float mx = sort2f(row16_max_i(mine) & ~255);
            const float ex = __expf(best - mx), sum = row16_sum_f(ex);
            const size_t o = (size_t)(tile * 64 + tok) * NSEL + head * 16 + l16;
            EIDX[o] = e; GATE[o] = ex / sum;
        }
    }
#undef TK_LOADS
#undef TK_GLD
    __syncthreads();
}
constexpr int PE_SH = 9, PE_NCH = NEXP >> PE_SH;
__device__ __forceinline__ int row16_sum_i(int x) { x += DPPX(x, 0xB1); x += DPPX(x, 0x4E); x += DPPX(x, 0x141); x += DPPX(x, 0x140); return x; }
__device__ __forceinline__ int wave_sum_i(int x) { x = row16_sum_i(x); return __builtin_amdgcn_readlane(x, 0) + __builtin_amdgcn_readlane(x, 16) + __builtin_amdgcn_readlane(x, 32) + __builtin_amdgcn_readlane(x, 48); }
__device__ __forceinline__ void peer_down_phase(Frame& F) {
    const int tid = F.tid, lane = F.lane, w = F.wave;
    LAS unsigned char* XQ = F.lds;
    LAS unsigned* LIST = (LAS unsigned*)(F.lds + 131072);
    LAS float* SX = (LAS float*)(F.lds + 131072 + 16384);
    LAS unsigned* CNT = (LAS unsigned*)(F.lds + 131072 + 16384 + 128);
    const float* gf = F.ka->in[17]; const float* SSQ2 = (const float*)(F.ws + WS_SSQ2); const unsigned char* DOWN = F.ws + WS_DOWN; const float* DSC = (const float*)(F.ws + WS_DSC);
    const int* EIDX = (const int*)(F.ws + WS_EIDX); const float* GATE = (const float*)(F.ws + WS_GATE); float* WSEL = (float*)(F.ws + WS_WSEL);
    for (int g = F.vcu; g < M / 32; g += F.G) {
        const int t0 = g * 32;
        __syncthreads();
        if (tid < 64) CNT[tid] = 0u;
#pragma unroll 1
        for (int k = 0; k < 4; ++k) {
            const int tl = w * 4 + k; const size_t t = (size_t)(t0 + tl);
            const float rstd = __builtin_amdgcn_rsqf(wave_sum(SSQ2[t * 64 + lane]) * (1.f / 4096.f) + EPS);
            const bf16* h2 = (const bf16*)(F.ws + WS_XN) + t * D;
            f32x4 x[16]; float am = 0.f;
#pragma unroll
            for (int i = 0; i < 4; ++i) { const int e0 = (i * 64 + lane) * 16; const v4u ha = *(const GAS v4u*)(h2 + e0), hb = *(const GAS v4u*)(h2 + e0 + 8);
                const f32x4 hv[4] = {(f32x4){bflo(ha.x), bfhi(ha.x), bflo(ha.y), bfhi(ha.y)}, (f32x4){bflo(ha.z), bfhi(ha.z), bflo(ha.w), bfhi(ha.w)}, (f32x4){bflo(hb.x), bfhi(hb.x), bflo(hb.y), bfhi(hb.y)}, (f32x4){bflo(hb.z), bfhi(hb.z), bflo(hb.w), bfhi(hb.w)}};
#pragma unroll
                for (int q = 0; q < 4; ++q) { const f32x4 v = hv[q] * *(const GAS f32x4*)(gf + e0 + 4 * q) * rstd; x[4 * i + q] = v;
                    am = fmaxf(am, fmaxf(fmaxf(fabsf(v.x), fabsf(v.y)), fmaxf(fabsf(v.z), fabsf(v.w)))); } }
#pragma unroll
            for (int o = 1; o < 64; o <<= 1) am = fmaxf(am, __shfl_xor(am, o));
            const float qs = (am > 0.f) ? 127.0f / am : 1.0f;
#pragma unroll
            for (int i = 0; i < 4; ++i) { v4u pk;
                pk.x = pack_i8x4(x[4 * i + 0].x * qs, x[4 * i + 0].y * qs, x[4 * i + 0].z * qs, x[4 * i + 0].w * qs); pk.y = pack_i8x4(x[4 * i + 1].x * qs, x[4 * i + 1].y * qs, x[4 * i + 1].z * qs, x[4 * i + 1].w * qs);
                pk.z = pack_i8x4(x[4 * i + 2].x * qs, x[4 * i + 2].y * qs, x[4 * i + 2].z * qs, x[4 * i + 2].w * qs); pk.w = pack_i8x4(x[4 * i + 3].x * qs, x[4 * i + 3].y * qs, x[4 * i + 3].z * qs, x[4 * i + 3].w * qs);
                *(LAS v4u*)(XQ + tl * 4096 + (i * 64 + lane) * 16) = pk; }
            if (lane == 0) SX[tl] = (am > 0.f) ? am * (1.0f / 127.0f) : 1.0f;
        }
        unsigned rec[8];
#pragma unroll
        for (int k = 0; k < 8; ++k) { const int r = tid + 512 * k, tl = r >> 7, j = r & 127; const unsigned e = (unsigned)EIDX[(size_t)(t0 + tl) * NSEL + j]; rec[k] = e | ((unsigned)tl << 14) | ((unsigned)j << 19); }
        __syncthreads();
#pragma unroll
        for (int k = 0; k < 8; ++k) (void)__hip_atomic_fetch_add((unsigned*)&CNT[(rec[k] & 16383u) >> PE_SH], 1u, __ATOMIC_RELAXED, __HIP_MEMORY_SCOPE_WORKGROUP);
        __syncthreads();
        if (tid == 0) { unsigned run = 0u; for (int c = 0; c < PE_NCH; ++c) { const unsigned n = CNT[c]; CNT[32 + c] = run; run += n; } }
        __syncthreads();
#pragma unroll
        for (int k = 0; k < 8; ++k) { const unsigned pos = __hip_atomic_fetch_add((unsigned*)&CNT[32 + ((rec[k] & 16383u) >> PE_SH)], 1u, __ATOMIC_RELAXED, __HIP_MEMORY_SCOPE_WORKGROUP); LIST[pos] = rec[k]; }
        __syncthreads();
#pragma unroll 1
        for (int p = w * 8; p < 4096; p += 64) {
            const unsigned myrec = LIST[p + (lane & 7)];
            const unsigned me = myrec & 16383u, mtl = (myrec >> 14) & 31u, mj = myrec >> 19;
            const size_t oidx = (size_t)(t0 + (int)mtl) * NSEL + mj;
            const float mg = GATE[oidx], md = DSC[me], ms = SX[mtl];
            v4u v[8][4];
#pragma unroll
            for (int k = 0; k < 8; ++k) { const unsigned e = (unsigned)__builtin_amdgcn_readlane((int)me, k); const unsigned char* rowp = DOWN + (size_t)e * D + lane * 16;
#pragma unroll
                for (int i = 0; i < 4; ++i) v[k][i] = *(const GAS v4u*)(rowp + i * 1024); }
            int res = 0;
#pragma unroll
            for (int k = 0; k < 8; ++k) { const unsigned tl = (unsigned)__builtin_amdgcn_readlane((int)mtl, k); const LAS unsigned char* xp = XQ + tl * 4096 + lane * 16; int a = 0;
#pragma unroll
                for (int i = 0; i < 4; ++i) { const v4u xv = *(const LAS v4u*)(xp + i * 1024);
                    a = __builtin_amdgcn_sdot4((int)v[k][i].x, (int)xv.x, a, false); a = __builtin_amdgcn_sdot4((int)v[k][i].y, (int)xv.y, a, false);
                    a = __builtin_amdgcn_sdot4((int)v[k][i].z, (int)xv.z, a, false); a = __builtin_amdgcn_sdot4((int)v[k][i].w, (int)xv.w, a, false); }
                const int tot = wave_sum_i(a);
                if (lane == k) res = tot; }
            if (lane < 8) { const float act = (float)res * ms * md; WSEL[oidx] = mg * 0.5f * act * (1.0f + erff(act * 0.70710678118654752f)); }
        }
    }
    __syncthreads();
}
__device__ __forceinline__ void peer_up_phase(Frame& F) {
    typedef float f32x2_ __attribute__((ext_vector_type(2)));
    const int tid = F.tid, lane = F.lane, w = F.wave;
    LAS float* ACC = (LAS float*)F.lds;
    LAS unsigned* LREC = (LAS unsigned*)(F.lds + 131072);
    LAS float* LW = (LAS float*)(F.lds + 131072 + 8192);
    LAS unsigned* CNT = (LAS unsigned*)(F.lds + 131072 + 16384);
    LAS unsigned* OFF = (LAS unsigned*)(F.lds + 131072 + 16384 + 1024);
    LAS unsigned* GS = (LAS unsigned*)(F.lds + 131072 + 16384 + 2048);
    LAS float* PR = (LAS float*)(F.lds + 131072 + 16384 + 2048 + 256);
    const unsigned char* UP = F.ws + WS_UP; const float* USC = (const float*)(F.ws + WS_USC); const int* EIDX = (const int*)(F.ws + WS_EIDX); const float* WSEL = (const float*)(F.ws + WS_WSEL); const float* fg = F.ka->in[22];
    LAS float* SSP = PR + 128;
    for (int g = F.vcu; g < M / 16; g += F.G) {
        const int t0 = g * 16;
        __syncthreads();
        if (tid < 256) CNT[tid] = 0u;
        unsigned rec[4]; float rw[4]; unsigned key[4];
#pragma unroll
        for (int k = 0; k < 4; ++k) { const int r = tid + 512 * k, tl = r >> 7, j = r & 127; const size_t o = (size_t)(t0 + tl) * NSEL + j; const unsigned e = (unsigned)EIDX[o];
            rec[k] = e | ((unsigned)tl << 14); key[k] = ((unsigned)(tl >> 1) << 5) | ((e >> 10) << 1) | (unsigned)(tl & 1); rw[k] = WSEL[o] * USC[e]; }
        __syncthreads();
#pragma unroll
        for (int k = 0; k < 4; ++k) (void)__hip_atomic_fetch_add((unsigned*)&CNT[key[k]], 1u, __ATOMIC_RELAXED, __HIP_MEMORY_SCOPE_WORKGROUP);
        __syncthreads();
        if (tid < 64) GS[tid] = (CNT[tid * 4] + CNT[tid * 4 + 1]) + (CNT[tid * 4 + 2] + CNT[tid * 4 + 3]);
        __syncthreads();
        if (tid == 0) { unsigned run = 0u; for (int c = 0; c < 64; ++c) { const unsigned n = GS[c]; GS[c] = run; run += n; } }
        __syncthreads();
        if (tid < 64) { unsigned run = GS[tid];
#pragma unroll
            for (int k = 0; k < 4; ++k) { OFF[tid * 4 + k] = run; run += CNT[tid * 4 + k]; } }
        __syncthreads();
#pragma unroll
        for (int k = 0; k < 4; ++k) { const unsigned pos = __hip_atomic_fetch_add((unsigned*)&OFF[key[k]], 1u, __ATOMIC_RELAXED, __HIP_MEMORY_SCOPE_WORKGROUP); LREC[pos] = rec[k]; LW[pos] = rw[k]; }
        __syncthreads();
        if (tid < 256 && CNT[tid] != 0u) LREC[OFF[tid] - 1u] |= 0x80000000u;
        typedef _Float16 h16x8 __attribute__((ext_vector_type(8)));
        LAS h16x8* ACH = (LAS h16x8*)F.lds;
        __syncthreads();
#pragma unroll
        for (int k = 0; k < 16; ++k) ACH[k * 512 + tid] = (h16x8){0, 0, 0, 0, 0, 0, 0, 0};
        __syncthreads();
        {
            const LAS unsigned* HR = LREC + 256 * w; const LAS float* HW = LW + 256 * w;
            const unsigned char* ub = UP + lane * 16;
            float ra[64];
#pragma unroll
            for (int e = 0; e < 64; ++e) ra[e] = 0.f;
            v4u vn[4][2];
#pragma unroll
            for (int q = 0; q < 4; ++q) { const unsigned char* rp = ub + (size_t)(HR[q] & 16383u) * 2048; vn[q][0] = *(const GAS v4u*)rp; vn[q][1] = *(const GAS v4u*)(rp + 1024); }
#pragma unroll 1
            for (int p = 0; p < 256; p += 4) {
                v4u v[4][2];
#pragma unroll
                for (int q = 0; q < 4; ++q) { v[q][0] = vn[q][0]; v[q][1] = vn[q][1]; }
                { const int pn = (p + 4 < 256) ? p + 4 : p;
#pragma unroll
                  for (int q = 0; q < 4; ++q) { const unsigned char* rp = ub + (size_t)(HR[pn + q] & 16383u) * 2048; vn[q][0] = *(const GAS v4u*)rp; vn[q][1] = *(const GAS v4u*)(rp + 1024); } }
#pragma unroll
                for (int q = 0; q < 4; ++q) {
                    const unsigned rc = (unsigned)__builtin_amdgcn_readfirstlane((int)HR[p + q]); const float wv = HW[p + q];
#pragma unroll
                    for (int k = 0; k < 2; ++k) { const unsigned vw[4] = {v[q][k].x, v[q][k].y, v[q][k].z, v[q][k].w};
#pragma unroll
                        for (int d = 0; d < 4; ++d) { const int b = 32 * k + 8 * d;
                            const f32x2_ c0 = __builtin_amdgcn_cvt_scalef32_pk_f32_fp4(vw[d], 1.0f, 0), c1 = __builtin_amdgcn_cvt_scalef32_pk_f32_fp4(vw[d], 1.0f, 1), c2 = __builtin_amdgcn_cvt_scalef32_pk_f32_fp4(vw[d], 1.0f, 2), c3 = __builtin_amdgcn_cvt_scalef32_pk_f32_fp4(vw[d], 1.0f, 3);
                            ra[b + 0] = fmaf(wv, c0.x, ra[b + 0]); ra[b + 1] = fmaf(wv, c0.y, ra[b + 1]); ra[b + 2] = fmaf(wv, c1.x, ra[b + 2]); ra[b + 3] = fmaf(wv, c1.y, ra[b + 3]);
                            ra[b + 4] = fmaf(wv, c2.x, ra[b + 4]); ra[b + 5] = fmaf(wv, c2.y, ra[b + 5]); ra[b + 6] = fmaf(wv, c3.x, ra[b + 6]); ra[b + 7] = fmaf(wv, c3.y, ra[b + 7]); } }
                    if (rc & 0x80000000u) { asm volatile("; run end: flush" ::: "memory");
                        LAS h16x8* ap = ACH + ((rc >> 14) & 15u) * 512 + lane;
#pragma unroll
                        for (int c = 0; c < 8; ++c) { h16x8 t = ap[64 * c];
#pragma unroll
                            for (int e = 0; e < 8; ++e) { t[e] = (_Float16)((float)t[e] + ra[8 * c + e]); ra[8 * c + e] = 0.f; }
                            ap[64 * c] = t; } }
                }
            }
        }
        __syncthreads();
        {
            int tq = tid; asm volatile("" : "+v"(tq));
            const int col0 = 8 * tq;
            const f32x4 g0 = *(const GAS f32x4*)(fg + col0), g1 = *(const GAS f32x4*)(fg + col0 + 4);
#pragma unroll 1
            for (int kk = 0; kk < 2; ++kk) {
                f32x4 y0[8], y1[8];
                __syncthreads();
#pragma unroll
                for (int k = 0; k < 8; ++k) { const int tk = 8 * kk + k; const v4u hb = *(const GAS v4u*)((const bf16*)(F.ws + WS_XN) + (size_t)(t0 + tk) * D + col0);
                    const h16x8 a8 = ACH[tk * 512 + tq];
                    y0[k] = (f32x4){bflo(hb.x), bfhi(hb.x), bflo(hb.y), bfhi(hb.y)} + (f32x4){(float)a8[0], (float)a8[1], (float)a8[2], (float)a8[3]};
                    y1[k] = (f32x4){bflo(hb.z), bfhi(hb.z), bflo(hb.w), bfhi(hb.w)} + (f32x4){(float)a8[4], (float)a8[5], (float)a8[6], (float)a8[7]};
                    float ss = ((y0[k].x * y0[k].x + y0[k].y * y0[k].y) + (y0[k].z * y0[k].z + y0[k].w * y0[k].w)) + ((y1[k].x * y1[k].x + y1[k].y * y1[k].y) + (y1[k].z * y1[k].z + y1[k].w * y1[k].w));
                    ss = wave_sum(ss);
                    if (lane == 0) PR[k * 8 + w] = ss; }
                __syncthreads();
#pragma unroll
                for (int k = 0; k < 8; ++k) { const f32x4 p0 = *(const LAS f32x4*)(PR + k * 8), p1 = *(const LAS f32x4*)(PR + k * 8 + 4);
                    const float tot = ((p0.x + p0.y) + (p0.z + p0.w)) + ((p1.x + p1.y) + (p1.z + p1.w));
                    const float rstd = __builtin_amdgcn_rsqf(tot * (1.f / 4096.f) + EPS);
                    float* orow = F.out + (size_t)(t0 + 8 * kk + k) * D + col0;
                    *(GAS f32x4*)orow = y0[k] * rstd * g0; *(GAS f32x4*)(orow + 4) = y1[k] * rstd * g1; }
            }
        }
    }
    __syncthreads();
}
constexpr int N_PHASES = 12;
__global__ void __launch_bounds__(NTHR, 2) hybrid_fwd(Args args) {
    extern __shared__ __attribute__((aligned(16))) unsigned char lds[];
    Frame F;
    F.lds = (LAS unsigned char*)lds;
    F.MISC = (volatile LAS unsigned*)(F.lds + MISC_OFF);
    F.tid = threadIdx.x; F.lane = F.tid & 63; F.wave = __builtin_amdgcn_readfirstlane(F.tid >> 6);
    F.G = gridDim.x; { const int bx = blockIdx.x; F.vcu = (F.G % 8 == 0) ? (bx % 8) * (F.G / 8) + bx / 8 : bx; }
    F.ws = args.ws; F.ctl = (gu32*)(args.ws + WS_CTL); F.out = args.out;
    F.ka = (const Args*)__builtin_amdgcn_kernarg_segment_ptr();
    for (int u = F.tid; u < (LDS_BYTES - LDSCTL_OFF) / 4; u += NTHR) ((LAS unsigned*)(F.lds + LDSCTL_OFF))[u] = 0u;
    __syncthreads();
    XcdBarrier bar; bar.bar = (unsigned*)(F.ctl + CW_BAR); bar.x = 0; bar.st = nullptr;
    if (args.use_bar) bar = xcd_barrier_post((unsigned*)(F.ctl + CW_BAR), F.MISC + 8);
    const int lo = args.ph_lo, hi = args.ph_hi;
#ifndef PH_MASK
#define PH_MASK 0xfff
#endif
#define IN(k) ((((PH_MASK) >> (k)) & 1) && lo <= (k) && (k) < hi)
#define SEAM(k) do { if (IN(k) && IN((k) + 1)) xcd_barrier(bar); } while (0)
    unsigned char* ws = args.ws;
    bf16* XN = (bf16*)(ws + WS_XN);


    if (IN(1)) { p0_prologue(F); } SEAM(1);

    if (IN(2)) {
        {
            constexpr unsigned segs8 = []{ unsigned m = 0; int n = 0; for (int sgi = 0; sgi < 7; ++sgi) if ((FP8_SEGS >> sgi) & 1) { m |= (unsigned)sgi << (3 * n); ++n; } return m; }();
            constexpr unsigned segs16 = []{ unsigned m = 0; int n = 0; for (int sgi = 0; sgi < 7; ++sgi) if (!((FP8_SEGS >> sgi) & 1)) { m |= (unsigned)sgi << (3 * n); ++n; } return m; }();
            constexpr int n8 = __builtin_popcount(FP8_SEGS & 0x7f), n16 = 7 - n8;
            if (n8 > 0) { pg8::Gemm g{(const bf16*)(ws + WS_XN8), (const bf16*)(ws + WS_WIN8), D / 2, D / 2, D / 2, 0, 0, 0, 0}; pg8::SegOrder S; S.init(M, n8, segs8, F.G, (int)blockIdx.x);
                pg8::EpiInproj E{(bf16*)(ws + WS_PROJ), NIN, F.ka->in[9], (const float*)(ws + WS_SA), 1.0f / WIN_QS};
                pg8::gemm_phase<pg8::EpiInproj, pg8::SegOrder, true, true, true>(F.lds, g, S, E); }
            if (n16 > 0) { pg8::Gemm g{XN, (const bf16*)(ws + WS_WIN), D, D, D, 0, 0, 0, 0}; pg8::SegOrder S; S.init(M, n16, segs16, F.G, (int)blockIdx.x);
                pg8::EpiInproj E{(bf16*)(ws + WS_PROJ), NIN, F.ka->in[9], nullptr, 1.0f};
                pg8::gemm_phase<pg8::EpiInproj, pg8::SegOrder, true, true, false>(F.lds, g, S, E); }
        }
    } SEAM(2);

    if (IN(3)) {
        const int s3 = F.vcu & 3;
        { const int kvc = (s3 == 1 || s3 == 2) ? (F.vcu >> 2) * 2 + (s3 - 1) : 128 + F.vcu;
          pg8::Gemm g{(const bf16*)(ws + WS_MEMN), (const bf16*)(ws + WS_WCKV), D / 2, D / 2, D / 2, 0, 0, 0, 0}; pg8::StaticOrder S; S.init(MROWS, 2 * D, F.G, kvc, 1 << 20);
          pg8::EpiBf16Z E{nullptr, 2 * D, 0, 0, ws + WS_KV, KV_Q8, 1.0f / (KV_Q8 * WIN_QS)};
          pg8::gemm_phase<pg8::EpiBf16Z, pg8::StaticOrder, true, true, true>(F.lds, g, S, E); }
#ifndef NO_HGRN
        if (s3 == 0) for (int u = F.vcu >> 2; u < 64; u += F.G / 4) hgrn_head_mfma(F, u >> 4, u & 15);
#endif
#ifndef NO_ATTN
        float lam;
        { int ln_ = F.lane; asm volatile("" : "+v"(ln_)); const float a = wave_sum(F.ka->in[4][ln_] * F.ka->in[5][ln_]), c = wave_sum(F.ka->in[6][ln_] * F.ka->in[7][ln_]); lam = __expf(a) - __expf(c) + 0.2f; }
        for (int u = F.vcu; u < 256; u += F.G) {
            const int bh = u >> 2, s = u & 3;
            const unsigned qlist = (s == 0) ? 0x013u : (s == 1) ? 0x48CDu : (s == 2) ? 0x267ABu : 0x59EFu; const int nq = (s == 0) ? 3 : (s == 2) ? 5 : 4;
#pragma unroll 1
            for (int k = 0; k < nq; ++k) { const int qb = (int)((qlist >> (4 * k)) & 15u); attn_unit(F, bh >> 4, bh & 15, qb, lam); }
        }
#endif
    } SEAM(3);

    if (IN(4)) {
        for (int r = (int)blockIdx.x * NTHR + F.tid; r < M; r += F.G * NTHR) ((float*)(ws + WS_SA))[r] = 1.0f / MIX_Q8;
        { pg8::Gemm g{(const bf16*)(ws + WS_KV), (const bf16*)(ws + WS_WCQ), 512, D, D / 2, (size_t)MEML * D, 512, 0, 512}; pg8::BatchOrder S; S.init(4, 4, 1, 16, F.G, (int)blockIdx.x);
          pg8::EpiBf16Z E{(bf16*)(ws + WS_WKP), D, (size_t)1024 * D, (size_t)256 * D, nullptr, 0.f, 1.0f / (KV_Q8 * WIN_QS)};
          pg8::gemm_phase<pg8::EpiBf16Z, pg8::BatchOrder, true, true, true>(F.lds, g, S, E); }
        { pg8::Gemm g{(const bf16*)(ws + WS_WCO), (const bf16*)(ws + WS_KV + D), 512, D / 2, D, 0, 512, (size_t)MEML * D, 512}; pg8::BatchOrder S; S.init(4, 4, 16, 1, F.G, (int)blockIdx.x);
          pg8::EpiBf16Z E{(bf16*)(ws + WS_VP), 1024, (size_t)D * 1024, 256, nullptr, 0.f, 1.0f / (KV_Q8 * WIN_QS)};
          pg8::gemm_phase<pg8::EpiBf16Z, pg8::BatchOrder, true, true, true>(F.lds, g, S, E); }
    } SEAM(4);

    if (IN(5)) {
        pg8::Gemm g{(const bf16*)(ws + WS_XN8), (const bf16*)(ws + WS_WOUT), D / 2, D / 2, D / 2, 0, 0, 0, 0}; pg8::StaticOrder S; S.init(M, D, F.G, (int)blockIdx.x, 1 << 20);
        pg8::EpiResid<false> E{F.ka->in[0], (bf16*)(ws + WS_H1B), (float*)(ws + WS_SSQ1), (const float*)(ws + WS_SA), 1.0f / WIN_QS};
        pg8::gemm_phase<pg8::EpiResid<false>, pg8::StaticOrder, true, true, true>(F.lds, g, S, E);
    } SEAM(5);

    if (IN(6)) {
        pg8::Gemm g{(const bf16*)(ws + WS_H1B), (const bf16*)(ws + WS_WKP), D, D, D, 0, 0, (size_t)1024 * D, 0}; pg8::StaticOrder S; S.init(M, 1024, F.G, (int)blockIdx.x, 16);
        pg8::EpiSoftmax E{(bf16*)(ws + WS_PB), 1024, (const float*)(ws + WS_SSQ1), 0.03125f * LOG2E};
        pg8::gemm_phase<pg8::EpiSoftmax, pg8::StaticOrder, false, true>(F.lds, g, S, E);
    } SEAM(6);

    if (IN(7)) {
        pg8::Gemm g{(const bf16*)(ws + WS_PB), (const bf16*)(ws + WS_VP), 1024, 1024, 1024, 0, 0, (size_t)D * 1024, 0}; pg8::StaticOrder S; S.init(M, D, F.G, (int)blockIdx.x, 16);
        pg8::EpiResid<true> E{(const bf16*)(ws + WS_H1B), XN, (float*)(ws + WS_SSQ2), nullptr, 1.0f, ws + WS_XN8, (const float*)(ws + WS_SSQ1)};
        pg8::gemm_phase<pg8::EpiResid<true>, pg8::StaticOrder, true, true>(F.lds, g, S, E);
    } SEAM(7);

    if (IN(8)) {
        pg8::Gemm g{(const bf16*)(ws + WS_XN8), (const bf16*)(ws + WS_WPQ), D / 2, D / 2, D / 2, 0, 0, 0, 0}; pg8::StaticOrder S; S.init(M, 2048, F.G, (int)blockIdx.x, 1 << 20);
        pg8::EpiRowScale E{(bf16*)(ws + WS_WIN), 2048, (const float*)(ws + WS_SSQ2), (const float*)(ws + WS_SSQ1), 1.0f / WIN_QS};
        pg8::gemm_phase<pg8::EpiRowScale, pg8::StaticOrder, true, true, true>(F.lds, g, S, E);
    } SEAM(8);

    if (IN(9)) { topk_phase(F); } SEAM(9);
    if (IN(10)) { peer_down_phase(F); } SEAM(10);
    if (IN(11)) { peer_up_phase(F); }
#undef IN
#undef SEAM
}

#ifndef MK_SPLIT
#define MK_SPLIT 0
#endif
#ifndef PROBE_REP_MASK
#define PROBE_REP_MASK 0x0
#endif
#ifndef MK_LAST_PHASE
#define MK_LAST_PHASE N_PHASES
#endif
extern "C" void kernel_launch(void* const* d_in, const int* in_sizes, int n_in, void* d_out, int out_size, void* d_ws, size_t ws_size, hipStream_t stream) {
    static int grid = 0;
    if (grid == 0) {
        if (n_in != 23 || out_size != M * D || ws_size < WS_END2) { fprintf(stderr, "kernel_launch: unexpected shapes (n_in %d out %d ws %zu)\n", n_in, out_size, ws_size); grid = -1; return; }
        int dev = 0, cus = 0, per_cu = 0;
        if (hipGetDevice(&dev) != hipSuccess || hipDeviceGetAttribute(&cus, hipDeviceAttributeMultiprocessorCount, dev) != hipSuccess) { grid = -1; return; }
        if (hipFuncSetAttribute((const void*)hybrid_fwd, hipFuncAttributeMaxDynamicSharedMemorySize, LDS_BYTES) != hipSuccess) { fprintf(stderr, "kernel_launch: hipFuncSetAttribute failed\n"); grid = -1; return; }
        if (hipOccupancyMaxActiveBlocksPerMultiprocessor(&per_cu, (const void*)hybrid_fwd, NTHR, LDS_BYTES) != hipSuccess || per_cu < 1) fprintf(stderr, "kernel_launch: occupancy query reports %d\n", per_cu);
        (void)hipGetLastError();
        grid = cus;
        if (grid != 256) { fprintf(stderr, "kernel_launch: built for 256 CUs, device has %d\n", cus); grid = -1; return; }
    }
    if (grid < 0) return;
    (void)hipMemsetAsync((char*)d_ws + WS_CTL, 0, CTL_ZERO_BYTES, stream);
    Args a{};
    for (int i = 0; i < 23; ++i) a.in[i] = (const float*)d_in[i];
    a.out = (float*)d_out; a.ws = (unsigned char*)d_ws; a.pad = 0;
#if MK_SPLIT
    for (int p = 0; p < MK_LAST_PHASE; ++p) { a.ph_lo = p; a.ph_hi = p + 1; a.use_bar = 0;
        for (int rep = 0; rep < 1 + ((PROBE_REP_MASK >> p) & 1); ++rep) hipLaunchKernelGGL(hybrid_fwd, dim3(grid), dim3(NTHR), LDS_BYTES, stream, a); }
#else
    a.ph_lo = 0; a.ph_hi = MK_LAST_PHASE; a.use_bar = 1;
    hipLaunchKernelGGL(hybrid_fwd, dim3(grid), dim3(NTHR), LDS_BYTES, stream, a);
#endif
}
```

```cpp
#include <hip/hip_runtime.h>
#include <cstdio>
#include <cstdint>

#ifndef Q8_INT
#define Q8_INT 1
#endif
constexpr bool Q8_INT_ = (Q8_INT != 0);
namespace pg8 {
#define PG8_LAS __attribute__((address_space(3)))
typedef unsigned short bf16_t;
typedef short bf16x8 __attribute__((ext_vector_type(8)));
typedef float f32x4 __attribute__((ext_vector_type(4)));
typedef unsigned u32x4 __attribute__((ext_vector_type(4)));
constexpr int BM = 256, BK = 64, HALF = 128, HTB = HALF * BK * 2  , STAGE_BYTES = 8 * HTB, NXCD = 8, WGM = 8;

__host__ __device__ __forceinline__ int lds_byte(int r, int c) { const int st = (r >> 4) * 2 + (c >> 5), rr = r & 15, cc = c & 31, ob = rr * 64 + cc * 2; return st * 1024 + (ob ^ (((ob >> 9) & 1) << 5)); }
__host__ __device__ __forceinline__ void stage_rc(int b, int& R, int& C) { const int st = b / 1024, sb = b % 1024, swz = sb ^ (((sb >> 9) & 1) << 5); R = (st >> 1) * 16 + swz / 64; C = (st & 1) * 32 + (swz % 64) / 2; }
__host__ __device__ __forceinline__ int perm32(int rho) { const int n = rho >> 4, i = rho & 15; return 8 * (i >> 2) + 4 * n + (i & 3); }

struct Unit { int pm, pn, zb, zh; };
struct Gemm {
    const bf16_t* A; const bf16_t* Bt; int K, lda, ldb; size_t a_zb, a_zh, b_zb, b_zh;
    __device__ __forceinline__ const char* a_ptr(const Unit& u) const { return (const char*)(A + (size_t)u.zb * a_zb + (size_t)u.zh * a_zh + (size_t)u.pm * BM * lda); }
    __device__ __forceinline__ const char* b_ptr(const Unit& u) const { return (const char*)(Bt + (size_t)u.zb * b_zb + (size_t)u.zh * b_zh + (size_t)u.pn * BM * ldb); }
};

struct StaticOrder {
    int nM, nN, nwg, G, c, zdiv;
    __host__ __device__ void init(int M, int N, int G_, int c_, int zdiv_) { nM = M / BM; nN = N / BM; nwg = nM * nN; G = G_; c = c_; zdiv = zdiv_; }
    __host__ __device__ bool next(int i, Unit& u) const {
        const long L = (long)i * G + c; if (L >= nwg) return false;
        int wgid = (int)L; { const int q = nwg / NXCD, r = nwg % NXCD, xcd = wgid % NXCD, off = wgid / NXCD; wgid = (xcd < r ? xcd * (q + 1) : r * (q + 1) + (xcd - r) * q) + off; }
        const int nig = WGM * nN, gid = wgid / nig, fm = gid * WGM, gsz = (nM - fm) < WGM ? (nM - fm) : WGM;
        u.pm = fm + ((wgid % nig) % gsz); u.pn = (wgid % nig) / gsz; u.zb = u.pm / zdiv; u.zh = 0; return true;
    }
    __device__ __forceinline__ void a_ready(const Unit&) const {}
    __device__ __forceinline__ void done(const Unit&) const {}
};
struct SegOrder {
    StaticOrder so; unsigned segs;
    __host__ __device__ void init(int M, int nseg, unsigned segs_, int G_, int c_) { so.init(M, nseg * 2048, G_, c_, 1 << 20); segs = segs_; }
    __host__ __device__ bool next(int i, Unit& u) const { if (!so.next(i, u)) return false; u.pn = (int)((segs >> (3 * (u.pn >> 3))) & 7u) * 8 + (u.pn & 7); return true; }
    __device__ __forceinline__ void a_ready(const Unit&) const {}
    __device__ __forceinline__ void done(const Unit&) const {}
};
struct BatchOrder {
    int nM, nN, nzh, ntot, G, c;
    __host__ __device__ void init(int nzb_, int nzh_, int nM_, int nN_, int G_, int c_) { nM = nM_; nN = nN_; nzh = nzh_; ntot = nzb_ * nzh_ * nM_ * nN_; G = G_; c = c_; }
    __host__ __device__ bool next(int i, Unit& u) const {
        const long L = (long)i * G + c; if (L >= ntot) return false;
        const int l = (int)L, per = nM * nN, z = l / per, r = l % per; u.zb = z / nzh; u.zh = z % nzh; u.pm = r / nN; u.pn = r % nN; return true;
    }
    __device__ __forceinline__ void a_ready(const Unit&) const {}
    __device__ __forceinline__ void done(const Unit&) const {}
};

__device__ __forceinline__ unsigned cvt_pk_bf16(float lo, float hi) { typedef float f2 __attribute__((ext_vector_type(2))); typedef __bf16 b2 __attribute__((ext_vector_type(2))); f2 v = {lo, hi}; b2 b = __builtin_convertvector(v, b2); return __builtin_bit_cast(unsigned, b); }
__device__ __forceinline__ u32x4 pack8(const f32x4& v0, const f32x4& v1) { u32x4 w; w.x = cvt_pk_bf16(v0[0], v0[1]); w.y = cvt_pk_bf16(v0[2], v0[3]); w.z = cvt_pk_bf16(v1[0], v1[1]); w.w = cvt_pk_bf16(v1[2], v1[3]); return w; }
__device__ __forceinline__ float sigm(float t) { return __builtin_amdgcn_rcpf(1.0f + __expf(-t)); }

constexpr float QK_SCALE_LOG2E = 0.125f * 1.4426950408889634f;
struct EpiInproj {
    static constexpr bool PERM = true, AFTER_DRAIN = false;
    bf16_t* O; int ldc; const float* gamma; const float* sa; float sbw;
    __device__ __forceinline__ void operator()(const f32x4 (&acc)[2][2][4][2], const Unit& u, int wr, int wc, int fr, int fq) const {
        asm volatile("" : "+v"(fr), "+v"(fq));
        const int seg = u.pn >> 3; const int row0 = u.pm * BM + wr * 64 + fr, col0 = u.pn * BM + wc * 32 + 8 * fq;
#pragma unroll
        for (int bj = 0; bj < 2; ++bj) {
            const int col = col0 + bj * HALF;
            f32x4 om0 = {1.f, 1.f, 1.f, 1.f}, om1 = om0;
            if (seg == 4) { const int c = col - 8192; const f32x4 g00 = *(const f32x4*)(gamma + c), g01 = *(const f32x4*)(gamma + c + 4), g10 = *(const f32x4*)(gamma + 2048 + c), g11 = *(const f32x4*)(gamma + 2048 + c + 4);
#pragma unroll
                for (int e = 0; e < 4; ++e) { om0[e] = sigm(g10[e] - g00[e]); om1[e] = sigm(g11[e] - g01[e]); } }
#pragma unroll
            for (int ai = 0; ai < 2; ++ai)
#pragma unroll
                for (int m = 0; m < 4; ++m) {
                    const float rs_ = sa ? sa[row0 + ai * HALF + m * 16] * sbw : 1.0f;
                    f32x4 v0 = acc[ai][bj][m][0], v1 = acc[ai][bj][m][1];
                    if (Q8_INT_ && sa) {
#pragma unroll
                        for (int e = 0; e < 4; ++e) { v0[e] = (float)__float_as_int(v0[e]); v1[e] = (float)__float_as_int(v1[e]); } }
                    v0 = v0 * rs_; v1 = v1 * rs_;
                    if (seg == 3 || seg == 6) {
#pragma unroll
                        for (int e = 0; e < 4; ++e) { v0[e] = v0[e] * sigm(v0[e]); v1[e] = v1[e] * sigm(v1[e]); }
                    } else if (seg == 4) {
#pragma unroll
                        for (int e = 0; e < 4; ++e) { v0[e] = om0[e] * sigm(-v0[e]); v1[e] = om1[e] * sigm(-v1[e]); }
                    } else if (seg == 0) { v0 = v0 * QK_SCALE_LOG2E; v1 = v1 * QK_SCALE_LOG2E; }
                    *(u32x4*)(O + (size_t)(row0 + ai * HALF + m * 16) * ldc + col) = pack8(v0, v1);
                }
        }
    }
};
__device__ __forceinline__ float row_rstd(const float* ssq, int row, int fq);
constexpr float H2Q_CLIP = 6.5f;
__device__ __forceinline__ unsigned pk_i8x4(f32x4 v, float q) {
    const int a = (int)rintf(__builtin_amdgcn_fmed3f(v[0] * q, -127.f, 127.f)), b = (int)rintf(__builtin_amdgcn_fmed3f(v[1] * q, -127.f, 127.f)), c = (int)rintf(__builtin_amdgcn_fmed3f(v[2] * q, -127.f, 127.f)), d = (int)rintf(__builtin_amdgcn_fmed3f(v[3] * q, -127.f, 127.f));
    return ((unsigned)a & 255u) | (((unsigned)b & 255u) << 8) | (((unsigned)c & 255u) << 16) | ((unsigned)d << 24); }
struct EpiBf16Z {
    static constexpr bool PERM = true, AFTER_DRAIN = false;
    bf16_t* O; int ldc; size_t c_zb, c_zh; unsigned char* O8 = nullptr; float q8 = 0.f; float deq = 0.f;
    __device__ __forceinline__ void operator()(const f32x4 (&acc)[2][2][4][2], const Unit& u, int wr, int wc, int fr, int fq) const {
        asm volatile("" : "+v"(fr), "+v"(fq));
        bf16_t* base = O + (size_t)u.zb * c_zb + (size_t)u.zh * c_zh; unsigned char* base8 = O8 + (size_t)u.zb * c_zb + (size_t)u.zh * c_zh; const int row0 = u.pm * BM + wr * 64 + fr, col0 = u.pn * BM + wc * 32 + 8 * fq;
#pragma unroll
        for (int ai = 0; ai < 2; ++ai)
#pragma unroll
            for (int m = 0; m < 4; ++m)
#pragma unroll
                for (int bj = 0; bj < 2; ++bj) { const size_t off = (size_t)(row0 + ai * HALF + m * 16) * ldc + col0 + bj * HALF;
                    f32x4 a0 = acc[ai][bj][m][0], a1 = acc[ai][bj][m][1];
                    if (Q8_INT_ && deq != 0.f) {
#pragma unroll
                        for (int e = 0; e < 4; ++e) { a0[e] = (float)__float_as_int(a0[e]) * deq; a1[e] = (float)__float_as_int(a1[e]) * deq; } }
                    if (O8) { typedef unsigned u32x2z __attribute__((ext_vector_type(2))); u32x2z o8_; o8_.x = pk_i8x4(a0, q8); o8_.y = pk_i8x4(a1, q8); *(u32x2z*)(base8 + off) = o8_; }
                    else *(u32x4*)(base + off) = pack8(a0, a1); }
    }
};
template <bool RESID_BF16> struct EpiResid {
    static constexpr bool PERM = true, AFTER_DRAIN = false;
    const void* resid; bf16_t* outb; float* ssq; const float* sa = nullptr; float sbw = 1.0f; unsigned char* out8 = nullptr; const float* ssq_q = nullptr;
    __device__ __forceinline__ void operator()(const f32x4 (&acc)[2][2][4][2], const Unit& u, int wr, int wc, int fr, int fq) const {
        asm volatile("" : "+v"(fr), "+v"(fq));
        const int row0 = u.pm * BM + wr * 64 + fr, col0 = u.pn * BM + wc * 32 + 8 * fq;
#pragma unroll
        for (int ai = 0; ai < 2; ++ai)
#pragma unroll
            for (int m = 0; m < 4; ++m) { const int row = row0 + ai * HALF + m * 16; float s = 0.f; const float rs_ = sa ? sa[row] * sbw : 1.0f; const float q8_ = out8 ? (127.0f / H2Q_CLIP) * row_rstd(ssq_q, row, fq) : 0.f;
#pragma unroll
                for (int bj = 0; bj < 2; ++bj) { const size_t off = (size_t)row * 4096 + col0 + bj * HALF;
                    f32x4 r0, r1;
                    if constexpr (RESID_BF16) { const u32x4 rb = *(const u32x4*)((const bf16_t*)resid + off);
                        r0 = (f32x4){__uint_as_float(rb.x << 16), __uint_as_float(rb.x & 0xffff0000u), __uint_as_float(rb.y << 16), __uint_as_float(rb.y & 0xffff0000u)};
                        r1 = (f32x4){__uint_as_float(rb.z << 16), __uint_as_float(rb.z & 0xffff0000u), __uint_as_float(rb.w << 16), __uint_as_float(rb.w & 0xffff0000u)}; }
                    else { r0 = *(const f32x4*)((const float*)resid + off); r1 = *(const f32x4*)((const float*)resid + off + 4); }
                    f32x4 a0 = acc[ai][bj][m][0], a1 = acc[ai][bj][m][1];
                    if (Q8_INT_ && sa) {
#pragma unroll
                        for (int e = 0; e < 4; ++e) { a0[e] = (float)__float_as_int(a0[e]) * rs_; a1[e] = (float)__float_as_int(a1[e]) * rs_; } }
                    const f32x4 v0 = a0 + r0, v1 = a1 + r1;
                    *(u32x4*)(outb + off) = pack8(v0, v1);
                    if (out8) { typedef unsigned u32x2r __attribute__((ext_vector_type(2))); u32x2r o8_; o8_.x = pk_i8x4(v0, q8_); o8_.y = pk_i8x4(v1, q8_); *(u32x2r*)(out8 + off) = o8_; }
                    s += ((v0[0] * v0[0] + v0[1] * v0[1]) + (v0[2] * v0[2] + v0[3] * v0[3])) + ((v1[0] * v1[0] + v1[1] * v1[1]) + (v1[2] * v1[2] + v1[3] * v1[3])); }
                s += __shfl_xor(s, 16); s += __shfl_xor(s, 32);
                if (fq == 0) ssq[(size_t)row * 64 + u.pn * 4 + wc] = s; }
    }
};
__device__ __forceinline__ float row_rstd(const float* ssq, int row, int fq) {
    const f32x4* p = (const f32x4*)(ssq + (size_t)row * 64 + fq * 16); float s = 0.f;
#pragma unroll
    for (int k = 0; k < 4; ++k) { const f32x4 v = p[k]; s += (v[0] + v[1]) + (v[2] + v[3]); }
    s += __shfl_xor(s, 16); s += __shfl_xor(s, 32);
    return __builtin_amdgcn_rsqf(s * (1.0f / 4096.0f) + 1e-6f);
}
struct EpiRowScale {
    static constexpr bool PERM = true, AFTER_DRAIN = false;
    bf16_t* O; int ldc; const float* ssq; const float* ssq_q = nullptr; float sbw = 1.0f;
    __device__ __forceinline__ void operator()(const f32x4 (&acc)[2][2][4][2], const Unit& u, int wr, int wc, int fr, int fq) const {
        const int row0 = u.pm * BM + wr * 64 + fr, col0 = u.pn * BM + wc * 32 + 8 * fq;
#pragma unroll
        for (int ai = 0; ai < 2; ++ai)
#pragma unroll
            for (int m = 0; m < 4; ++m) { const int row = row0 + ai * HALF + m * 16; float rs = row_rstd(ssq, row, fq);
                if (ssq_q) rs = rs * (H2Q_CLIP / 127.0f) * sbw / row_rstd(ssq_q, row, fq);
#pragma unroll
                for (int bj = 0; bj < 2; ++bj) { f32x4 a0 = acc[ai][bj][m][0], a1 = acc[ai][bj][m][1];
                    if (Q8_INT_ && ssq_q) {
#pragma unroll
                        for (int e = 0; e < 4; ++e) { a0[e] = (float)__float_as_int(a0[e]); a1[e] = (float)__float_as_int(a1[e]); } }
                    *(u32x4*)(O + (size_t)row * ldc + col0 + bj * HALF) = pack8(a0 * rs, a1 * rs); } }
    }
};
struct EpiSoftmax {
    static constexpr bool PERM = true, AFTER_DRAIN = true;
    bf16_t* O; int ldc; const float* ssq; float scale_log2e;
    __device__ __forceinline__ void fused(f32x4 (&acc)[2][2][4][2], const Unit& u, int wr, int wc, int fr, int fq, PG8_LAS unsigned char* lds, int wid, int lane) const {
        typedef float f32x2v __attribute__((ext_vector_type(2)));
        PG8_LAS f32x2v* X = (PG8_LAS f32x2v*)lds;
        float mwv[2][4];
#pragma unroll
        for (int ai = 0; ai < 2; ++ai)
#pragma unroll
            for (int m = 0; m < 4; ++m) { const int rl = ai * HALF + wr * 64 + m * 16 + fr; const float rs = row_rstd(ssq, u.pm * BM + rl, fq) * scale_log2e;
                float mx = -3.0e38f;
#pragma unroll
                for (int bj = 0; bj < 2; ++bj)
#pragma unroll
                    for (int n = 0; n < 2; ++n) { acc[ai][bj][m][n] = acc[ai][bj][m][n] * rs; const f32x4 v = acc[ai][bj][m][n]; mx = fmaxf(mx, fmaxf(fmaxf(v[0], v[1]), fmaxf(v[2], v[3]))); }
                mx = fmaxf(mx, __shfl_xor(mx, 16)); mx = fmaxf(mx, __shfl_xor(mx, 32));
                float sm = 0.f;
#pragma unroll
                for (int bj = 0; bj < 2; ++bj)
#pragma unroll
                    for (int n = 0; n < 2; ++n) { f32x4 v = acc[ai][bj][m][n];
#pragma unroll
                        for (int e = 0; e < 4; ++e) { v[e] = __builtin_amdgcn_exp2f(v[e] - mx); sm += v[e]; } acc[ai][bj][m][n] = v; }
                sm += __shfl_xor(sm, 16); sm += __shfl_xor(sm, 32);
                mwv[ai][m] = mx;
                if (fq == 0) X[rl * 4 + wc] = (f32x2v){mx, sm}; }
        asm volatile("s_waitcnt lgkmcnt(0)" ::: "memory"); __builtin_amdgcn_s_barrier(); asm volatile("" ::: "memory");
        const int col0 = u.pn * BM + wc * 32 + 8 * fq;
#pragma unroll
        for (int ai = 0; ai < 2; ++ai)
#pragma unroll
            for (int m = 0; m < 4; ++m) { const int rl = ai * HALF + wr * 64 + m * 16 + fr;
                const f32x2v a = X[rl * 4 + 0], b = X[rl * 4 + 1], c = X[rl * 4 + 2], d = X[rl * 4 + 3];
                const float Mx = fmaxf(fmaxf(a.x, b.x), fmaxf(c.x, d.x));
                const float S = a.y * __builtin_amdgcn_exp2f(a.x - Mx) + b.y * __builtin_amdgcn_exp2f(b.x - Mx) + c.y * __builtin_amdgcn_exp2f(c.x - Mx) + d.y * __builtin_amdgcn_exp2f(d.x - Mx);
                const float f = __builtin_amdgcn_exp2f(mwv[ai][m] - Mx) / S;
#pragma unroll
                for (int bj = 0; bj < 2; ++bj) *(u32x4*)(O + (size_t)(u.pm * BM + rl) * ldc + col0 + bj * HALF) = pack8(acc[ai][bj][m][0] * f, acc[ai][bj][m][1] * f); }
    }
};

template <class Epi, class Sched, bool ALIGN_EPI = false, bool SP2 = false, bool FP8 = false>
__device__ __forceinline__ void gemm_phase(PG8_LAS unsigned char* lds, const Gemm g, const Sched& S, const Epi& E) {
    int tid_ = threadIdx.x; asm volatile("" : "+v"(tid_));
    const int tid = tid_, wid = __builtin_amdgcn_readfirstlane(tid >> 6), lane = tid & 63, wr = wid >> 2, wc = wid & 3, fr = lane & 15, fq = lane >> 4;
    const int K = g.K, nt = K / BK;
    unsigned voffA[2], voffB[2];
#pragma unroll
    for (int i = 0; i < 2; ++i) { int R, C; stage_rc(tid * 16 + i * 8192, R, C); const int Rb = Epi::PERM ? ((R & ~31) + perm32(R & 31)) : R;
        voffA[i] = (unsigned)(R * g.lda + C) * 2u; voffB[i] = (unsigned)(Rb * g.ldb + C) * 2u; }
    const size_t kstep = (size_t)(BK * 2);
    const size_t hstepA = (size_t)HALF * g.lda * 2, hstepB = (size_t)HALF * g.ldb * 2;

    const unsigned ldsw = (unsigned)wid * 1024u;
    const int aoff = lds_byte(wr * 64 + fr, fq * 8), boff = lds_byte(wc * 32 + fr, fq * 8);
#define PG8_SA(b, h) (((b) * 2 + (h)) * HTB)
#define PG8_SB(b, h) ((4 + (b) * 2 + (h)) * HTB)
#define PG8_STAGE(bufoff, gbase, voff) do { _Pragma("unroll") for (int _i = 0; _i < 2; ++_i) { unsigned keep_; \
        asm volatile("s_mov_b32 %0, m0\n\ts_mov_b32 m0, %3\n\ts_nop 0\n\tglobal_load_lds_dwordx4 %1, %2\n\ts_mov_b32 m0, %0" : "=&s"(keep_) \
            : "v"((voff)[_i]), "s"((const char*)(gbase)), "s"((unsigned)(size_t)(lds + (bufoff) + ldsw + _i * 8192)) : "memory"); } } while (0)
#define PG8_LDA(dst, b, h) do { _Pragma("unroll") for (int m = 0; m < 4; ++m) dst[m] = __builtin_shufflevector(*(const PG8_LAS v4i_*)(lds + PG8_SA(b, h) + aoff + m * 2048), *(const PG8_LAS v4i_*)(lds + PG8_SA(b, h) + aoff + m * 2048 + 1024), 0, 1, 2, 3, 4, 5, 6, 7); } while (0)
#define PG8_LDB(dst, b, h) do { _Pragma("unroll") for (int n = 0; n < 2; ++n) dst[n] = __builtin_shufflevector(*(const PG8_LAS v4i_*)(lds + PG8_SB(b, h) + boff + n * 2048), *(const PG8_LAS v4i_*)(lds + PG8_SB(b, h) + boff + n * 2048 + 1024), 0, 1, 2, 3, 4, 5, 6, 7); } while (0)
#define PG8_LO4(x) __builtin_shufflevector(x, x, 0, 1, 2, 3)
#define PG8_HI4(x) __builtin_shufflevector(x, x, 4, 5, 6, 7)
#define PG8_LO(x) __builtin_bit_cast(bf16x8, __builtin_shufflevector(x, x, 0, 1, 2, 3))
#define PG8_HI(x) __builtin_bit_cast(bf16x8, __builtin_shufflevector(x, x, 4, 5, 6, 7))
#define PG8_MMA(ai, bj, At, Bt) do { __builtin_amdgcn_s_setprio(1); _Pragma("unroll") for (int m = 0; m < 4; ++m) _Pragma("unroll") for (int n = 0; n < 2; ++n) { \
        if constexpr (FP8) { if constexpr (Q8_INT_) { \
                acc[ai][bj][m][n] = __builtin_bit_cast(f32x4, __builtin_amdgcn_mfma_i32_16x16x64_i8(PG8_LO4(Bt[n]), PG8_LO4(At[m]), __builtin_bit_cast(v4i_, acc[ai][bj][m][n]), 0, 0, 0)); \
                acc[ai][bj][m][n] = __builtin_bit_cast(f32x4, __builtin_amdgcn_mfma_i32_16x16x64_i8(PG8_HI4(Bt[n]), PG8_HI4(At[m]), __builtin_bit_cast(v4i_, acc[ai][bj][m][n]), 0, 0, 0)); \
            } else acc[ai][bj][m][n] = __builtin_amdgcn_mfma_scale_f32_16x16x128_f8f6f4(Bt[n], At[m], acc[ai][bj][m][n], 0, 0, 0, 0, 0, 0); } \
        else { acc[ai][bj][m][n] = __builtin_amdgcn_mfma_f32_16x16x32_bf16(PG8_LO(Bt[n]), PG8_LO(At[m]), acc[ai][bj][m][n], 0, 0, 0); acc[ai][bj][m][n] = __builtin_amdgcn_mfma_f32_16x16x32_bf16(PG8_HI(Bt[n]), PG8_HI(At[m]), acc[ai][bj][m][n], 0, 0, 0); } } \
        __builtin_amdgcn_s_setprio(0); } while (0)
#define PG8_WAIT_V(n) asm volatile("s_waitcnt vmcnt(" #n ")" ::: "memory")
#define PG8_WAIT_L(n) asm volatile("s_waitcnt lgkmcnt(" #n ")" ::: "memory")
#define PG8_BAR __builtin_amdgcn_s_barrier()
#define PG8_SCHED __builtin_amdgcn_sched_barrier(0)
    Unit cur, nxt; int ui = 0;
    if (!S.next(0, cur)) return;
    f32x4 acc[2][2][4][2];
#pragma unroll
    for (int a = 0; a < 2; ++a)
#pragma unroll
        for (int b = 0; b < 2; ++b)
#pragma unroll
            for (int m = 0; m < 4; ++m)
#pragma unroll
                for (int n = 0; n < 2; ++n) acc[a][b][m][n] = (f32x4){0.f, 0.f, 0.f, 0.f};
    typedef int v4i_ __attribute__((ext_vector_type(4))); typedef int v8i_ __attribute__((ext_vector_type(8)));
    v8i_ At[4], B0[2], B1[2];
    const char* cA = g.a_ptr(cur); const char* cB = g.b_ptr(cur);
    S.a_ready(cur);
    if constexpr (SP2) {
        PG8_STAGE(PG8_SB(0, 0), cB, voffB); PG8_STAGE(PG8_SB(0, 1), cB + hstepB, voffB); PG8_STAGE(PG8_SA(0, 0), cA, voffA); PG8_STAGE(PG8_SA(0, 1), cA + hstepA, voffA);
        if (wr == 1) PG8_BAR;
        PG8_WAIT_V(2); PG8_BAR;
        PG8_STAGE(PG8_SB(1, 0), cB + kstep, voffB); PG8_STAGE(PG8_SA(1, 0), cA + kstep, voffA); PG8_STAGE(PG8_SB(1, 1), cB + hstepB + kstep, voffB);
        PG8_WAIT_V(6); PG8_BAR;
    } else {
        PG8_STAGE(PG8_SB(0, 0), cB, voffB); PG8_STAGE(PG8_SA(0, 0), cA, voffA); PG8_STAGE(PG8_SB(0, 1), cB + hstepB, voffB); PG8_STAGE(PG8_SA(0, 1), cA + hstepA, voffA);
        if (wr == 1) PG8_BAR;
        PG8_WAIT_V(4); PG8_BAR;
        PG8_STAGE(PG8_SB(1, 0), cB + kstep, voffB); PG8_STAGE(PG8_SA(1, 0), cA + kstep, voffA); PG8_STAGE(PG8_SB(1, 1), cB + hstepB + kstep, voffB);
        PG8_WAIT_V(6); PG8_BAR;
    }
    for (;;) {
        const bool has_next = S.next(ui + 1, nxt);
        const char* nA = has_next ? g.a_ptr(nxt) : cA; const char* nB = has_next ? g.b_ptr(nxt) : cB;
        for (int t = 0; t < nt; t += 2) {
            const bool last = (t == nt - 2);
            const char* a1 = cA + (size_t)(t + 1) * kstep;
            const char* a2 = last ? nA : cA + (size_t)(t + 2) * kstep; const char* b2 = last ? nB : cB + (size_t)(t + 2) * kstep;
            const char* a3 = a2 + kstep; const char* b3 = b2 + kstep;
            if (last && has_next) S.a_ready(nxt);
            if constexpr (SP2) {
            PG8_LDB(B0, 0, 0); PG8_LDB(B1, 0, 1); PG8_SCHED; PG8_LDA(At, 0, 0); PG8_STAGE(PG8_SA(1, 1), a1 + hstepA, voffA);
            PG8_WAIT_V(8); PG8_WAIT_L(0); PG8_BAR; PG8_MMA(0, 0, At, B0); PG8_MMA(0, 1, At, B1); PG8_BAR; PG8_SCHED;
            PG8_LDA(At, 0, 1); PG8_STAGE(PG8_SB(0, 0), b2, voffB); PG8_STAGE(PG8_SB(0, 1), b2 + hstepB, voffB); PG8_STAGE(PG8_SA(0, 0), a2, voffA);
            PG8_WAIT_V(8); PG8_WAIT_L(0); PG8_BAR; PG8_MMA(1, 0, At, B0); PG8_MMA(1, 1, At, B1); PG8_BAR; PG8_SCHED;
            PG8_LDB(B0, 1, 0); PG8_LDB(B1, 1, 1); PG8_SCHED; PG8_LDA(At, 1, 0); PG8_STAGE(PG8_SA(0, 1), a2 + hstepA, voffA);
            PG8_WAIT_V(8); PG8_WAIT_L(0); PG8_BAR; PG8_MMA(0, 0, At, B0); PG8_MMA(0, 1, At, B1); PG8_BAR; PG8_SCHED;
            PG8_LDA(At, 1, 1); PG8_STAGE(PG8_SB(1, 0), b3, voffB); PG8_STAGE(PG8_SB(1, 1), b3 + hstepB, voffB); PG8_STAGE(PG8_SA(1, 0), a3, voffA);
            PG8_WAIT_V(8); PG8_WAIT_L(0); PG8_BAR; PG8_MMA(1, 0, At, B0); PG8_MMA(1, 1, At, B1); PG8_BAR; PG8_SCHED;
            } else {
            PG8_LDB(B0, 0, 0); PG8_SCHED; PG8_LDA(At, 0, 0); PG8_STAGE(PG8_SA(1, 1), a1 + hstepA, voffA);
            PG8_WAIT_L(8); PG8_BAR; PG8_WAIT_L(0); PG8_MMA(0, 0, At, B0); PG8_BAR; PG8_SCHED;
            PG8_LDB(B1, 0, 1); PG8_STAGE(PG8_SB(0, 0), b2, voffB);
            PG8_BAR; PG8_WAIT_L(0); PG8_MMA(0, 1, At, B1); PG8_BAR;
            PG8_LDA(At, 0, 1); PG8_STAGE(PG8_SA(0, 0), a2, voffA);
            PG8_BAR; PG8_WAIT_L(0); PG8_MMA(1, 0, At, B0); PG8_BAR; PG8_SCHED;
            PG8_STAGE(PG8_SB(0, 1), b2 + hstepB, voffB);
            PG8_WAIT_V(6); PG8_BAR; PG8_MMA(1, 1, At, B1); PG8_BAR;
            PG8_LDB(B0, 1, 0); PG8_SCHED; PG8_LDA(At, 1, 0); PG8_STAGE(PG8_SA(0, 1), a2 + hstepA, voffA);
            PG8_WAIT_L(8); PG8_BAR; PG8_WAIT_L(0); PG8_MMA(0, 0, At, B0); PG8_BAR; PG8_SCHED;
            PG8_LDB(B1, 1, 1); PG8_STAGE(PG8_SB(1, 0), b3, voffB);
            PG8_BAR; PG8_WAIT_L(0); PG8_MMA(0, 1, At, B1); PG8_BAR;
            PG8_LDA(At, 1, 1); PG8_STAGE(PG8_SA(1, 0), a3, voffA);
            PG8_BAR; PG8_WAIT_L(0); PG8_MMA(1, 0, At, B0); PG8_BAR; PG8_SCHED;
            PG8_STAGE(PG8_SB(1, 1), b3 + hstepB, voffB);
            PG8_WAIT_V(6); PG8_BAR; PG8_MMA(1, 1, At, B1); PG8_BAR;
            }
        }
        if constexpr (ALIGN_EPI) { if (wr == 0) PG8_BAR; }
        if constexpr (!Epi::AFTER_DRAIN) { E(acc, cur, wr, wc, fr, fq); S.done(cur); }
        if (!has_next) break;
#pragma unroll
        for (int a = 0; a < 2; ++a)
#pragma unroll
            for (int b = 0; b < 2; ++b)
#pragma unroll
                for (int m = 0; m < 4; ++m)
#pragma unroll
                    for (int n = 0; n < 2; ++n) acc[a][b][m][n] = (f32x4){0.f, 0.f, 0.f, 0.f};
        cur = nxt; cA = nA; cB = nB; ++ui;
        if constexpr (ALIGN_EPI) { if (wr == 1) PG8_BAR; }
    }
    PG8_WAIT_V(0);
    if constexpr (!ALIGN_EPI) { if (wr == 0) PG8_BAR; }
    PG8_BAR;
    if constexpr (Epi::AFTER_DRAIN) { E.fused(acc, cur, wr, wc, fr, fq, lds, wid, lane); S.done(cur); }
#undef PG8_SA
#undef PG8_SB
#undef PG8_STAGE
#undef PG8_LDA
#undef PG8_LDB
#undef PG8_LO
#undef PG8_HI
#undef PG8_MMA
#undef PG8_WAIT_V
#undef PG8_WAIT_L
#undef PG8_BAR
#undef PG8_SCHED
}
}
#define GAS __attribute__((address_space(1)))
#define LAS __attribute__((address_space(3)))
typedef unsigned short bf16;
typedef unsigned v4u __attribute__((ext_vector_type(4)));
typedef float f32x4 __attribute__((ext_vector_type(4)));
typedef short bf16x8 __attribute__((ext_vector_type(8)));
typedef GAS unsigned gu32;
typedef GAS unsigned long long gu64;
#define RLX_AGENT __ATOMIC_RELAXED, __HIP_MEMORY_SCOPE_AGENT
#define LDS_WAIT() asm volatile("s_waitcnt lgkmcnt(0)" ::: "memory")
#define VM_WAIT() asm volatile("s_waitcnt vmcnt(0)" ::: "memory")
__device__ __forceinline__ unsigned long long rt() { return __builtin_amdgcn_s_memrealtime(); }
__device__ __forceinline__ unsigned f2bf(float f) { unsigned u = __builtin_bit_cast(unsigned, f); return (u + 0x7fffu + ((u >> 16) & 1u)) >> 16; }
__device__ __forceinline__ unsigned pk2(float lo, float hi) { return f2bf(lo) | (f2bf(hi) << 16); }

#define XB_TMO      128
#define XB_XCNT(j)  (256  + 64 * (j))
#define XB_XSUB(j)  (1280 + 64 * (j))
#define XB_XGEN(j)  (2304 + 64 * (j))
#define XB_TOP      3328
#define XB_TOPGEN   3392
#define XCD_BAR_WORDS 3456
#define XB_SPIN_CAP (1u << 18)

__device__ __forceinline__ unsigned xb_ld(unsigned* p)              { return __hip_atomic_load(p, __ATOMIC_RELAXED, __HIP_MEMORY_SCOPE_AGENT); }
__device__ __forceinline__ unsigned xb_add(unsigned* p, unsigned v) { return __hip_atomic_fetch_add(p, v, __ATOMIC_RELAXED, __HIP_MEMORY_SCOPE_AGENT); }
__device__ __forceinline__ unsigned xb_xcc_id() { return (unsigned)__builtin_amdgcn_s_getreg((3 << 11) | 20) & 0xFu; }
#define XB_SPIN(cond, bar) do { unsigned _sp = 0; while (cond) { __builtin_amdgcn_s_sleep(1); \
    if ((++_sp & 255u) == 0u) { if (xb_ld(&(bar)[XB_TMO])) break; if (_sp > XB_SPIN_CAP) { atomicAdd(&(bar)[XB_TMO], 1u); break; } } } } while (0)

struct XcdBarrier {
    unsigned* bar; unsigned x;
    volatile LAS unsigned* st;
};

__device__ __forceinline__ XcdBarrier xcd_barrier_post(unsigned* bar, volatile LAS unsigned* st) {
    XcdBarrier b; b.bar = bar; b.x = xb_xcc_id(); b.st = st;
    if (threadIdx.x == 0) (void)xb_add(&bar[XB_XCNT(b.x)], 1u);
    return b;
}
__device__ __forceinline__ void xcd_barrier_complete(unsigned* bar, unsigned x, unsigned& nloc, unsigned& nx) {
    const unsigned G = gridDim.x * gridDim.y * gridDim.z;
    unsigned sum, cnt, mine, sp = 0u;
    for (;;) {
        sum = 0u; cnt = 0u; mine = 0u;
#pragma unroll
        for (unsigned j = 0; j < 16; ++j) { const unsigned c = xb_ld(&bar[XB_XCNT(j)]); sum += c; cnt += (c > 0u) ? 1u : 0u; mine = (j == x) ? c : mine; }
        if (sum == G) break;
        __builtin_amdgcn_s_sleep(1);
        if ((++sp & 255u) == 0u) { if (xb_ld(&bar[XB_TMO])) break; if (sp > XB_SPIN_CAP) { atomicAdd(&bar[XB_TMO], 1u); break; } }
    }
    nloc = mine > 0u ? mine : 1u; nx = cnt > 0u ? cnt : 1u;
}

__device__ __forceinline__ void xcd_barrier(const XcdBarrier& b) {
    asm volatile("s_waitcnt vmcnt(0)" ::: "memory");
    __syncthreads();
    if (threadIdx.x == 0) {
        unsigned* bar = b.bar;
        __builtin_amdgcn_s_waitcnt(0);
        unsigned nloc = b.st[0], nx = b.st[1];
        if (nloc == 0u) { xcd_barrier_complete(bar, b.x, nloc, nx); b.st[0] = nloc; b.st[1] = nx; }
        const unsigned old = xb_add(&bar[XB_XSUB(b.x)], 1u);
        const unsigned gen = old / nloc;
        if (old + 1u == (gen + 1u) * nloc) {
            __builtin_amdgcn_fence(__ATOMIC_RELEASE, "agent");
            asm volatile("s_waitcnt vmcnt(0)" ::: "memory");
            const unsigned og = xb_add(&bar[XB_TOP], 1u);
            const unsigned tg = og / nx;
            if (og + 1u == (tg + 1u) * nx) xb_add(&bar[XB_TOPGEN], 1u);
            else XB_SPIN(xb_ld(&bar[XB_TOPGEN]) == tg, bar);
            __builtin_amdgcn_fence(__ATOMIC_ACQUIRE, "agent");
            xb_add(&bar[XB_XGEN(b.x)], 1u);
            asm volatile("s_waitcnt vmcnt(0)" ::: "memory");
        } else {
            XB_SPIN(xb_ld(&bar[XB_XGEN(b.x)]) == gen, bar);
            __builtin_amdgcn_fence(__ATOMIC_ACQUIRE, "agent");
            asm volatile("s_waitcnt vmcnt(0)" ::: "memory");
        }
    }
    __syncthreads();
}

constexpr int NWAVES = 8, NTHR = 512;
constexpr int D = 4096, BATCH = 4, SEQ = 4096, M = BATCH * SEQ, MEML = 256, MROWS = BATCH * MEML, NIN = 14336;
constexpr int COL_DQ = 0, COL_DK = 2048, COL_DV = 4096, COL_HQ = 6144, COL_HF = 8192, COL_HI = 10240, COL_HG = 12288;
constexpr int NEXP = 16384, PEER_H = 8, PEER_K = 16, NSEL = PEER_H * PEER_K;
constexpr float EPS = 1e-6f, LOG2E = 1.4426950408889634f;
#ifndef Q8_INT
#define Q8_INT 1
#endif
constexpr float WIN_QS = Q8_INT ? 1344.0f : 2048.0f;
constexpr size_t MiB = 1u << 20;
constexpr size_t WS_CTL = 0, CTL_ZERO_BYTES = 1 * MiB;
constexpr size_t WS_SUBK = 1 * MiB;
constexpr size_t WS_XN = 2 * MiB;
constexpr size_t WS_WIN = 130 * MiB;
constexpr size_t WS_WOUT = 242 * MiB, WS_WCQ = 274 * MiB, WS_WCKV = 306 * MiB, WS_WCO = 370 * MiB, WS_WPQ = 402 * MiB;
constexpr size_t WS_PROJ = 418 * MiB;
constexpr size_t WS_H1F = WS_PROJ, WS_H1B = WS_PROJ + 256 * MiB, WS_PB = WS_PROJ + 384 * MiB;
constexpr size_t WS_MEMN = 866 * MiB, WS_KV = 874 * MiB, WS_WKP = 890 * MiB, WS_VP = 922 * MiB;
constexpr size_t WS_EIDX = 954 * MiB, WS_GATE = 962 * MiB, WS_HSSQ = 970 * MiB, WS_SSQ1 = 974 * MiB, WS_SSQ2 = 978 * MiB;
constexpr size_t WS_ATT = 982 * MiB;
constexpr size_t WS_DOWN = 1014 * MiB, WS_UP = 1078 * MiB, WS_WSEL = 1142 * MiB, WS_DSC = 1150 * MiB, WS_USC = 1151 * MiB, WS_END = 1152 * MiB;
constexpr float KV_Q8 = 127.0f / 6.5f;
constexpr float MIX_CLIP = 8.0f, MIX_Q8 = 127.0f / MIX_CLIP;
constexpr size_t WS_XN8 = 1152 * MiB, WS_WIN8 = 1216 * MiB, WS_END2 = 1272 * MiB;
constexpr size_t WS_SA = 1150 * MiB + 512 * 1024;
constexpr int CW_AMAX = 8;
constexpr int CW_BAR = 4096;
constexpr int RING_BYTES = 131072, LDS_BYTES = 163840, LDSCTL_OFF = LDS_BYTES - 1024, MISC_OFF = LDSCTL_OFF + 320;

struct Args { const float* in[23]; float* out; unsigned char* ws; int ph_lo, ph_hi, use_bar, pad; };
struct Frame {
    LAS unsigned char* lds;
    volatile LAS unsigned* MISC;
    gu32* ctl;
    int tid, lane, wave, vcu, G;
    unsigned char* ws;
    const Args* ka;
    float* out;
};
__device__ __forceinline__ float bf2f(unsigned short b) { return __uint_as_float((unsigned)b << 16); }
__device__ __forceinline__ float bflo(unsigned w) { return __uint_as_float(w << 16); }
__device__ __forceinline__ float bfhi(unsigned w) { return __uint_as_float(w & 0xffff0000u); }
__device__ __forceinline__ float wave_sum(float v) {
#pragma unroll
    for (int o = 1; o < 64; o <<= 1) v += __shfl_xor(v, o);
    return v;
}
__device__ __forceinline__ void p0_transpose_item(const float* W, int K, int N, bf16* WT, const float* ks, LAS float* scr, int item, int lane) {
    const int nblk = N / 32, kb = item / nblk, nb = item % nblk, k0 = 64 * kb, n0 = 32 * nb;
#pragma unroll 8
    for (int i = 0; i < 32; ++i) { const int kk = 2 * i + (lane >> 5); float v = W[(size_t)(k0 + kk) * N + n0 + (lane & 31)]; if (ks) v *= ks[k0 + kk]; scr[kk * 33 + (lane & 31)] = v; }
    LDS_WAIT(); asm volatile("" ::: "memory");
    const int c = lane & 7;
#pragma unroll
    for (int j = 0; j < 4; ++j) { const int n = (lane >> 3) + 8 * j; const LAS float* s = scr + (8 * c) * 33 + n;
        v4u o; o.x = pk2(s[0 * 33], s[1 * 33]); o.y = pk2(s[2 * 33], s[3 * 33]); o.z = pk2(s[4 * 33], s[5 * 33]); o.w = pk2(s[6 * 33], s[7 * 33]);
        *(GAS v4u*)(WT + (size_t)(n0 + n) * K + k0 + 8 * c) = o; }
    LDS_WAIT(); asm volatile("" ::: "memory");
}
#ifndef FP8_SEGS
#define FP8_SEGS 0x7f
#endif
#ifndef Q8_INT
#define Q8_INT 1
#endif
__device__ __forceinline__ unsigned q8_pack4(float a, float b, float c, float d) {
    const int ia = (int)rintf(a), ib = (int)rintf(b), ic = (int)rintf(c), id = (int)rintf(d);
    return ((unsigned)ia & 255u) | (((unsigned)ib & 255u) << 8) | (((unsigned)ic & 255u) << 16) | ((unsigned)id << 24); }
__device__ __forceinline__ void p0_transpose_item_fp8(const float* W, int K, int N, unsigned char* WT, float qs, LAS float* scr, int item, int lane, const float* ks = nullptr) {
    const int nblk = N / 32, kb = item / nblk, nb = item % nblk, k0 = 64 * kb, n0 = 32 * nb;
    float wl_[32];
    { const float* wp_ = W + (size_t)(k0 + (lane >> 5)) * N + n0 + (lane & 31); const size_t st_ = (size_t)2 * N;
#pragma unroll
      for (int i = 0; i < 32; ++i) wl_[i] = wp_[i * st_]; }
    float kl_[32];
    if (ks) {
#pragma unroll
        for (int i = 0; i < 32; ++i) kl_[i] = ks[k0 + 2 * i + (lane >> 5)]; }
#pragma unroll
    for (int i = 0; i < 32; ++i) { const int kk = 2 * i + (lane >> 5); float wv_ = wl_[i] * qs; if (ks) wv_ *= kl_[i]; scr[kk * 33 + (lane & 31)] = __builtin_amdgcn_fmed3f(wv_, Q8_INT ? -127.0f : -448.0f, Q8_INT ? 127.0f : 448.0f); }
    LDS_WAIT(); asm volatile("" ::: "memory");
    const int c = lane & 3;
#pragma unroll
    for (int j = 0; j < 2; ++j) { const int n = (lane >> 2) + 16 * j; const LAS float* sp = scr + (16 * c) * 33 + n; v4u o; unsigned ow[4];
#pragma unroll
        for (int q = 0; q < 4; ++q) {
#if Q8_INT
            ow[q] = q8_pack4(sp[(4 * q) * 33], sp[(4 * q + 1) * 33], sp[(4 * q + 2) * 33], sp[(4 * q + 3) * 33]);
#else
            int w = __builtin_amdgcn_cvt_pk_fp8_f32(sp[(4 * q) * 33], sp[(4 * q + 1) * 33], 0, false); w = __builtin_amdgcn_cvt_pk_fp8_f32(sp[(4 * q + 2) * 33], sp[(4 * q + 3) * 33], w, true); ow[q] = (unsigned)w;
#endif
        }
        o.x = ow[0]; o.y = ow[1]; o.z = ow[2]; o.w = ow[3];
        *(GAS v4u*)(WT + (size_t)(n0 + n) * K + k0 + 16 * c) = o; }
    LDS_WAIT(); asm volatile("" ::: "memory");
}
__device__ __forceinline__ void row4096_norm_to_fp8(const float* src, const float* g, unsigned char* dst, bf16* dst16, float* sa_out, int lane) {
    const GAS f32x4* xr = (const GAS f32x4*)src + lane;
    f32x4 v[16]; float s = 0.f;
#pragma unroll
    for (int j = 0; j < 16; ++j) { v[j] = xr[64 * j]; s += (v[j].x * v[j].x + v[j].y * v[j].y) + (v[j].z * v[j].z + v[j].w * v[j].w); }
    const float r = __builtin_amdgcn_rsqf(wave_sum(s) * (1.f / 4096.f) + EPS);
    float am = 0.f;
#pragma unroll
    for (int j = 0; j < 16; ++j) { v[j] = v[j] * r * ((const GAS f32x4*)g)[64 * j + lane]; am = fmaxf(am, fmaxf(fmaxf(fabsf(v[j].x), fabsf(v[j].y)), fmaxf(fabsf(v[j].z), fabsf(v[j].w)))); }
#pragma unroll
    for (int o = 1; o < 64; o <<= 1) am = fmaxf(am, __shfl_xor(am, o));
    const float q = (am > 0.f) ? (Q8_INT ? 127.0f : 448.0f) / am : 1.0f;
    GAS unsigned* o4 = (GAS unsigned*)dst + lane; GAS unsigned long long* o8 = (GAS unsigned long long*)dst16 + lane;
#pragma unroll
    for (int j = 0; j < 16; ++j) {
#if Q8_INT
        o4[64 * j] = q8_pack4(v[j].x * q, v[j].y * q, v[j].z * q, v[j].w * q);
#else
        int w = __builtin_amdgcn_cvt_pk_fp8_f32(v[j].x * q, v[j].y * q, 0, false); w = __builtin_amdgcn_cvt_pk_fp8_f32(v[j].z * q, v[j].w * q, w, true); o4[64 * j] = (unsigned)w;
#endif
        if ((FP8_SEGS & 0x7f) != 0x7f) o8[64 * j] = (unsigned long long)pk2(v[j].x, v[j].y) | ((unsigned long long)pk2(v[j].z, v[j].w) << 32); }
    if (lane == 0) *sa_out = (am > 0.f) ? am * (1.0f / (Q8_INT ? 127.0f : 448.0f)) : 1.0f;
}
__device__ __forceinline__ void row4096_bf16_to_i8(const bf16* src, unsigned char* dst, float* sc_out, int lane) {
    typedef unsigned u32x2q __attribute__((ext_vector_type(2)));
    v4u v[8]; float am = 0.f;
#pragma unroll
    for (int j = 0; j < 8; ++j) { v[j] = *(const GAS v4u*)(src + 512 * j + 8 * lane);
        const unsigned wd[4] = {v[j].x, v[j].y, v[j].z, v[j].w};
#pragma unroll
        for (int e = 0; e < 4; ++e) am = fmaxf(am, fmaxf(fabsf(bflo(wd[e])), fabsf(bfhi(wd[e])))); }
#pragma unroll
    for (int o = 1; o < 64; o <<= 1) am = fmaxf(am, __shfl_xor(am, o));
    const float q = (am > 0.f) ? 127.0f / am : 1.0f;
#pragma unroll
    for (int j = 0; j < 8; ++j) { u32x2q o;
        o.x = q8_pack4(bflo(v[j].x) * q, bfhi(v[j].x) * q, bflo(v[j].y) * q, bfhi(v[j].y) * q); o.y = q8_pack4(bflo(v[j].z) * q, bfhi(v[j].z) * q, bflo(v[j].w) * q, bfhi(v[j].w) * q);
        *(GAS u32x2q*)(dst + 512 * j + 8 * lane) = o; }
    if (lane == 0) *sc_out = (am > 0.f) ? am * (1.0f / 127.0f) : 1.0f;
}
__device__ __forceinline__ void p0_absmax(Frame& F) {
    const GAS f32x4* W = (const GAS f32x4*)F.ka->in[3]; const size_t n4 = (size_t)D * NIN / 4, stride = (size_t)F.G * NTHR;
    float am = 0.f;
    for (size_t i = (size_t)F.vcu * NTHR + F.tid; i < n4; i += stride) { const f32x4 v = W[i]; am = fmaxf(am, fmaxf(fmaxf(fabsf(v.x), fabsf(v.y)), fmaxf(fabsf(v.z), fabsf(v.w)))); }
#pragma unroll
    for (int o = 1; o < 64; o <<= 1) am = fmaxf(am, __shfl_xor(am, o));
    if (F.lane == 0) (void)__hip_atomic_fetch_max((unsigned*)(F.ctl + CW_AMAX), __float_as_uint(am), __ATOMIC_RELAXED, __HIP_MEMORY_SCOPE_AGENT);
}
__device__ __forceinline__ void row4096_to_bf16(const float* src, bf16* dst, const float* g, float sc, int mode, int lane, unsigned char* dst8 = nullptr, float q8 = 0.f) {
    const GAS f32x4* xr = (const GAS f32x4*)src + lane;
    f32x4 v[16]; float s = 0.f;
#pragma unroll
    for (int j = 0; j < 16; ++j) { v[j] = xr[64 * j]; s += (v[j].x * v[j].x + v[j].y * v[j].y) + (v[j].z * v[j].z + v[j].w * v[j].w); }
    float r = sc;
    if (mode == 1) r = __builtin_amdgcn_rsqf(wave_sum(s) * (1.f / 4096.f) + EPS);
    GAS unsigned long long* o8 = (GAS unsigned long long*)dst + lane;
#pragma unroll
    for (int j = 0; j < 16; ++j) { f32x4 w = v[j] * r; if (mode == 1) w = w * ((const GAS f32x4*)g)[64 * j + lane];
        if (dst8) ((GAS unsigned*)dst8)[64 * j + lane] = pg8::pk_i8x4(w, q8);
        else o8[64 * j] = (unsigned long long)pk2(w.x, w.y) | ((unsigned long long)pk2(w.z, w.w) << 32); }
}
__device__ __forceinline__ void row4096_to_fp8(const float* src, unsigned char* dst, float* sc_out, int lane) {
    const GAS f32x4* xr = (const GAS f32x4*)src + lane;
    f32x4 v[16]; float am = 0.f;
#pragma unroll
    for (int j = 0; j < 16; ++j) { v[j] = xr[64 * j]; am = fmaxf(am, fmaxf(fmaxf(fabsf(v[j].x), fabsf(v[j].y)), fmaxf(fabsf(v[j].z), fabsf(v[j].w)))); }
#pragma unroll
    for (int o = 1; o < 64; o <<= 1) am = fmaxf(am, __shfl_xor(am, o));
    const float q = (am > 0.f) ? 448.0f / am : 1.0f;
    GAS unsigned* o4 = (GAS unsigned*)dst + lane;
#pragma unroll
    for (int j = 0; j < 16; ++j) { int w = __builtin_amdgcn_cvt_pk_fp8_f32(v[j].x * q, v[j].y * q, 0, false); w = __builtin_amdgcn_cvt_pk_fp8_f32(v[j].z * q, v[j].w * q, w, true); o4[64 * j] = (unsigned)w; }
    if (lane == 0) *sc_out = (am > 0.f) ? am * (1.0f / 448.0f) : 1.0f;
}
__device__ __forceinline__ void row4096_to_fp4(const float* src, unsigned char* dst, float* sc_out, int lane) {
    const GAS f32x4* xr = (const GAS f32x4*)src + lane;
    f32x4 v[16]; float am = 0.f;
#pragma unroll
    for (int j = 0; j < 16; ++j) { v[j] = xr[64 * j]; am = fmaxf(am, fmaxf(fmaxf(fabsf(v[j].x), fabsf(v[j].y)), fmaxf(fabsf(v[j].z), fabsf(v[j].w)))); }
#pragma unroll
    for (int o = 1; o < 64; o <<= 1) am = fmaxf(am, __shfl_xor(am, o));
    const float q = (am > 0.f) ? 6.0f / am : 1.0f;
#pragma unroll
    for (int j = 0; j < 16; ++j) { unsigned w = __builtin_amdgcn_cvt_scalef32_pk_fp4_f32(0u, v[j].x * q, v[j].y * q, 1.0f, 0); w = __builtin_amdgcn_cvt_scalef32_pk_fp4_f32(w, v[j].z * q, v[j].w * q, 1.0f, 1);
        *(GAS unsigned short*)(dst + 1024 * (j >> 3) + 16 * (32 * (j & 1) + (lane >> 1)) + 4 * ((j >> 1) & 3) + 2 * (lane & 1)) = (unsigned short)w; }
    if (lane == 0) *sc_out = (am > 0.f) ? am * (1.0f / 6.0f) : 1.0f;
}
__device__ __forceinline__ unsigned pack_i8x4(float a, float b, float c, float d) {
    const int ia = (int)rintf(a), ib = (int)rintf(b), ic = (int)rintf(c), id = (int)rintf(d);
    return ((unsigned)ia & 255u) | (((unsigned)ib & 255u) << 8) | (((unsigned)ic & 255u) << 16) | ((unsigned)id << 24); }
__device__ __forceinline__ void row4096_to_i8(const float* src, unsigned char* dst, float* sc_out, int lane) {
    const GAS f32x4* xr = (const GAS f32x4*)src + lane;
    f32x4 v[16]; float am = 0.f;
#pragma unroll
    for (int j = 0; j < 16; ++j) { v[j] = xr[64 * j]; am = fmaxf(am, fmaxf(fmaxf(fabsf(v[j].x), fabsf(v[j].y)), fmaxf(fabsf(v[j].z), fabsf(v[j].w)))); }
#pragma unroll
    for (int o = 1; o < 64; o <<= 1) am = fmaxf(am, __shfl_xor(am, o));
    const float q = (am > 0.f) ? 127.0f / am : 1.0f;
    GAS unsigned* o4 = (GAS unsigned*)dst + lane;
#pragma unroll
    for (int j = 0; j < 16; ++j) o4[64 * j] = pack_i8x4(v[j].x * q, v[j].y * q, v[j].z * q, v[j].w * q);
    if (lane == 0) *sc_out = (am > 0.f) ? am * (1.0f / 127.0f) : 1.0f;
}
__device__ __forceinline__ void p0_prologue(Frame& F) {
    LAS float* scr = (LAS float*)(F.lds + F.wave * 16384);
    const int gw = F.vcu * NWAVES + F.wave, NGW = F.G * NWAVES;
    bf16* WS = (bf16*)F.ws;
    const float qs_in = WIN_QS;
    constexpr int I_IN = 64 * (NIN / 32), I_OUT = 64 * 128, I_CKV = 64 * 256, I_CO = 64 * 128, I_PQ = 64 * 64;
    constexpr int NITEMS = I_IN + I_OUT + I_CKV + I_CO + I_PQ;
    for (int it = gw; it < NITEMS; it += NGW) {
        int r = it;
        if (r < I_IN) { const int nb = r % (NIN / 32), kb = r / (NIN / 32), seg = nb >> 6;
            if ((FP8_SEGS >> seg) & 1) p0_transpose_item_fp8(F.ka->in[3], D, NIN, F.ws + WS_WIN8, qs_in, scr, kb * (NIN / 32) + nb, F.lane);
            else p0_transpose_item(F.ka->in[3], D, NIN, (bf16*)(F.ws + WS_WIN), nullptr, scr, kb * (NIN / 32) + nb, F.lane);
            continue; } r -= I_IN;
        if (r < I_OUT) { p0_transpose_item_fp8(F.ka->in[11], D, D, F.ws + WS_WOUT, WIN_QS, scr, r, F.lane); continue; } r -= I_OUT;
        if (r < I_CKV) { p0_transpose_item_fp8(F.ka->in[15], D, 2 * D, F.ws + WS_WCKV, WIN_QS, scr, r, F.lane); continue; } r -= I_CKV;
        if (r < I_CO) { p0_transpose_item_fp8(F.ka->in[16], D, D, F.ws + WS_WCO, WIN_QS, scr, r, F.lane); continue; } r -= I_CO;
        p0_transpose_item_fp8(F.ka->in[18], D, 2048, F.ws + WS_WPQ, WIN_QS, scr, r, F.lane, F.ka->in[17]);
    }
    (void)WS;
    constexpr int R_X = M, R_MEM = MROWS, R_CQ = D, R_DOWN = NEXP, R_UP = NEXP, R_SK = 64;
    constexpr int NROWS = R_X + R_MEM + R_CQ + R_DOWN + R_UP + R_SK;
    for (int it = gw; it < NROWS; it += NGW) {
        int r = it;
        if (r < R_X) { row4096_norm_to_fp8(F.ka->in[0] + (size_t)r * D, F.ka->in[2], F.ws + WS_XN8 + (size_t)r * D, (bf16*)(F.ws + WS_XN) + (size_t)r * D, (float*)(F.ws + WS_SA) + r, F.lane); continue; } r -= R_X;
        if (r < R_MEM) { row4096_to_bf16(F.ka->in[1] + (size_t)r * D, nullptr, F.ka->in[13], 1.f, 1, F.lane, F.ws + WS_MEMN + (size_t)r * D, KV_Q8); continue; } r -= R_MEM;
        if (r < R_CQ) { row4096_to_bf16(F.ka->in[14] + (size_t)r * D, nullptr, nullptr, F.ka->in[12][r], 0, F.lane, F.ws + WS_WCQ + (size_t)r * D, WIN_QS); continue; } r -= R_CQ;
        if (r < R_DOWN) { row4096_to_i8(F.ka->in[20] + (size_t)r * D, F.ws + WS_DOWN + (size_t)r * D, (float*)(F.ws + WS_DSC) + r, F.lane); continue; } r -= R_DOWN;
        if (r < R_UP) { row4096_to_fp4(F.ka->in[21] + (size_t)r * D, F.ws + WS_UP + (size_t)r * 2048, (float*)(F.ws + WS_USC) + r, F.lane); continue; }        r -= R_UP;
        row4096_to_bf16(F.ka->in[19] + (size_t)r * D, (bf16*)(F.ws + WS_SUBK) + (size_t)r * D, nullptr, 1.f, 0, F.lane);
    }
}

#define DPP_MUL(d, a, b, J) asm volatile("v_mul_f32_dpp %0, %1, %2 row_newbcast:" #J " row_mask:0xf bank_mask:0xf" : "=v"(d) : "v"(a), "v"(b))
#define DPP_FMAC(d, a, b, J) asm volatile("v_fmac_f32_dpp %0, %1, %2 row_newbcast:" #J " row_mask:0xf bank_mask:0xf" : "+v"(d) : "v"(a), "v"(b))
constexpr int HG_T = 32, HG_P = 36;
#define HG_STEP(QV, FV, KV, IV, TT) { float u0_, u1_, u2_, u3_, u4_, u5_, u6_, u7_, a0 = 0.f, a1 = 0.f; \
    asm volatile("s_nop 1\n\tv_mul_f32_dpp %0, %1, %2 row_newbcast:0 row_mask:0xf bank_mask:0xf" : "=v"(u0_) : "v"(FV), "v"(s[0]), "v"(QV), "v"(KV)); \
    DPP_MUL(u1_, FV, s[1], 1); DPP_MUL(u2_, FV, s[2], 2); DPP_MUL(u3_, FV, s[3], 3); DPP_MUL(u4_, FV, s[4], 4); DPP_MUL(u5_, FV, s[5], 5); DPP_MUL(u6_, FV, s[6], 6); DPP_MUL(u7_, FV, s[7], 7); \
    DPP_FMAC(u0_, KV, IV, 0); DPP_FMAC(u1_, KV, IV, 1); DPP_FMAC(u2_, KV, IV, 2); DPP_FMAC(u3_, KV, IV, 3); DPP_FMAC(u4_, KV, IV, 4); DPP_FMAC(u5_, KV, IV, 5); DPP_FMAC(u6_, KV, IV, 6); DPP_FMAC(u7_, KV, IV, 7); \
    DPP_FMAC(a0, QV, u0_, 0); DPP_FMAC(a1, QV, u1_, 1); DPP_FMAC(a0, QV, u2_, 2); DPP_FMAC(a1, QV, u3_, 3); DPP_FMAC(a0, QV, u4_, 4); DPP_FMAC(a1, QV, u5_, 5); DPP_FMAC(a0, QV, u6_, 6); DPP_FMAC(a1, QV, u7_, 7); \
    s[0] = u0_; s[1] = u1_; s[2] = u2_; s[3] = u3_; s[4] = u4_; s[5] = u5_; s[6] = u6_; s[7] = u7_; Pl[pslot + (TT) * 32] = a0 + a1; }
__device__ __forceinline__ void hgrn_unit(Frame& F, int b, int h, int vq) {
    const int tid = F.tid, lane = F.lane, w = F.wave;
    LAS float* Ql = (LAS float*)F.lds; LAS float* Fl = Ql + 128 * HG_P; LAS float* Kl = Fl + 128 * HG_P; LAS float* Il = Kl + 128 * HG_P; LAS float* Pl = Il + 32 * HG_P;
    const bf16* Pb = (const bf16*)(F.ws + WS_PROJ) + (size_t)b * SEQ * NIN;
    bf16* MIX = (bf16*)(F.ws + WS_XN); float* HSSQ = (float*)(F.ws + WS_HSSQ);
    const int lrow = tid & 31, lseg = tid >> 5;
    const bf16* qsrc = Pb + (size_t)lrow * NIN + COL_HQ + h * 128 + lseg * 8;
    const bf16* ksrc = Pb + (size_t)lrow * NIN + COL_HF + h * 128 + lseg * 8;
    const int iseg = (tid >> 5) & 3;
    const bf16* isrc = Pb + (size_t)lrow * NIN + COL_HI + h * 128 + vq * 32 + iseg * 8;
    float s[8];
#pragma unroll
    for (int j = 0; j < 8; ++j) s[j] = 0.f;
    v4u rq = *(const GAS v4u*)qsrc, rk = *(const GAS v4u*)ksrc, ri = (v4u){0u, 0u, 0u, 0u};
    if (tid < 128) ri = *(const GAS v4u*)isrc;
    const int idxq = (16 * w + 8 * (lane >> 5) + (lane & 7)) * HG_P, idxi = (lane & 31) * HG_P;
    const int pslot = (w * 2 + (lane >> 5)) * HG_T * 32 + (lane & 31);
    constexpr int NCH = SEQ / HG_T;
    __syncthreads();
    for (int c = 0; c < NCH; ++c) {
        {
            const unsigned qa[4] = {rq.x, rq.y, rq.z, rq.w}, ka[4] = {rk.x, rk.y, rk.z, rk.w}, ia[4] = {ri.x, ri.y, ri.z, ri.w};
            const int o = (lseg * 8) * HG_P + lrow;
#pragma unroll
            for (int j = 0; j < 4; ++j) { const float q0 = bflo(qa[j]), q1 = bfhi(qa[j]), k0 = bflo(ka[j]), k1 = bfhi(ka[j]);
                Ql[o + (2 * j) * HG_P] = q0; Ql[o + (2 * j + 1) * HG_P] = q1; Kl[o + (2 * j) * HG_P] = k0; Kl[o + (2 * j + 1) * HG_P] = k1; Fl[o + (2 * j) * HG_P] = 1.0f - k0; Fl[o + (2 * j + 1) * HG_P] = 1.0f - k1; }
            if (tid < 128) { const int oi = (iseg * 8) * HG_P + lrow;
#pragma unroll
                for (int j = 0; j < 4; ++j) { Il[oi + (2 * j) * HG_P] = bflo(ia[j]); Il[oi + (2 * j + 1) * HG_P] = bfhi(ia[j]); } }
        }
        if (c + 1 < NCH) { const size_t adv = (size_t)(c + 1) * HG_T * NIN; rq = *(const GAS v4u*)(qsrc + adv); rk = *(const GAS v4u*)(ksrc + adv); if (tid < 128) ri = *(const GAS v4u*)(isrc + adv); }
        __syncthreads();
        f32x4 qv = *(const LAS f32x4*)(Ql + idxq), fv = *(const LAS f32x4*)(Fl + idxq), kv = *(const LAS f32x4*)(Kl + idxq), iv = *(const LAS f32x4*)(Il + idxi);
#pragma unroll 2
        for (int t4 = 0; t4 < HG_T; t4 += 4) {
            const int tn = (t4 + 4 < HG_T) ? t4 + 4 : t4;
            const f32x4 qn = *(const LAS f32x4*)(Ql + idxq + tn), fn = *(const LAS f32x4*)(Fl + idxq + tn), kn = *(const LAS f32x4*)(Kl + idxq + tn), in_ = *(const LAS f32x4*)(Il + idxi + tn);
            HG_STEP(qv.x, fv.x, kv.x, iv.x, t4 + 0)
            HG_STEP(qv.y, fv.y, kv.y, iv.y, t4 + 1)
            HG_STEP(qv.z, fv.z, kv.z, iv.z, t4 + 2)
            HG_STEP(qv.w, fv.w, kv.w, iv.w, t4 + 3)
            qv = qn; fv = fn; kv = kn; iv = in_;
        }
        __syncthreads();
        {
            const int t = tid >> 4, vp = tid & 15; typedef float f32x2v __attribute__((ext_vector_type(2)));
            f32x2v o = {0.f, 0.f};
#pragma unroll
            for (int p = 0; p < 16; ++p) { const f32x2v x = *(LAS f32x2v*)(Pl + (p * HG_T + t) * 32 + 2 * vp); o += x; }
            const size_t grow = (size_t)b * SEQ + (size_t)c * HG_T + t;
            *(GAS unsigned*)(MIX + grow * D + 2048 + h * 128 + vq * 32 + 2 * vp) = pk2(o.x, o.y);
            float ss = o.x * o.x + o.y * o.y;
            ss += __shfl_xor(ss, 1); ss += __shfl_xor(ss, 2); ss += __shfl_xor(ss, 4); ss += __shfl_xor(ss, 8);
            if (vp == 0) HSSQ[grow * 64 + h * 4 + vq] = ss;
        }
    }
    __syncthreads();
}
#define DPPX(v, ctrl) __builtin_amdgcn_update_dpp(0, (v), (ctrl), 0xf, 0xf, false)
typedef short s16x4 __attribute__((ext_vector_type(4)));
#define MFMA16K16(a, b, c) __builtin_amdgcn_mfma_f32_16x16x16bf16_1k((a), (b), (c), 0, 0, 0)
#define MFMA16K32(a, b, c) __builtin_amdgcn_mfma_f32_16x16x32_bf16((a), (b), (c), 0, 0, 0)
constexpr int HM_P = 272;
constexpr int HM_NS = 4, HM_BLK = 39936;
__device__ __forceinline__ void hgrn_unit_mfma(Frame& F, int b, int h, int vq) {
    const int tid = F.tid, lane = F.lane, w = F.wave, l15 = lane & 15, kg = lane >> 4;
    const bf16* Pb = (const bf16*)(F.ws + WS_PROJ) + (size_t)b * SEQ * NIN;
    bf16* MIX = (bf16*)(F.ws + WS_XN); float* HSSQ = (float*)(F.ws + WS_HSSQ);
    const int lt = tid >> 5, ls = tid & 31;
    const bf16* qksrc = Pb + (size_t)lt * NIN + (ls < 16 ? COL_HQ : COL_HF) + h * 128 + (ls & 15) * 8;
    const bf16* isrc = Pb + (size_t)((tid >> 2) & 15) * NIN + COL_HI + h * 128 + vq * 32 + (tid & 3) * 8;
    v4u rqk[HM_NS], ri[HM_NS];
#pragma unroll
    for (int u = 0; u < HM_NS; ++u) { rqk[u] = *(const GAS v4u*)(qksrc + (size_t)u * 16 * NIN); ri[u] = (v4u){0u, 0u, 0u, 0u}; if (tid < 64) ri[u] = *(const GAS v4u*)(isrc + (size_t)u * 16 * NIN); }
    f32x4 S[2] = {(f32x4){0.f, 0.f, 0.f, 0.f}, (f32x4){0.f, 0.f, 0.f, 0.f}};
    constexpr int NIT = SEQ / (16 * HM_NS);
    __syncthreads();
    for (int c = 0; c < NIT; ++c) {
#pragma unroll
        for (int u = 0; u < HM_NS; ++u) { LAS unsigned char* L = F.lds + u * HM_BLK;
            *(LAS v4u*)((LAS unsigned short*)(L + (ls < 16 ? 0 : 4096)) + lt * 128 + (ls & 15) * 8) = rqk[u];
            if (tid < 64) *(LAS v4u*)((LAS unsigned short*)(L + 8192) + (tid >> 2) * 32 + (tid & 3) * 8) = ri[u]; }
        if (c + 1 < NIT) {
#pragma unroll
            for (int u = 0; u < HM_NS; ++u) { const size_t adv = (size_t)((c + 1) * HM_NS + u) * 16 * NIN; rqk[u] = *(const GAS v4u*)(qksrc + adv); if (tid < 64) ri[u] = *(const GAS v4u*)(isrc + adv); } }
        __syncthreads();
#pragma unroll
        for (int u = 0; u < HM_NS; ++u) {
            LAS unsigned char* L = F.lds + u * HM_BLK;
            LAS unsigned short* RAWQ = (LAS unsigned short*)L; LAS unsigned short* RAWK = (LAS unsigned short*)(L + 4096); LAS unsigned short* RAWI = (LAS unsigned short*)(L + 8192);
            LAS unsigned char* QT = L + 9216; LAS unsigned char* KT = L + 13568; LAS unsigned short* KH = (LAS unsigned short*)(L + 17920); LAS unsigned short* IT = (LAS unsigned short*)(L + 22016); LAS float* D16 = (LAS float*)(L + 23040);
            const int d = tid >> 2, tq = tid & 3;
            float qv[4], kv[4], cs[4]; float run = 0.f;
#pragma unroll
            for (int j = 0; j < 4; ++j) { const int t = 4 * tq + j; qv[j] = bf2f(RAWQ[t * 128 + d]); kv[j] = bf2f(RAWK[t * 128 + d]); run += __log2f(fmaxf(1.0f - kv[j], 1.0e-6f)); cs[j] = run; }
            const float t0 = __int_as_float(DPPX(__float_as_int(run), 0x00)), t1 = __int_as_float(DPPX(__float_as_int(run), 0x55)), t2 = __int_as_float(DPPX(__float_as_int(run), 0xAA)), t3 = __int_as_float(DPPX(__float_as_int(run), 0xFF));
            const float off = (tq > 0 ? t0 : 0.f) + (tq > 1 ? t1 : 0.f) + (tq > 2 ? t2 : 0.f), b16 = (t0 + t1) + (t2 + t3);
#pragma unroll
            for (int j = 0; j < 4; ++j) { const int t = 4 * tq + j; const float bt = off + cs[j];
                *(LAS unsigned short*)(QT + t * HM_P + d * 2) = (unsigned short)f2bf(qv[j] * __builtin_amdgcn_exp2f(bt));
                *(LAS unsigned short*)(KT + t * HM_P + d * 2) = (unsigned short)f2bf(kv[j] * __builtin_amdgcn_exp2f(-bt));
                KH[d * 16 + t] = (unsigned short)f2bf(kv[j] * __builtin_amdgcn_exp2f(b16 - bt)); }
            if (tq == 0) D16[d] = __builtin_amdgcn_exp2f(b16);
            IT[(tid & 31) * 16 + (tid >> 5)] = RAWI[(tid >> 5) * 32 + (tid & 31)];
        }
        __syncthreads();
#pragma unroll
        for (int u = 0; u < HM_NS; ++u) {
            LAS unsigned char* L = F.lds + u * HM_BLK;
            LAS unsigned char* QT = L + 9216; LAS unsigned char* KT = L + 13568; LAS unsigned short* KH = (LAS unsigned short*)(L + 17920); LAS unsigned short* IT = (LAS unsigned short*)(L + 22016); LAS float* D16 = (LAS float*)(L + 23040); LAS float* PART = (LAS float*)(L + 23552);
            typedef unsigned u32x2v __attribute__((ext_vector_type(2)));
            const s16x4 aq = *(const LAS s16x4*)(QT + l15 * HM_P + (16 * w + 4 * kg) * 2);
            const s16x4 bi0 = *(const LAS s16x4*)(IT + l15 * 16 + 4 * kg), bi1 = *(const LAS s16x4*)(IT + (16 + l15) * 16 + 4 * kg);
            f32x4 O0 = {0.f, 0.f, 0.f, 0.f}, O1 = O0;
            { const s16x4 bs0 = __builtin_bit_cast(s16x4, (u32x2v){pg8::cvt_pk_bf16(S[0][0], S[0][1]), pg8::cvt_pk_bf16(S[0][2], S[0][3])}), bs1 = __builtin_bit_cast(s16x4, (u32x2v){pg8::cvt_pk_bf16(S[1][0], S[1][1]), pg8::cvt_pk_bf16(S[1][2], S[1][3])});
              O0 = MFMA16K16(aq, bs0, O0); O1 = MFMA16K16(aq, bs1, O1); }
            if (w == u) {
                f32x4 at = {0.f, 0.f, 0.f, 0.f};
#pragma unroll
                for (int ks = 0; ks < 4; ++ks) { const bf16x8 ak = *(const LAS bf16x8*)(KT + l15 * HM_P + (32 * ks + 8 * kg) * 2), bq = *(const LAS bf16x8*)(QT + l15 * HM_P + (32 * ks + 8 * kg) * 2); at = MFMA16K32(ak, bq, at); }
#pragma unroll
                for (int r = 0; r < 4; ++r) if (4 * kg + r > l15) at[r] = 0.f;
                const s16x4 aA = __builtin_bit_cast(s16x4, (u32x2v){pg8::cvt_pk_bf16(at[0], at[1]), pg8::cvt_pk_bf16(at[2], at[3])});
                O0 = MFMA16K16(aA, bi0, O0); O1 = MFMA16K16(aA, bi1, O1);
            }
            LAS float* pp = PART + (w * 16 + 4 * kg) * 32 + l15;
#pragma unroll
            for (int r = 0; r < 4; ++r) { pp[r * 32] = O0[r]; pp[r * 32 + 16] = O1[r]; }
            const f32x4 d4 = *(const LAS f32x4*)(D16 + 16 * w + 4 * kg);
            const s16x4 akh = *(const LAS s16x4*)(KH + (16 * w + l15) * 16 + 4 * kg);
            S[0] = MFMA16K16(akh, bi0, S[0] * d4); S[1] = MFMA16K16(akh, bi1, S[1] * d4);
        }
        __syncthreads();
        {
            const int t = (tid >> 4) & 15, vp = tid & 15; typedef float f32x2v __attribute__((ext_vector_type(2)));
#pragma unroll
            for (int u = tid >> 8; u < HM_NS; u += 2) {
            const LAS float* PART = (const LAS float*)(F.lds + u * HM_BLK + 23552);
            f32x2v o = {0.f, 0.f};
#pragma unroll
            for (int p = 0; p < 8; ++p) { const f32x2v x = *(const LAS f32x2v*)(PART + (p * 16 + t) * 32 + 2 * vp); o += x; }
            const size_t grow = (size_t)b * SEQ + (size_t)(c * HM_NS + u) * 16 + t;
            *(GAS unsigned*)(MIX + grow * D + 2048 + h * 128 + vq * 32 + 2 * vp) = pk2(o.x, o.y);
            float ss = o.x * o.x + o.y * o.y;
            ss += __shfl_xor(ss, 1); ss += __shfl_xor(ss, 2); ss += __shfl_xor(ss, 4); ss += __shfl_xor(ss, 8);
            if (vp == 0) HSSQ[grow * 64 + h * 4 + vq] = ss;
            }
        }
    }
    __syncthreads();
}
#define HBAR() asm volatile("s_waitcnt lgkmcnt(0)\n\ts_barrier" ::: "memory")
constexpr int HH_NS = 4, HH_BLK = 37888;
__device__ __forceinline__ void hgrn_head_mfma(Frame& F, int b, int h) {
    const int tid = F.tid, lane = F.lane, w = F.wave, l15 = lane & 15, kg = lane >> 4;
    const bf16* Pb = (const bf16*)(F.ws + WS_PROJ) + (size_t)b * SEQ * NIN;
    bf16* MIX = (bf16*)(F.ws + WS_XN); const float* ng = F.ka->in[10];
    const int pp = tid & 255, pst = pp >> 4, psg = pp & 15;
    const bf16* qksrc = Pb + (size_t)pst * NIN + (tid < 256 ? COL_HQ : COL_HF) + h * 128 + psg * 8;
    const bf16* isrc = Pb + (size_t)pst * NIN + COL_HI + h * 128 + psg * 8;
    v4u rqk[HH_NS], ri[HH_NS];
#pragma unroll
    for (int u = 0; u < HH_NS; ++u) { rqk[u] = *(const GAS v4u*)(qksrc + (size_t)u * 16 * NIN); ri[u] = (v4u){0u, 0u, 0u, 0u}; if (tid < 256) ri[u] = *(const GAS v4u*)(isrc + (size_t)u * 16 * NIN); }
    f32x4 S[8];
#pragma unroll
    for (int j = 0; j < 8; ++j) S[j] = (f32x4){0.f, 0.f, 0.f, 0.f};
    f32x4 n0 = *(const GAS f32x4*)(ng + 8 * (tid & 15)), n1 = *(const GAS f32x4*)(ng + 8 * (tid & 15) + 4);
    asm volatile("" : "+v"(n0), "+v"(n1));
    constexpr int NIT = SEQ / (16 * HH_NS);
    __syncthreads();
    for (int c = 0; c < NIT; ++c) {
#pragma unroll
        for (int u = 0; u < HH_NS; ++u) { LAS unsigned char* L = F.lds + u * HH_BLK;
            *(LAS v4u*)((LAS unsigned short*)(L + (tid < 256 ? 0 : 4096)) + pst * 128 + psg * 8) = rqk[u];
            if (tid < 256) *(LAS v4u*)((LAS unsigned short*)(L + 8192) + pst * 128 + psg * 8) = ri[u]; }
#define HH_GLD(dst, ptr) asm volatile("global_load_dwordx4 %0, %1, off" : "=v"(dst) : "v"(ptr) : "memory")
        if (c + 1 < NIT) {
#pragma unroll
            for (int u = 0; u < HH_NS; ++u) { const size_t adv = (size_t)((c + 1) * HH_NS + u) * 16 * NIN; HH_GLD(rqk[u], qksrc + adv); if (tid < 256) HH_GLD(ri[u], isrc + adv); } }
        v4u gpre[2];
#pragma unroll
        for (int k = 0; k < 2; ++k) HH_GLD(gpre[k], Pb + ((size_t)(c * HH_NS + (tid >> 8) + 2 * k) * 16 + ((tid >> 4) & 15)) * NIN + COL_HG + h * 128 + 8 * (tid & 15));
#undef HH_GLD
        HBAR();
        {
            const int u = w >> 1, d = 64 * (w & 1) + lane;
            LAS unsigned char* L = F.lds + u * HH_BLK;
            LAS unsigned short* RAWQ = (LAS unsigned short*)L; LAS unsigned short* RAWK = (LAS unsigned short*)(L + 4096);
            LAS unsigned char* QT = L + 12288; LAS unsigned char* KT = L + 16640; LAS unsigned char* KHb = L + 20992; LAS float* D16 = (LAS float*)(L + 29184);
            float kv[16], cs[16]; float run = 0.f;
#pragma unroll
            for (int t = 0; t < 16; ++t) { kv[t] = bf2f(RAWK[t * 128 + d]); run += __log2f(fmaxf(1.0f - kv[t], 1.0e-6f)); cs[t] = run; }
            const float b16 = run;
            unsigned kh[8];
#pragma unroll
            for (int t = 0; t < 16; t += 2) {
                const float q0 = bf2f(RAWQ[t * 128 + d]), q1 = bf2f(RAWQ[(t + 1) * 128 + d]);
                *(LAS unsigned short*)(QT + t * HM_P + d * 2) = (unsigned short)f2bf(q0 * __builtin_amdgcn_exp2f(cs[t]));
                *(LAS unsigned short*)(QT + (t + 1) * HM_P + d * 2) = (unsigned short)f2bf(q1 * __builtin_amdgcn_exp2f(cs[t + 1]));
                *(LAS unsigned short*)(KT + t * HM_P + d * 2) = (unsigned short)f2bf(kv[t] * __builtin_amdgcn_exp2f(-cs[t]));
                *(LAS unsigned short*)(KT + (t + 1) * HM_P + d * 2) = (unsigned short)f2bf(kv[t + 1] * __builtin_amdgcn_exp2f(-cs[t + 1]));
                kh[t >> 1] = pk2(kv[t] * __builtin_amdgcn_exp2f(b16 - cs[t]), kv[t + 1] * __builtin_amdgcn_exp2f(b16 - cs[t + 1])); }
            *(LAS v4u*)(KHb + d * 32) = (v4u){kh[0], kh[1], kh[2], kh[3]}; *(LAS v4u*)(KHb + d * 32 + 16) = (v4u){kh[4], kh[5], kh[6], kh[7]};
            D16[d] = __builtin_amdgcn_exp2f(b16);
        }
        {
            const int u = tid >> 7, v = tid & 127;
            LAS unsigned char* L = F.lds + u * HH_BLK; LAS unsigned short* RAWI = (LAS unsigned short*)(L + 8192); LAS unsigned char* ITb = L + 25088;
            unsigned iw[8];
#pragma unroll
            for (int t = 0; t < 16; t += 2) iw[t >> 1] = (unsigned)RAWI[t * 128 + v] | ((unsigned)RAWI[(t + 1) * 128 + v] << 16);
            *(LAS v4u*)(ITb + v * 32) = (v4u){iw[0], iw[1], iw[2], iw[3]}; *(LAS v4u*)(ITb + v * 32 + 16) = (v4u){iw[4], iw[5], iw[6], iw[7]};
        }
        HBAR();
        typedef unsigned u32x2v __attribute__((ext_vector_type(2)));
        s16x4 aA[HH_NS];
#pragma unroll
        for (int u = 0; u < HH_NS; ++u) {
            LAS unsigned char* L = F.lds + u * HH_BLK; LAS unsigned char* QT = L + 12288; LAS unsigned char* KT = L + 16640;
            f32x4 at = {0.f, 0.f, 0.f, 0.f};
#pragma unroll
            for (int ks = 0; ks < 4; ++ks) { const bf16x8 ak = *(const LAS bf16x8*)(KT + l15 * HM_P + (32 * ks + 8 * kg) * 2), bq = *(const LAS bf16x8*)(QT + l15 * HM_P + (32 * ks + 8 * kg) * 2); at = MFMA16K32(ak, bq, at); }
#pragma unroll
            for (int r = 0; r < 4; ++r) if (4 * kg + r > l15) at[r] = 0.f;
            aA[u] = __builtin_bit_cast(s16x4, (u32x2v){pg8::cvt_pk_bf16(at[0], at[1]), pg8::cvt_pk_bf16(at[2], at[3])});
        }
#pragma unroll
        for (int u = 0; u < HH_NS; ++u) {
            LAS unsigned char* L = F.lds + u * HH_BLK;
            LAS unsigned char* QT = L + 12288; LAS unsigned short* KH = (LAS unsigned short*)(L + 20992); LAS unsigned short* IT = (LAS unsigned short*)(L + 25088); LAS float* D16 = (LAS float*)(L + 29184); LAS float* OUT = (LAS float*)(L + 29696);
            const s16x4 bi = *(const LAS s16x4*)(IT + (16 * w + l15) * 16 + 4 * kg);
            f32x4 O0 = {0.f, 0.f, 0.f, 0.f}, O1 = O0;
            O1 = MFMA16K16(aA[u], bi, O1);
#pragma unroll
            for (int j = 0; j < 8; j += 2) {
                const s16x4 aq0 = *(const LAS s16x4*)(QT + l15 * HM_P + (16 * j + 4 * kg) * 2), aq1 = *(const LAS s16x4*)(QT + l15 * HM_P + (16 * (j + 1) + 4 * kg) * 2);
                const s16x4 bs0 = __builtin_bit_cast(s16x4, (u32x2v){pg8::cvt_pk_bf16(S[j][0], S[j][1]), pg8::cvt_pk_bf16(S[j][2], S[j][3])});
                const s16x4 bs1 = __builtin_bit_cast(s16x4, (u32x2v){pg8::cvt_pk_bf16(S[j + 1][0], S[j + 1][1]), pg8::cvt_pk_bf16(S[j + 1][2], S[j + 1][3])});
                O0 = MFMA16K16(aq0, bs0, O0); O1 = MFMA16K16(aq1, bs1, O1); }
            const f32x4 O = O0 + O1;
            LAS float* op = OUT + (4 * kg) * 128 + 16 * w + l15;
#pragma unroll
            for (int r = 0; r < 4; ++r) op[r * 128] = O[r];
#pragma unroll
            for (int j = 0; j < 8; ++j) { const f32x4 d4 = *(const LAS f32x4*)(D16 + 16 * j + 4 * kg);
                const s16x4 akh = *(const LAS s16x4*)(KH + (16 * j + l15) * 16 + 4 * kg);
                S[j] = MFMA16K16(akh, bi, S[j] * d4); }
        }
        HBAR();
        asm volatile("s_waitcnt vmcnt(0)" ::: "memory");
        {
            const int t = (tid >> 4) & 15, vs = tid & 15;
#pragma unroll
            for (int k = 0; k < 2; ++k) { const int u = (tid >> 8) + 2 * k;
                const LAS float* OUT = (const LAS float*)(F.lds + u * HH_BLK + 29696);
                const size_t grow = (size_t)b * SEQ + (size_t)(c * HH_NS + u) * 16 + t;
                const v4u g = gpre[k];
                const f32x4 o0 = *(const LAS f32x4*)(OUT + t * 128 + 8 * vs), o1 = *(const LAS f32x4*)(OUT + t * 128 + 8 * vs + 4);
                float ss = ((o0.x * o0.x + o0.y * o0.y) + (o0.z * o0.z + o0.w * o0.w)) + ((o1.x * o1.x + o1.y * o1.y) + (o1.z * o1.z + o1.w * o1.w));
                ss += __shfl_xor(ss, 1); ss += __shfl_xor(ss, 2); ss += __shfl_xor(ss, 4); ss += __shfl_xor(ss, 8);
                const float rstd = __builtin_amdgcn_rsqf(ss * (1.f / 128.f) + EPS);
                typedef unsigned u32x2m __attribute__((ext_vector_type(2))); u32x2m r;
                r.x = pg8::pk_i8x4((f32x4){o0.x * rstd * n0.x * bflo(g.x), o0.y * rstd * n0.y * bfhi(g.x), o0.z * rstd * n0.z * bflo(g.y), o0.w * rstd * n0.w * bfhi(g.y)}, MIX_Q8);
                r.y = pg8::pk_i8x4((f32x4){o1.x * rstd * n1.x * bflo(g.z), o1.y * rstd * n1.y * bfhi(g.z), o1.z * rstd * n1.z * bflo(g.w), o1.w * rstd * n1.w * bfhi(g.w)}, MIX_Q8);
                *(GAS u32x2m*)(F.ws + WS_XN8 + grow * D + 2048 + h * 128 + 8 * vs) = r;
            }
        }
    }
    __syncthreads();
}
__device__ __forceinline__ void hgrn_fixup(Frame& F) {
    bf16* MIX = (bf16*)(F.ws + WS_XN); const float* HSSQ = (const float*)(F.ws + WS_HSSQ); const bf16* PROJ = (const bf16*)(F.ws + WS_PROJ); const float* ng = F.ka->in[10];
    const size_t total = (size_t)M * 256, stride = (size_t)F.G * NTHR;
    for (size_t idx = (size_t)F.vcu * NTHR + F.tid; idx < total; idx += stride) {
        const size_t row = idx >> 8; const int cg = (int)(idx & 255), hh = cg >> 4, col = cg * 8;
        const f32x4 q = *(const GAS f32x4*)(HSSQ + row * 64 + hh * 4);
        const float rstd = __builtin_amdgcn_rsqf(((q.x + q.y) + (q.z + q.w)) * (1.f / 128.f) + EPS);
        const v4u o = *(const GAS v4u*)(MIX + row * D + 2048 + col), g = *(const GAS v4u*)(PROJ + row * NIN + COL_HG + col);
        const f32x4 n0 = *(const GAS f32x4*)(ng + (col & 127)), n1 = *(const GAS f32x4*)(ng + (col & 127) + 4);
        v4u r;
        r.x = pk2(bflo(o.x) * rstd * n0.x * bflo(g.x), bfhi(o.x) * rstd * n0.y * bfhi(g.x)); r.y = pk2(bflo(o.y) * rstd * n0.z * bflo(g.y), bfhi(o.y) * rstd * n0.w * bfhi(g.y));
        r.z = pk2(bflo(o.z) * rstd * n1.x * bflo(g.z), bfhi(o.z) * rstd * n1.y * bfhi(g.z)); r.w = pk2(bflo(o.w) * rstd * n1.z * bflo(g.w), bfhi(o.w) * rstd * n1.w * bfhi(g.w));
        *(GAS v4u*)(MIX + row * D + 2048 + col) = r;
    }
}
typedef float f32x16 __attribute__((ext_vector_type(16)));
typedef short v4i16_t __attribute__((ext_vector_type(4)));
#define MFMA32(a, b, c) __builtin_amdgcn_mfma_f32_32x32x16_bf16((a), (b), (c), 0, 0, 0)
__device__ __forceinline__ int crow(int i, int hh) { return (i & 3) + 8 * (i >> 2) + 4 * hh; }
__device__ __forceinline__ float xhalf_max(float m) { auto rr = __builtin_amdgcn_permlane32_swap(__float_as_uint(m), __float_as_uint(m), false, false); return fmaxf(__uint_as_float(rr[0]), __uint_as_float(rr[1])); }
__device__ __forceinline__ float xhalf_sum(float m) { auto rr = __builtin_amdgcn_permlane32_swap(__float_as_uint(m), __float_as_uint(m), false, false); return __uint_as_float(rr[0]) + __uint_as_float(rr[1]); }
constexpr int AT_KP = 144, AT_VP = 320, AT_KB = 64 * AT_KP, AT_VB = 64 * AT_VP, AT_VOFF = 2 * AT_KB, AT_AOFF = AT_VOFF + 2 * AT_VB;
__device__ __forceinline__ void attn_unit(Frame& F, int b, int h, int qb, float lam) {
    const int tid = F.tid, lane = F.lane, w = F.wave, r = lane & 31, hh = lane >> 5;
    const bf16* Pb = (const bf16*)(F.ws + WS_PROJ) + (size_t)b * SEQ * NIN;
    LAS unsigned char* Kl = F.lds; LAS unsigned char* Vl = F.lds + AT_VOFF; LAS float* Al = (LAS float*)(F.lds + AT_AOFF) + w * 32;
    const int q0 = qb * 256 + w * 32, qpos = q0 + r;
    const float cs = exp2f(-0.5f * (float)(h + 1)) * LOG2E;
    const int NT = 4 * (qb + 1);
    float* scr = (float*)(F.ws + WS_ATT) + (size_t)blockIdx.x * 32768;
    const int i16 = lane & 15, q4 = i16 >> 2, p4 = i16 & 3, g16 = (lane >> 4) & 1;
    const int vrd = (4 * hh + q4) * AT_VP + 32 * g16 + 8 * p4;
    f32x16 O[4];
    for (int c = 0; c < 2; ++c) {
        bf16x8 qf[4];
#pragma unroll
        for (int s = 0; s < 4; ++s) qf[s] = *(const GAS bf16x8*)(Pb + (size_t)qpos * NIN + COL_DQ + h * 128 + c * 64 + 16 * s + 8 * hh);
#pragma unroll
        for (int d = 0; d < 4; ++d)
#pragma unroll
            for (int i = 0; i < 16; ++i) O[d][i] = 0.f;
        float mrun = -1.0e30f, lrun = 0.f;
        const int krow = tid >> 3, kseg = tid & 7, vrow = tid >> 4, vseg = tid & 15;
        const unsigned koff = (unsigned)(krow * NIN + kseg * 8) * 2u, voff = (unsigned)(vrow * NIN + vseg * 8) * 2u;
        const char* kbase = (const char*)(Pb + COL_DK + h * 128 + c * 64); const char* vbase = (const char*)(Pb + COL_DV + h * 128);
        const int kdst = krow * AT_KP + kseg * 16, vdst = vrow * AT_VP + vseg * 16;
        v4u rkA, rv0A, rv1A, rkB, rv0B, rv1B;
#define AT_LD(S, TT) do { const size_t adv_ = (size_t)(TT) * 64 * NIN * 2; const char* kb2_ = kbase + adv_; const char* vb2_ = vbase + adv_; rk##S = *(const GAS v4u*)(kb2_ + koff); rv0##S = *(const GAS v4u*)(vb2_ + voff); rv1##S = *(const GAS v4u*)(vb2_ + (size_t)32 * NIN * 2 + voff); } while (0)
#define AT_ST(S, BB) do { *(LAS v4u*)(Kl + (BB) * AT_KB + kdst) = rk##S; *(LAS v4u*)(Vl + (BB) * AT_VB + vdst) = rv0##S; *(LAS v4u*)(Vl + (BB) * AT_VB + vdst + 32 * AT_VP) = rv1##S; } while (0)
        AT_LD(A, NT - 1);
        AT_LD(B, NT - 2);
        __syncthreads();
        AT_ST(A, 0);
        __syncthreads();
#define AT_ITER(IT, SLD, SST) do { const int it = (IT); \
            const int t = NT - 1 - it, buf = it & 1; \
            if (it + 2 < NT) AT_LD(SLD, t - 2); \
            if (64 * t <= q0 + 31) { \
                f32x16 st[2]; \
            _Pragma("unroll") \
                for (int nb = 0; nb < 2; ++nb) { \
            _Pragma("unroll") \
                    for (int i = 0; i < 16; ++i) st[nb][i] = 0.f; \
            _Pragma("unroll") \
                    for (int s = 0; s < 4; ++s) { const bf16x8 kf = *(const LAS bf16x8*)(Kl + buf * AT_KB + (32 * nb + r) * AT_KP + (16 * s + 8 * hh) * 2); st[nb] = MFMA32(kf, qf[s], st[nb]); } \
                } \
                const bool band = (64 * t + 63 > q0); \
                float cs_ = cs; asm volatile("" : "+v"(cs_)); \
                const float basev = cs_ * (float)(64 * t - qpos + 4 * hh); \
                float mx = -3.0e38f; \
                if (band) { \
                    const int thr = qpos - 64 * t - 4 * hh; \
            _Pragma("unroll") \
                    for (int nb = 0; nb < 2; ++nb) \
            _Pragma("unroll") \
                        for (int i = 0; i < 16; ++i) { const int kc = 32 * nb + (i & 3) + 8 * (i >> 2); float v = fmaf(cs_, (float)kc, st[nb][i]); \
                            if (kc > thr) v = -1.0e30f; st[nb][i] = v; mx = fmaxf(mx, v); } \
                } else { \
            _Pragma("unroll") \
                    for (int nb = 0; nb < 2; ++nb) \
            _Pragma("unroll") \
                        for (int i = 0; i < 16; ++i) { const int kc = 32 * nb + (i & 3) + 8 * (i >> 2); const float v = fmaf(cs_, (float)kc, st[nb][i]); st[nb][i] = v; mx = fmaxf(mx, v); } \
                } \
                const float mxt = xhalf_max(mx + basev); \
                if (__builtin_amdgcn_ballot_w64(mxt > mrun + 8.0f) != 0ull) { \
                    const float mnew = fmaxf(mrun, mxt), alpha = __builtin_amdgcn_exp2f(mrun - mnew); mrun = mnew; lrun *= alpha; \
                    if (hh == 0) Al[r] = alpha; \
                    f32x4 a4[4]; \
            _Pragma("unroll") \
                    for (int g = 0; g < 4; ++g) a4[g] = *(const LAS f32x4*)(Al + 8 * g + 4 * hh); \
            _Pragma("unroll") \
                    for (int d = 0; d < 4; ++d) \
            _Pragma("unroll") \
                        for (int i = 0; i < 16; ++i) O[d][i] *= a4[i >> 2][i & 3]; \
                } \
                const float mref = mrun - basev; \
                float rs = 0.f; \
            _Pragma("unroll") \
                for (int nb = 0; nb < 2; ++nb) \
            _Pragma("unroll") \
                    for (int i = 0; i < 16; ++i) { const float p = __builtin_amdgcn_exp2f(st[nb][i] - mref); st[nb][i] = p; rs += p; } \
                rs = xhalf_sum(rs); lrun += rs; \
            _Pragma("unroll") \
                for (int nb = 0; nb < 2; ++nb) \
            _Pragma("unroll") \
                    for (int s2 = 0; s2 < 2; ++s2) { \
                        v4u pw; pw.x = pg8::cvt_pk_bf16(st[nb][8 * s2 + 0], st[nb][8 * s2 + 1]); pw.y = pg8::cvt_pk_bf16(st[nb][8 * s2 + 2], st[nb][8 * s2 + 3]); \
                        pw.z = pg8::cvt_pk_bf16(st[nb][8 * s2 + 4], st[nb][8 * s2 + 5]); pw.w = pg8::cvt_pk_bf16(st[nb][8 * s2 + 6], st[nb][8 * s2 + 7]); \
                        const bf16x8 pf = __builtin_bit_cast(bf16x8, pw); \
                        const LAS unsigned char* vb = Vl + buf * AT_VB + (32 * nb + 16 * s2) * AT_VP + vrd; \
            _Pragma("unroll") \
                        for (int d = 0; d < 4; ++d) { \
                            const v4i16_t lo = __builtin_amdgcn_ds_read_tr16_b64_v4i16((LAS v4i16_t*)(vb + d * 64)), hi = __builtin_amdgcn_ds_read_tr16_b64_v4i16((LAS v4i16_t*)(vb + d * 64 + 8 * AT_VP)); \
                            const bf16x8 vf = __builtin_shufflevector(lo, hi, 0, 1, 2, 3, 4, 5, 6, 7); \
                            O[d] = MFMA32(pf, vf, O[d]); \
                        } \
                    } \
            } \
            if (it + 1 < NT) AT_ST(SST, buf ^ 1); \
            HBAR(); } while (0)
#pragma unroll 1
        for (int it2 = 0; it2 < NT; it2 += 2) { AT_ITER(it2, A, B); AT_ITER(it2 + 1, B, A); }
#undef AT_ITER
#undef AT_LD
#undef AT_ST
        if (hh == 0) Al[r] = 1.0f / lrun;
        f32x4 a4[4];
#pragma unroll
        for (int g = 0; g < 4; ++g) a4[g] = *(const LAS f32x4*)(Al + 8 * g + 4 * hh);
        float* sp = scr + tid * 64; asm volatile("" : "+v"(sp));
        if (c == 0) {
#pragma unroll
            for (int d = 0; d < 4; ++d)
#pragma unroll
                for (int g = 0; g < 4; ++g) *(GAS f32x4*)(sp + d * 16 + 4 * g) = (f32x4){O[d][4 * g], O[d][4 * g + 1], O[d][4 * g + 2], O[d][4 * g + 3]} * a4[g];
        } else {
            asm volatile("s_waitcnt vmcnt(0)" ::: "memory");
#pragma unroll
            for (int d = 0; d < 4; ++d)
#pragma unroll
                for (int g = 0; g < 4; ++g) { const f32x4 o0 = *(const GAS f32x4*)(sp + d * 16 + 4 * g);
#pragma unroll
                    for (int j = 0; j < 4; ++j) O[d][4 * g + j] = o0[j] - lam * (O[d][4 * g + j] * a4[g][j]); }
        }
    }
    const float* sg = F.ka->in[8]; bf16* MIX = (bf16*)(F.ws + WS_XN);
    float gcol[4];
#pragma unroll
    for (int d = 0; d < 4; ++d) gcol[d] = sg[d * 32 + r] * 0.8f;
    unsigned char* obase = F.ws + WS_XN8 + ((size_t)b * SEQ + q0 + 4 * hh) * D + h * 128 + r; asm volatile("" : "+v"(obase));
#pragma unroll
    for (int i = 0; i < 16; ++i) {
        float p = (O[0][i] * O[0][i] + O[1][i] * O[1][i]) + (O[2][i] * O[2][i] + O[3][i] * O[3][i]);
        p += __shfl_xor(p, 1); p += __shfl_xor(p, 2); p += __shfl_xor(p, 4); p += __shfl_xor(p, 8); p += __shfl_xor(p, 16);
        const float rstd = __builtin_amdgcn_rsqf(p * (1.f / 128.f) + EPS);
        unsigned char* orow = obase + (size_t)((i & 3) + 8 * (i >> 2)) * D;
#pragma unroll
        for (int d = 0; d < 4; ++d) orow[d * 32] = (unsigned char)(int)rintf(__builtin_amdgcn_fmed3f(O[d][i] * rstd * gcol[d] * MIX_Q8, -127.f, 127.f));
    }
}
__device__ __forceinline__ int row16_max_i(int x) {
    x = max(x, DPPX(x, 0xB1)); x = max(x, DPPX(x, 0x4E)); x = max(x, DPPX(x, 0x141)); x = max(x, DPPX(x, 0x140)); return x; }
__device__ __forceinline__ float row16_sum_f(float x) {
    x += __int_as_float(DPPX(__float_as_int(x), 0xB1)); x += __int_as_float(DPPX(__float_as_int(x), 0x4E)); x += __int_as_float(DPPX(__float_as_int(x), 0x141)); x += __int_as_float(DPPX(__float_as_int(x), 0x140)); return x; }
__device__ __forceinline__ int f2sort(float f) { const int b = __float_as_int(f); return b ^ ((b >> 31) & 0x7fffffff); }
__device__ __forceinline__ float sort2f(int k) { return __int_as_float(k ^ ((k >> 31) & 0x7fffffff)); }
__device__ __forceinline__ void topk_phase(Frame& F) {
    const int tid = F.tid, lane = F.lane, w = F.wave, r = lane & 31, hh = lane >> 5, g16 = tid >> 4, l16 = tid & 15;
    LAS float* Sl = (LAS float*)F.lds;
    LAS float* SV = (LAS float*)(F.lds + 65536);
    LAS int* SI = (LAS int*)(F.lds + 65536 + 8192);
    const bf16* QP = (const bf16*)(F.ws + WS_WIN); const bf16* SUBK = (const bf16*)(F.ws + WS_SUBK);
    int* EIDX = (int*)(F.ws + WS_EIDX); float* GATE = (float*)(F.ws + WS_GATE);
#define TK_GLD(dst, ptr, off) asm volatile("global_load_dwordx4 %0, %1, off offset:" #off : "=v"(dst) : "v"(ptr) : "memory")
#define TK_LOADS(itx) do { const int head_ = (itx) & 7, tile_ = (itx) >> 3; \
        const bf16* Q_ = QP + (size_t)(tile_ * 64 + r) * 2048 + head_ * 256 + (w >> 2) * 128 + 8 * hh; const bf16* Q1_ = Q_ + (size_t)32 * 2048; \
        const bf16* SK_ = SUBK + ((size_t)(head_ * 2 + (w >> 2)) * 128 + 32 * (w & 3) + r) * 128 + 8 * hh; \
        TK_GLD(kf[0], SK_, 0); TK_GLD(q0[0], Q_, 0); TK_GLD(q1[0], Q1_, 0); TK_GLD(kf[1], SK_, 32); TK_GLD(q0[1], Q_, 32); TK_GLD(q1[1], Q1_, 32); \
        TK_GLD(kf[2], SK_, 64); TK_GLD(q0[2], Q_, 64); TK_GLD(q1[2], Q1_, 64); TK_GLD(kf[3], SK_, 96); TK_GLD(q0[3], Q_, 96); TK_GLD(q1[3], Q1_, 96); \
        TK_GLD(kf[4], SK_, 128); TK_GLD(q0[4], Q_, 128); TK_GLD(q1[4], Q1_, 128); TK_GLD(kf[5], SK_, 160); TK_GLD(q0[5], Q_, 160); TK_GLD(q1[5], Q1_, 160); \
        TK_GLD(kf[6], SK_, 192); TK_GLD(q0[6], Q_, 192); TK_GLD(q1[6], Q1_, 192); TK_GLD(kf[7], SK_, 224); TK_GLD(q0[7], Q_, 224); TK_GLD(q1[7], Q1_, 224); } while (0)
    bf16x8 kf[8], q0[8], q1[8];
    if (F.vcu < (M / 64) * PEER_H) TK_LOADS(F.vcu);
    for (int it = F.vcu; it < (M / 64) * PEER_H; it += F.G) {
        const int head = it & 7, tile = it >> 3;
        {
            const int c = w >> 2, kb = w & 3;
            f32x16 acc[2];
#pragma unroll
            for (int i = 0; i < 16; ++i) { acc[0][i] = 0.f; acc[1][i] = 0.f; }
            asm volatile("s_waitcnt vmcnt(0)" ::: "memory");
#pragma unroll
            for (int s = 0; s < 8; ++s) asm volatile("" : "+v"(kf[s]), "+v"(q0[s]), "+v"(q1[s]));
#pragma unroll
            for (int s = 0; s < 8; ++s) { acc[0] = MFMA32(q0[s], kf[s], acc[0]); acc[1] = MFMA32(q1[s], kf[s], acc[1]); }
            HBAR();
#pragma unroll
            for (int tb = 0; tb < 2; ++tb)
#pragma unroll
                for (int i = 0; i < 16; ++i) Sl[(32 * tb + crow(i, hh)) * 256 + c * 128 + 32 * kb + r] = acc[tb][i];
            if (it + F.G < (M / 64) * PEER_H) TK_LOADS(it + F.G);
        }
        HBAR();
#pragma unroll 1
        for (int rd = 0; rd < 4; ++rd) {
            const int row = rd * 32 + g16, tok = row >> 1, c = row & 1;
            int key[8];
#pragma unroll
            for (int s = 0; s < 8; ++s) { const int idx = s * 16 + l16; key[s] = (f2sort(Sl[tok * 256 + c * 128 + idx]) & ~127) | (127 - idx); }
#define TK_CE(i, j) do { const int hi_ = max(key[i], key[j]), lo_ = min(key[i], key[j]); key[i] = hi_; key[j] = lo_; } while (0)
            TK_CE(0, 1); TK_CE(2, 3); TK_CE(4, 5); TK_CE(6, 7); TK_CE(0, 2); TK_CE(1, 3); TK_CE(4, 6); TK_CE(5, 7); TK_CE(1, 2); TK_CE(5, 6); TK_CE(0, 4); TK_CE(3, 7);
            TK_CE(1, 5); TK_CE(2, 6); TK_CE(1, 4); TK_CE(3, 6); TK_CE(2, 4); TK_CE(3, 5); TK_CE(3, 4);
#undef TK_CE
            int mine = 0;
#pragma unroll 1
            for (int k = 0; k < 16; ++k) {
                const int m = row16_max_i(key[0]);
                if (l16 == k) mine = m;
                const bool pop = (key[0] == m);
#pragma unroll
                for (int s = 0; s < 7; ++s) key[s] = pop ? key[s + 1] : key[s];
                key[7] = pop ? (int)0x80000000 : key[7];
            }
            SV[(tok * 2 + c) * 16 + l16] = sort2f(mine & ~127); SI[(tok * 2 + c) * 16 + l16] = 127 - (mine & 127);
        }
        HBAR();
#pragma unroll 1
        for (int rd = 0; rd < 2; ++rd) {
            const int tok = rd * 32 + g16;
            const float sv0 = SV[(tok * 2) * 16 + l16];
            int ptr = 0;
            int key = (f2sort(sv0 + SV[(tok * 2 + 1) * 16]) & ~255) | (255 - (l16 * 16));
            int mine = 0;
#pragma unroll 1
            for (int k = 0; k < 16; ++k) {
                const int m = row16_max_i(key);
                if (l16 == k) mine = m;
                if (key == m) { ++ptr; key = (ptr < 16) ? ((f2sort(sv0 + SV[(tok * 2 + 1) * 16 + (ptr & 15)]) & ~255) | (255 - (l16 * 16 + ptr))) : (int)0x80000000; }
            }
            const int flat = 255 - (mine & 255), aw = flat >> 4, bw = flat & 15;
            const float best = sort2f(mine & ~255);
            const int e = SI[(tok * 2) * 16 + aw] * 128 + SI[(tok * 2 + 1) * 16 + bw];
            const float mx = sort2f(row16_max_i(mine) & ~255);
            const float ex = __expf(best - mx), sum = row16_sum_f(ex);
            const size_t o = (size_t)(tile * 64 + tok) * NSEL + head * 16 + l16;
            EIDX[o] = e; GATE[o] = ex / sum;
        }
    }
#undef TK_LOADS
#undef TK_GLD
    __syncthreads();
}
constexpr int PE_SH = 9, PE_NCH = NEXP >> PE_SH;
__device__ __forceinline__ int row16_sum_i(int x) { x += DPPX(x, 0xB1); x += DPPX(x, 0x4E); x += DPPX(x, 0x141); x += DPPX(x, 0x140); return x; }
__device__ __forceinline__ int wave_sum_i(int x) { x = row16_sum_i(x); return __builtin_amdgcn_readlane(x, 0) + __builtin_amdgcn_readlane(x, 16) + __builtin_amdgcn_readlane(x, 32) + __builtin_amdgcn_readlane(x, 48); }
__device__ __forceinline__ void peer_down_phase(Frame& F) {
    const int tid = F.tid, lane = F.lane, w = F.wave;
    LAS unsigned char* XQ = F.lds;
    LAS unsigned* LIST = (LAS unsigned*)(F.lds + 131072);
    LAS float* SX = (LAS float*)(F.lds + 131072 + 16384);
    LAS unsigned* CNT = (LAS unsigned*)(F.lds + 131072 + 16384 + 128);
    const float* gf = F.ka->in[17]; const float* SSQ2 = (const float*)(F.ws + WS_SSQ2); const unsigned char* DOWN = F.ws + WS_DOWN; const float* DSC = (const float*)(F.ws + WS_DSC);
    const int* EIDX = (const int*)(F.ws + WS_EIDX); const float* GATE = (const float*)(F.ws + WS_GATE); float* WSEL = (float*)(F.ws + WS_WSEL);
    for (int g = F.vcu; g < M / 32; g += F.G) {
        const int t0 = g * 32;
        __syncthreads();
        if (tid < 64) CNT[tid] = 0u;
#pragma unroll 1
        for (int k = 0; k < 4; ++k) {
            const int tl = w * 4 + k; const size_t t = (size_t)(t0 + tl);
            const float rstd = __builtin_amdgcn_rsqf(wave_sum(SSQ2[t * 64 + lane]) * (1.f / 4096.f) + EPS);
            const bf16* h2 = (const bf16*)(F.ws + WS_XN) + t * D;
            f32x4 x[16]; float am = 0.f;
#pragma unroll
            for (int i = 0; i < 4; ++i) { const int e0 = (i * 64 + lane) * 16; const v4u ha = *(const GAS v4u*)(h2 + e0), hb = *(const GAS v4u*)(h2 + e0 + 8);
                const f32x4 hv[4] = {(f32x4){bflo(ha.x), bfhi(ha.x), bflo(ha.y), bfhi(ha.y)}, (f32x4){bflo(ha.z), bfhi(ha.z), bflo(ha.w), bfhi(ha.w)}, (f32x4){bflo(hb.x), bfhi(hb.x), bflo(hb.y), bfhi(hb.y)}, (f32x4){bflo(hb.z), bfhi(hb.z), bflo(hb.w), bfhi(hb.w)}};
#pragma unroll
                for (int q = 0; q < 4; ++q) { const f32x4 v = hv[q] * *(const GAS f32x4*)(gf + e0 + 4 * q) * rstd; x[4 * i + q] = v;
                    am = fmaxf(am, fmaxf(fmaxf(fabsf(v.x), fabsf(v.y)), fmaxf(fabsf(v.z), fabsf(v.w)))); } }
#pragma unroll
            for (int o = 1; o < 64; o <<= 1) am = fmaxf(am, __shfl_xor(am, o));
            const float qs = (am > 0.f) ? 127.0f / am : 1.0f;
#pragma unroll
            for (int i = 0; i < 4; ++i) { v4u pk;
                pk.x = pack_i8x4(x[4 * i + 0].x * qs, x[4 * i + 0].y * qs, x[4 * i + 0].z * qs, x[4 * i + 0].w * qs); pk.y = pack_i8x4(x[4 * i + 1].x * qs, x[4 * i + 1].y * qs, x[4 * i + 1].z * qs, x[4 * i + 1].w * qs);
                pk.z = pack_i8x4(x[4 * i + 2].x * qs, x[4 * i + 2].y * qs, x[4 * i + 2].z * qs, x[4 * i + 2].w * qs); pk.w = pack_i8x4(x[4 * i + 3].x * qs, x[4 * i + 3].y * qs, x[4 * i + 3].z * qs, x[4 * i + 3].w * qs);
                *(LAS v4u*)(XQ + tl * 4096 + (i * 64 + lane) * 16) = pk; }
            if (lane == 0) SX[tl] = (am > 0.f) ? am * (1.0f / 127.0f) : 1.0f;
        }
        unsigned rec[8];
#pragma unroll
        for (int k = 0; k < 8; ++k) { const int r = tid + 512 * k, tl = r >> 7, j = r & 127; const unsigned e = (unsigned)EIDX[(size_t)(t0 + tl) * NSEL + j]; rec[k] = e | ((unsigned)tl << 14) | ((unsigned)j << 19); }
        __syncthreads();
#pragma unroll
        for (int k = 0; k < 8; ++k) (void)__hip_atomic_fetch_add((unsigned*)&CNT[(rec[k] & 16383u) >> PE_SH], 1u, __ATOMIC_RELAXED, __HIP_MEMORY_SCOPE_WORKGROUP);
        __syncthreads();
        if (tid == 0) { unsigned run = 0u; for (int c = 0; c < PE_NCH; ++c) { const unsigned n = CNT[c]; CNT[32 + c] = run; run += n; } }
        __syncthreads();
#pragma unroll
        for (int k = 0; k < 8; ++k) { const unsigned pos = __hip_atomic_fetch_add((unsigned*)&CNT[32 + ((rec[k] & 16383u) >> PE_SH)], 1u, __ATOMIC_RELAXED, __HIP_MEMORY_SCOPE_WORKGROUP); LIST[pos] = rec[k]; }
        __syncthreads();
#pragma unroll 1
        for (int p = w * 8; p < 4096; p += 64) {
            const unsigned myrec = LIST[p + (lane & 7)];
            const unsigned me = myrec & 16383u, mtl = (myrec >> 14) & 31u, mj = myrec >> 19;
            const size_t oidx = (size_t)(t0 + (int)mtl) * NSEL + mj;
            const float mg = GATE[oidx], md = DSC[me], ms = SX[mtl];
            v4u v[8][4];
#pragma unroll
            for (int k = 0; k < 8; ++k) { const unsigned e = (unsigned)__builtin_amdgcn_readlane((int)me, k); const unsigned char* rowp = DOWN + (size_t)e * D + lane * 16;
#pragma unroll
                for (int i = 0; i < 4; ++i) v[k][i] = *(const GAS v4u*)(rowp + i * 1024); }
            int res = 0;
#pragma unroll
            for (int k = 0; k < 8; ++k) { const unsigned tl = (unsigned)__builtin_amdgcn_readlane((int)mtl, k); const LAS unsigned char* xp = XQ + tl * 4096 + lane * 16; int a = 0;
#pragma unroll
                for (int i = 0; i < 4; ++i) { const v4u xv = *(const LAS v4u*)(xp + i * 1024);
                    a = __builtin_amdgcn_sdot4((int)v[k][i].x, (int)xv.x, a, false); a = __builtin_amdgcn_sdot4((int)v[k][i].y, (int)xv.y, a, false);
                    a = __builtin_amdgcn_sdot4((int)v[k][i].z, (int)xv.z, a, false); a = __builtin_amdgcn_sdot4((int)v[k][i].w, (int)xv.w, a, false); }
                const int tot = wave_sum_i(a);
                if (lane == k) res = tot; }
            if (lane < 8) { const float act = (float)res * ms * md; WSEL[oidx] = mg * 0.5f * act * (1.0f + erff(act * 0.70710678118654752f)); }
        }
    }
    __syncthreads();
}
__device__ __forceinline__ void peer_up_phase(Frame& F) {
    typedef float f32x2_ __attribute__((ext_vector_type(2)));
    const int tid = F.tid, lane = F.lane, w = F.wave;
    LAS float* ACC = (LAS float*)F.lds;
    LAS unsigned* LREC = (LAS unsigned*)(F.lds + 131072);
    LAS float* LW = (LAS float*)(F.lds + 131072 + 8192);
    LAS unsigned* CNT = (LAS unsigned*)(F.lds + 131072 + 16384);
    LAS unsigned* OFF = (LAS unsigned*)(F.lds + 131072 + 16384 + 1024);
    LAS unsigned* GS = (LAS unsigned*)(F.lds + 131072 + 16384 + 2048);
    LAS float* PR = (LAS float*)(F.lds + 131072 + 16384 + 2048 + 256);
    const unsigned char* UP = F.ws + WS_UP; const float* USC = (const float*)(F.ws + WS_USC); const int* EIDX = (const int*)(F.ws + WS_EIDX); const float* WSEL = (const float*)(F.ws + WS_WSEL); const float* fg = F.ka->in[22];
    LAS float* SSP = PR + 128;
    for (int g = F.vcu; g < M / 16; g += F.G) {
        const int t0 = g * 16;
        __syncthreads();
        if (tid < 256) CNT[tid] = 0u;
        unsigned rec[4]; float rw[4]; unsigned key[4];
#pragma unroll
        for (int k = 0; k < 4; ++k) { const int r = tid + 512 * k, tl = r >> 7, j = r & 127; const size_t o = (size_t)(t0 + tl) * NSEL + j; const unsigned e = (unsigned)EIDX[o];
            rec[k] = e | ((unsigned)tl << 14); key[k] = ((unsigned)(tl >> 1) << 5) | ((e >> 12) << 1) | (unsigned)(tl & 1); rw[k] = WSEL[o] * USC[e]; }
        __syncthreads();
#pragma unroll
        for (int k = 0; k < 4; ++k) (void)__hip_atomic_fetch_add((unsigned*)&CNT[key[k]], 1u, __ATOMIC_RELAXED, __HIP_MEMORY_SCOPE_WORKGROUP);
        __syncthreads();
        if (tid < 64) GS[tid] = (CNT[tid * 4] + CNT[tid * 4 + 1]) + (CNT[tid * 4 + 2] + CNT[tid * 4 + 3]);
        __syncthreads();
        if (tid == 0) { unsigned run = 0u; for (int c = 0; c < 64; ++c) { const unsigned n = GS[c]; GS[c] = run; run += n; } }
        __syncthreads();
        if (tid < 64) { unsigned run = GS[tid];
#pragma unroll
            for (int k = 0; k < 4; ++k) { OFF[tid * 4 + k] = run; run += CNT[tid * 4 + k]; } }
        __syncthreads();
#pragma unroll
        for (int k = 0; k < 4; ++k) { const unsigned pos = __hip_atomic_fetch_add((unsigned*)&OFF[key[k]], 1u, __ATOMIC_RELAXED, __HIP_MEMORY_SCOPE_WORKGROUP); LREC[pos] = rec[k]; LW[pos] = rw[k]; }
        __syncthreads();
        if (tid < 256 && CNT[tid] != 0u) LREC[OFF[tid] - 1u] |= 0x80000000u;
        typedef _Float16 h16x8 __attribute__((ext_vector_type(8)));
        LAS h16x8* ACH = (LAS h16x8*)F.lds;
        __syncthreads();
#pragma unroll
        for (int k = 0; k < 16; ++k) ACH[k * 512 + tid] = (h16x8){0, 0, 0, 0, 0, 0, 0, 0};
        __syncthreads();
        {
            const LAS unsigned* HR = LREC + 256 * w; const LAS float* HW = LW + 256 * w;
            const unsigned char* ub = UP + lane * 16;
            float ra[64];
#pragma unroll
            for (int e = 0; e < 64; ++e) ra[e] = 0.f;
            v4u vn[4][2];
#pragma unroll
            for (int q = 0; q < 4; ++q) { const unsigned char* rp = ub + (size_t)(HR[q] & 16383u) * 2048; vn[q][0] = *(const GAS v4u*)rp; vn[q][1] = *(const GAS v4u*)(rp + 1024); }
#pragma unroll 1
            for (int p = 0; p < 256; p += 4) {
                v4u v[4][2];
#pragma unroll
                for (int q = 0; q < 4; ++q) { v[q][0] = vn[q][0]; v[q][1] = vn[q][1]; }
                { const int pn = (p + 4 < 256) ? p + 4 : p;
#pragma unroll
                  for (int q = 0; q < 4; ++q) { const unsigned char* rp = ub + (size_t)(HR[pn + q] & 16383u) * 2048; vn[q][0] = *(const GAS v4u*)rp; vn[q][1] = *(const GAS v4u*)(rp + 1024); } }
#pragma unroll
                for (int q = 0; q < 4; ++q) {
                    const unsigned rc = (unsigned)__builtin_amdgcn_readfirstlane((int)HR[p + q]); const float wv = HW[p + q];
#pragma unroll
                    for (int k = 0; k < 2; ++k) { const unsigned vw[4] = {v[q][k].x, v[q][k].y, v[q][k].z, v[q][k].w};
#pragma unroll
                        for (int d = 0; d < 4; ++d) { const int b = 32 * k + 8 * d;
                            const f32x2_ c0 = __builtin_amdgcn_cvt_scalef32_pk_f32_fp4(vw[d], 1.0f, 0), c1 = __builtin_amdgcn_cvt_scalef32_pk_f32_fp4(vw[d], 1.0f, 1), c2 = __builtin_amdgcn_cvt_scalef32_pk_f32_fp4(vw[d], 1.0f, 2), c3 = __builtin_amdgcn_cvt_scalef32_pk_f32_fp4(vw[d], 1.0f, 3);
                            ra[b + 0] = fmaf(wv, c0.x, ra[b + 0]); ra[b + 1] = fmaf(wv, c0.y, ra[b + 1]); ra[b + 2] = fmaf(wv, c1.x, ra[b + 2]); ra[b + 3] = fmaf(wv, c1.y, ra[b + 3]);
                            ra[b + 4] = fmaf(wv, c2.x, ra[b + 4]); ra[b + 5] = fmaf(wv, c2.y, ra[b + 5]); ra[b + 6] = fmaf(wv, c3.x, ra[b + 6]); ra[b + 7] = fmaf(wv, c3.y, ra[b + 7]); } }
                    if (rc & 0x80000000u) { asm volatile("; run end: flush" ::: "memory");
                        LAS h16x8* ap = ACH + ((rc >> 14) & 15u) * 512 + lane;
#pragma unroll
                        for (int c = 0; c < 8; ++c) { h16x8 t = ap[64 * c];
#pragma unroll
                            for (int e = 0; e < 8; ++e) { t[e] = (_Float16)((float)t[e] + ra[8 * c + e]); ra[8 * c + e] = 0.f; }
                            ap[64 * c] = t; } }
                }
            }
        }
        __syncthreads();
        {
            int tq = tid; asm volatile("" : "+v"(tq));
            const int col0 = 8 * tq;
            const f32x4 g0 = *(const GAS f32x4*)(fg + col0), g1 = *(const GAS f32x4*)(fg + col0 + 4);
#pragma unroll 1
            for (int kk = 0; kk < 2; ++kk) {
                f32x4 y0[8], y1[8];
                __syncthreads();
#pragma unroll
                for (int k = 0; k < 8; ++k) { const int tk = 8 * kk + k; const v4u hb = *(const GAS v4u*)((const bf16*)(F.ws + WS_XN) + (size_t)(t0 + tk) * D + col0);
                    const h16x8 a8 = ACH[tk * 512 + tq];
                    y0[k] = (f32x4){bflo(hb.x), bfhi(hb.x), bflo(hb.y), bfhi(hb.y)} + (f32x4){(float)a8[0], (float)a8[1], (float)a8[2], (float)a8[3]};
                    y1[k] = (f32x4){bflo(hb.z), bfhi(hb.z), bflo(hb.w), bfhi(hb.w)} + (f32x4){(float)a8[4], (float)a8[5], (float)a8[6], (float)a8[7]};
                    float ss = ((y0[k].x * y0[k].x + y0[k].y * y0[k].y) + (y0[k].z * y0[k].z + y0[k].w * y0[k].w)) + ((y1[k].x * y1[k].x + y1[k].y * y1[k].y) + (y1[k].z * y1[k].z + y1[k].w * y1[k].w));
                    ss = wave_sum(ss);
                    if (lane == 0) PR[k * 8 + w] = ss; }
                __syncthreads();
#pragma unroll
                for (int k = 0; k < 8; ++k) { const f32x4 p0 = *(const LAS f32x4*)(PR + k * 8), p1 = *(const LAS f32x4*)(PR + k * 8 + 4);
                    const float tot = ((p0.x + p0.y) + (p0.z + p0.w)) + ((p1.x + p1.y) + (p1.z + p1.w));
                    const float rstd = __builtin_amdgcn_rsqf(tot * (1.f / 4096.f) + EPS);
                    float* orow = F.out + (size_t)(t0 + 8 * kk + k) * D + col0;
                    *(GAS f32x4*)orow = y0[k] * rstd * g0; *(GAS f32x4*)(orow + 4) = y1[k] * rstd * g1; }
            }
        }
    }
    __syncthreads();
}
constexpr int N_PHASES = 12;
__global__ void __launch_bounds__(NTHR, 2) hybrid_fwd(Args args) {
    extern __shared__ __attribute__((aligned(16))) unsigned char lds[];
    Frame F;
    F.lds = (LAS unsigned char*)lds;
    F.MISC = (volatile LAS unsigned*)(F.lds + MISC_OFF);
    F.tid = threadIdx.x; F.lane = F.tid & 63; F.wave = __builtin_amdgcn_readfirstlane(F.tid >> 6);
    F.G = gridDim.x; { const int bx = blockIdx.x; F.vcu = (F.G % 8 == 0) ? (bx % 8) * (F.G / 8) + bx / 8 : bx; }
    F.ws = args.ws; F.ctl = (gu32*)(args.ws + WS_CTL); F.out = args.out;
    F.ka = (const Args*)__builtin_amdgcn_kernarg_segment_ptr();
    for (int u = F.tid; u < (LDS_BYTES - LDSCTL_OFF) / 4; u += NTHR) ((LAS unsigned*)(F.lds + LDSCTL_OFF))[u] = 0u;
    __syncthreads();
    XcdBarrier bar; bar.bar = (unsigned*)(F.ctl + CW_BAR); bar.x = 0; bar.st = nullptr;
    if (args.use_bar) bar = xcd_barrier_post((unsigned*)(F.ctl + CW_BAR), F.MISC + 8);
    const int lo = args.ph_lo, hi = args.ph_hi;
#ifndef PH_MASK
#define PH_MASK 0xfff
#endif
#define IN(k) ((((PH_MASK) >> (k)) & 1) && lo <= (k) && (k) < hi)
#define SEAM(k) do { if (IN(k) && IN((k) + 1)) xcd_barrier(bar); } while (0)
    unsigned char* ws = args.ws;
    bf16* XN = (bf16*)(ws + WS_XN);


    if (IN(1)) { p0_prologue(F); } SEAM(1);

    if (IN(2)) {
        {
            constexpr unsigned segs8 = []{ unsigned m = 0; int n = 0; for (int sgi = 0; sgi < 7; ++sgi) if ((FP8_SEGS >> sgi) & 1) { m |= (unsigned)sgi << (3 * n); ++n; } return m; }();
            constexpr unsigned segs16 = []{ unsigned m = 0; int n = 0; for (int sgi = 0; sgi < 7; ++sgi) if (!((FP8_SEGS >> sgi) & 1)) { m |= (unsigned)sgi << (3 * n); ++n; } return m; }();
            constexpr int n8 = __builtin_popcount(FP8_SEGS & 0x7f), n16 = 7 - n8;
            if (n8 > 0) { pg8::Gemm g{(const bf16*)(ws + WS_XN8), (const bf16*)(ws + WS_WIN8), D / 2, D / 2, D / 2, 0, 0, 0, 0}; pg8::SegOrder S; S.init(M, n8, segs8, F.G, (int)blockIdx.x);
                pg8::EpiInproj E{(bf16*)(ws + WS_PROJ), NIN, F.ka->in[9], (const float*)(ws + WS_SA), 1.0f / WIN_QS};
                pg8::gemm_phase<pg8::EpiInproj, pg8::SegOrder, true, true, true>(F.lds, g, S, E); }
            if (n16 > 0) { pg8::Gemm g{XN, (const bf16*)(ws + WS_WIN), D, D, D, 0, 0, 0, 0}; pg8::SegOrder S; S.init(M, n16, segs16, F.G, (int)blockIdx.x);
                pg8::EpiInproj E{(bf16*)(ws + WS_PROJ), NIN, F.ka->in[9], nullptr, 1.0f};
                pg8::gemm_phase<pg8::EpiInproj, pg8::SegOrder, true, true, false>(F.lds, g, S, E); }
        }
    } SEAM(2);

    if (IN(3)) {
        const int s3 = F.vcu & 3;
        { const int kvc = (s3 == 1 || s3 == 2) ? (F.vcu >> 2) * 2 + (s3 - 1) : 128 + F.vcu;
          pg8::Gemm g{(const bf16*)(ws + WS_MEMN), (const bf16*)(ws + WS_WCKV), D / 2, D / 2, D / 2, 0, 0, 0, 0}; pg8::StaticOrder S; S.init(MROWS, 2 * D, F.G, kvc, 1 << 20);
          pg8::EpiBf16Z E{nullptr, 2 * D, 0, 0, ws + WS_KV, KV_Q8, 1.0f / (KV_Q8 * WIN_QS)};
          pg8::gemm_phase<pg8::EpiBf16Z, pg8::StaticOrder, true, true, true>(F.lds, g, S, E); }
#ifndef NO_HGRN
        if (s3 == 0) for (int u = F.vcu >> 2; u < 64; u += F.G / 4) hgrn_head_mfma(F, u >> 4, u & 15);
#endif
#ifndef NO_ATTN
        float lam;
        { int ln_ = F.lane; asm volatile("" : "+v"(ln_)); const float a = wave_sum(F.ka->in[4][ln_] * F.ka->in[5][ln_]), c = wave_sum(F.ka->in[6][ln_] * F.ka->in[7][ln_]); lam = __expf(a) - __expf(c) + 0.2f; }
        for (int u = F.vcu; u < 256; u += F.G) {
            const int bh = u >> 2, s = u & 3;
            const unsigned qlist = (s == 0) ? 0x013u : (s == 1) ? 0x48CDu : (s == 2) ? 0x267ABu : 0x59EFu; const int nq = (s == 0) ? 3 : (s == 2) ? 5 : 4;
#pragma unroll 1
            for (int k = 0; k < nq; ++k) { const int qb = (int)((qlist >> (4 * k)) & 15u); attn_unit(F, bh >> 4, bh & 15, qb, lam); }
        }
#endif
    } SEAM(3);

    if (IN(4)) {
        for (int r = (int)blockIdx.x * NTHR + F.tid; r < M; r += F.G * NTHR) ((float*)(ws + WS_SA))[r] = 1.0f / MIX_Q8;
        { pg8::Gemm g{(const bf16*)(ws + WS_KV), (const bf16*)(ws + WS_WCQ), 512, D, D / 2, (size_t)MEML * D, 512, 0, 512}; pg8::BatchOrder S; S.init(4, 4, 1, 16, F.G, (int)blockIdx.x);
          pg8::EpiBf16Z E{(bf16*)(ws + WS_WKP), D, (size_t)1024 * D, (size_t)256 * D, nullptr, 0.f, 1.0f / (KV_Q8 * WIN_QS)};
          pg8::gemm_phase<pg8::EpiBf16Z, pg8::BatchOrder, true, true, true>(F.lds, g, S, E); }
        { pg8::Gemm g{(const bf16*)(ws + WS_WCO), (const bf16*)(ws + WS_KV + D), 512, D / 2, D, 0, 512, (size_t)MEML * D, 512}; pg8::BatchOrder S; S.init(4, 4, 16, 1, F.G, (int)blockIdx.x);
          pg8::EpiBf16Z E{(bf16*)(ws + WS_VP), 1024, (size_t)D * 1024, 256, nullptr, 0.f, 1.0f / (KV_Q8 * WIN_QS)};
          pg8::gemm_phase<pg8::EpiBf16Z, pg8::BatchOrder, true, true, true>(F.lds, g, S, E); }
    } SEAM(4);

    if (IN(5)) {
        pg8::Gemm g{(const bf16*)(ws + WS_XN8), (const bf16*)(ws + WS_WOUT), D / 2, D / 2, D / 2, 0, 0, 0, 0}; pg8::StaticOrder S; S.init(M, D, F.G, (int)blockIdx.x, 1 << 20);
        pg8::EpiResid<false> E{F.ka->in[0], (bf16*)(ws + WS_H1B), (float*)(ws + WS_SSQ1), (const float*)(ws + WS_SA), 1.0f / WIN_QS};
        pg8::gemm_phase<pg8::EpiResid<false>, pg8::StaticOrder, true, true, true>(F.lds, g, S, E);
    } SEAM(5);

    if (IN(6)) {
        pg8::Gemm g{(const bf16*)(ws + WS_H1B), (const bf16*)(ws + WS_WKP), D, D, D, 0, 0, (size_t)1024 * D, 0}; pg8::StaticOrder S; S.init(M, 1024, F.G, (int)blockIdx.x, 16);
        pg8::EpiSoftmax E{(bf16*)(ws + WS_PB), 1024, (const float*)(ws + WS_SSQ1), 0.03125f * LOG2E};
        pg8::gemm_phase<pg8::EpiSoftmax, pg8::StaticOrder, false, true>(F.lds, g, S, E);
    } SEAM(6);

    if (IN(7)) {
        pg8::Gemm g{(const bf16*)(ws + WS_PB), (const bf16*)(ws + WS_VP), 1024, 1024, 1024, 0, 0, (size_t)D * 1024, 0}; pg8::StaticOrder S; S.init(M, D, F.G, (int)blockIdx.x, 16);
        pg8::EpiResid<true> E{(const bf16*)(ws + WS_H1B), XN, (float*)(ws + WS_SSQ2), nullptr, 1.0f, ws + WS_XN8, (const float*)(ws + WS_SSQ1)};
        pg8::gemm_phase<pg8::EpiResid<true>, pg8::StaticOrder, true, true>(F.lds, g, S, E);
    } SEAM(7);

    if (IN(8)) {
        pg8::Gemm g{(const bf16*)(ws + WS_XN8), (const bf16*)(ws + WS_WPQ), D / 2, D / 2, D / 2, 0, 0, 0, 0}; pg8::StaticOrder S; S.init(M, 2048, F.G, (int)blockIdx.x, 1 << 20);
        pg8::EpiRowScale E{(bf16*)(ws + WS_WIN), 2048, (const float*)(ws + WS_SSQ2), (const float*)(ws + WS_SSQ1), 1.0f / WIN_QS};
        pg8::gemm_phase<pg8::EpiRowScale, pg8::StaticOrder, true, true, true>(F.lds, g, S, E);
    } SEAM(8);

    if (IN(9)) { topk_phase(F); } SEAM(9);
    if (IN(10)) { peer_down_phase(F); } SEAM(10);
    if (IN(11)) { peer_up_phase(F); }
#undef IN
#undef SEAM
}

#ifndef MK_SPLIT
#define MK_SPLIT 0
#endif
#ifndef PROBE_REP_MASK
#define PROBE_REP_MASK 0x0
#endif
#ifndef MK_LAST_PHASE
#define MK_LAST_PHASE N_PHASES
#endif
extern "C" void kernel_launch(void* const* d_in, const int* in_sizes, int n_in, void* d_out, int out_size, void* d_ws, size_t ws_size, hipStream_t stream) {
    static int grid = 0;
    if (grid == 0) {
        if (n_in != 23 || out_size != M * D || ws_size < WS_END2) { fprintf(stderr, "kernel_launch: unexpected shapes (n_in %d out %d ws %zu)\n", n_in, out_size, ws_size); grid = -1; return; }
        int dev = 0, cus = 0, per_cu = 0;
        if (hipGetDevice(&dev) != hipSuccess || hipDeviceGetAttribute(&cus, hipDeviceAttributeMultiprocessorCount, dev) != hipSuccess) { grid = -1; return; }
        if (hipFuncSetAttribute((const void*)hybrid_fwd, hipFuncAttributeMaxDynamicSharedMemorySize, LDS_BYTES) != hipSuccess) { fprintf(stderr, "kernel_launch: hipFuncSetAttribute failed\n"); grid = -1; return; }
        if (hipOccupancyMaxActiveBlocksPerMultiprocessor(&per_cu, (const void*)hybrid_fwd, NTHR, LDS_BYTES) != hipSuccess || per_cu < 1) fprintf(stderr, "kernel_launch: occupancy query reports %d\n", per_cu);
        (void)hipGetLastError();
        grid = cus;
        if (grid != 256) { fprintf(stderr, "kernel_launch: built for 256 CUs, device has %d\n", cus); grid = -1; return; }
    }
    if (grid < 0) return;
    (void)hipMemsetAsync((char*)d_ws + WS_CTL, 0, CTL_ZERO_BYTES, stream);
    Args a{};
    for (int i = 0; i < 23; ++i) a.in[i] = (const float*)d_in[i];
    a.out = (float*)d_out; a.ws = (unsigned char*)d_ws; a.pad = 0;
#if MK_SPLIT
    for (int p = 0; p < MK_LAST_PHASE; ++p) { a.ph_lo = p; a.ph_hi = p + 1; a.use_bar = 0;
        for (int rep = 0; rep < 1 + ((PROBE_REP_MASK >> p) & 1); ++rep) hipLaunchKernelGGL(hybrid_fwd, dim3(grid), dim3(NTHR), LDS_BYTES, stream, a); }
#else
    a.ph_lo = 0; a.ph_hi = MK_LAST_PHASE; a.use_bar = 1;
    hipLaunchKernelGGL(hybrid_fwd, dim3(grid), dim3(NTHR), LDS_BYTES, stream, a);
#endif
}
```

```cpp
#include <hip/hip_runtime.h>
#include <cstdio>
#include <cstdint>

#ifndef Q8_INT
#define Q8_INT 1
#endif
constexpr bool Q8_INT_ = (Q8_INT != 0);
namespace pg8 {
#define PG8_LAS __attribute__((address_space(3)))
typedef unsigned short bf16_t;
typedef short bf16x8 __attribute__((ext_vector_type(8)));
typedef float f32x4 __attribute__((ext_vector_type(4)));
typedef unsigned u32x4 __attribute__((ext_vector_type(4)));
constexpr int BM = 256, BK = 64, HALF = 128, HTB = HALF * BK * 2  , STAGE_BYTES = 8 * HTB, NXCD = 8, WGM = 8;

__host__ __device__ __forceinline__ int lds_byte(int r, int c) { const int st = (r >> 4) * 2 + (c >> 5), rr = r & 15, cc = c & 31, ob = rr * 64 + cc * 2; return st * 1024 + (ob ^ (((ob >> 9) & 1) << 5)); }
__host__ __device__ __forceinline__ void stage_rc(int b, int& R, int& C) { const int st = b / 1024, sb = b % 1024, swz = sb ^ (((sb >> 9) & 1) << 5); R = (st >> 1) * 16 + swz / 64; C = (st & 1) * 32 + (swz % 64) / 2; }
__host__ __device__ __forceinline__ int perm32(int rho) { const int n = rho >> 4, i = rho & 15; return 8 * (i >> 2) + 4 * n + (i & 3); }

struct Unit { int pm, pn, zb, zh; };
struct Gemm {
    const bf16_t* A; const bf16_t* Bt; int K, lda, ldb; size_t a_zb, a_zh, b_zb, b_zh;
    __device__ __forceinline__ const char* a_ptr(const Unit& u) const { return (const char*)(A + (size_t)u.zb * a_zb + (size_t)u.zh * a_zh + (size_t)u.pm * BM * lda); }
    __device__ __forceinline__ const char* b_ptr(const Unit& u) const { return (const char*)(Bt + (size_t)u.zb * b_zb + (size_t)u.zh * b_zh + (size_t)u.pn * BM * ldb); }
};

struct StaticOrder {
    int nM, nN, nwg, G, c, zdiv;
    __host__ __device__ void init(int M, int N, int G_, int c_, int zdiv_) { nM = M / BM; nN = N / BM; nwg = nM * nN; G = G_; c = c_; zdiv = zdiv_; }
    __host__ __device__ bool next(int i, Unit& u) const {
        const long L = (long)i * G + c; if (L >= nwg) return false;
        int wgid = (int)L; { const int q = nwg / NXCD, r = nwg % NXCD, xcd = wgid % NXCD, off = wgid / NXCD; wgid = (xcd < r ? xcd * (q + 1) : r * (q + 1) + (xcd - r) * q) + off; }
        const int nig = WGM * nN, gid = wgid / nig, fm = gid * WGM, gsz = (nM - fm) < WGM ? (nM - fm) : WGM;
        u.pm = fm + ((wgid % nig) % gsz); u.pn = (wgid % nig) / gsz; u.zb = u.pm / zdiv; u.zh = 0; return true;
    }
    __device__ __forceinline__ void a_ready(const Unit&) const {}
    __device__ __forceinline__ void done(const Unit&) const {}
};
struct SegOrder {
    StaticOrder so; unsigned segs;
    __host__ __device__ void init(int M, int nseg, unsigned segs_, int G_, int c_) { so.init(M, nseg * 2048, G_, c_, 1 << 20); segs = segs_; }
    __host__ __device__ bool next(int i, Unit& u) const { if (!so.next(i, u)) return false; u.pn = (int)((segs >> (3 * (u.pn >> 3))) & 7u) * 8 + (u.pn & 7); return true; }
    __device__ __forceinline__ void a_ready(const Unit&) const {}
    __device__ __forceinline__ void done(const Unit&) const {}
};
struct BatchOrder {
    int nM, nN, nzh, ntot, G, c;
    __host__ __device__ void init(int nzb_, int nzh_, int nM_, int nN_, int G_, int c_) { nM = nM_; nN = nN_; nzh = nzh_; ntot = nzb_ * nzh_ * nM_ * nN_; G = G_; c = c_; }
    __host__ __device__ bool next(int i, Unit& u) const {
        const long L = (long)i * G + c; if (L >= ntot) return false;
        const int l = (int)L, per = nM * nN, z = l / per, r = l % per; u.zb = z / nzh; u.zh = z % nzh; u.pm = r / nN; u.pn = r % nN; return true;
    }
    __device__ __forceinline__ void a_ready(const Unit&) const {}
    __device__ __forceinline__ void done(const Unit&) const {}
};

__device__ __forceinline__ unsigned cvt_pk_bf16(float lo, float hi) { typedef float f2 __attribute__((ext_vector_type(2))); typedef __bf16 b2 __attribute__((ext_vector_type(2))); f2 v = {lo, hi}; b2 b = __builtin_convertvector(v, b2); return __builtin_bit_cast(unsigned, b); }
__device__ __forceinline__ u32x4 pack8(const f32x4& v0, const f32x4& v1) { u32x4 w; w.x = cvt_pk_bf16(v0[0], v0[1]); w.y = cvt_pk_bf16(v0[2], v0[3]); w.z = cvt_pk_bf16(v1[0], v1[1]); w.w = cvt_pk_bf16(v1[2], v1[3]); return w; }
__device__ __forceinline__ float sigm(float t) { return __builtin_amdgcn_rcpf(1.0f + __expf(-t)); }

constexpr float QK_SCALE_LOG2E = 0.125f * 1.4426950408889634f;
struct EpiInproj {
    static constexpr bool PERM = true, AFTER_DRAIN = false;
    bf16_t* O; int ldc; const float* gamma; const float* sa; float sbw;
    __device__ __forceinline__ void operator()(const f32x4 (&acc)[2][2][4][2], const Unit& u, int wr, int wc, int fr, int fq) const {
        asm volatile("" : "+v"(fr), "+v"(fq));
        const int seg = u.pn >> 3; const int row0 = u.pm * BM + wr * 64 + fr, col0 = u.pn * BM + wc * 32 + 8 * fq;
#pragma unroll
        for (int bj = 0; bj < 2; ++bj) {
            const int col = col0 + bj * HALF;
            f32x4 om0 = {1.f, 1.f, 1.f, 1.f}, om1 = om0;
            if (seg == 4) { const int c = col - 8192; const f32x4 g00 = *(const f32x4*)(gamma + c), g01 = *(const f32x4*)(gamma + c + 4), g10 = *(const f32x4*)(gamma + 2048 + c), g11 = *(const f32x4*)(gamma + 2048 + c + 4);
#pragma unroll
                for (int e = 0; e < 4; ++e) { om0[e] = sigm(g10[e] - g00[e]); om1[e] = sigm(g11[e] - g01[e]); } }
#pragma unroll
            for (int ai = 0; ai < 2; ++ai)
#pragma unroll
                for (int m = 0; m < 4; ++m) {
                    const float rs_ = sa ? sa[row0 + ai * HALF + m * 16] * sbw : 1.0f;
                    f32x4 v0 = acc[ai][bj][m][0], v1 = acc[ai][bj][m][1];
                    if (Q8_INT_ && sa) {
#pragma unroll
                        for (int e = 0; e < 4; ++e) { v0[e] = (float)__float_as_int(v0[e]); v1[e] = (float)__float_as_int(v1[e]); } }
                    v0 = v0 * rs_; v1 = v1 * rs_;
                    if (seg == 3 || seg == 6) {
#pragma unroll
                        for (int e = 0; e < 4; ++e) { v0[e] = v0[e] * sigm(v0[e]); v1[e] = v1[e] * sigm(v1[e]); }
                    } else if (seg == 4) {
#pragma unroll
                        for (int e = 0; e < 4; ++e) { v0[e] = om0[e] * sigm(-v0[e]); v1[e] = om1[e] * sigm(-v1[e]); }
                    } else if (seg == 0) { v0 = v0 * QK_SCALE_LOG2E; v1 = v1 * QK_SCALE_LOG2E; }
                    *(u32x4*)(O + (size_t)(row0 + ai * HALF + m * 16) * ldc + col) = pack8(v0, v1);
                }
        }
    }
};
__device__ __forceinline__ float row_rstd(const float* ssq, int row, int fq);
constexpr float H2Q_CLIP = 6.5f;
__device__ __forceinline__ unsigned pk_i8x4(f32x4 v, float q) {
    const int a = (int)rintf(__builtin_amdgcn_fmed3f(v[0] * q, -127.f, 127.f)), b = (int)rintf(__builtin_amdgcn_fmed3f(v[1] * q, -127.f, 127.f)), c = (int)rintf(__builtin_amdgcn_fmed3f(v[2] * q, -127.f, 127.f)), d = (int)rintf(__builtin_amdgcn_fmed3f(v[3] * q, -127.f, 127.f));
    return ((unsigned)a & 255u) | (((unsigned)b & 255u) << 8) | (((unsigned)c & 255u) << 16) | ((unsigned)d << 24); }
struct EpiBf16Z {
    static constexpr bool PERM = true, AFTER_DRAIN = false;
    bf16_t* O; int ldc; size_t c_zb, c_zh; unsigned char* O8 = nullptr; float q8 = 0.f; float deq = 0.f;
    __device__ __forceinline__ void operator()(const f32x4 (&acc)[2][2][4][2], const Unit& u, int wr, int wc, int fr, int fq) const {
        asm volatile("" : "+v"(fr), "+v"(fq));
        bf16_t* base = O + (size_t)u.zb * c_zb + (size_t)u.zh * c_zh; unsigned char* base8 = O8 + (size_t)u.zb * c_zb + (size_t)u.zh * c_zh; const int row0 = u.pm * BM + wr * 64 + fr, col0 = u.pn * BM + wc * 32 + 8 * fq;
#pragma unroll
        for (int ai = 0; ai < 2; ++ai)
#pragma unroll
            for (int m = 0; m < 4; ++m)
#pragma unroll
                for (int bj = 0; bj < 2; ++bj) { const size_t off = (size_t)(row0 + ai * HALF + m * 16) * ldc + col0 + bj * HALF;
                    f32x4 a0 = acc[ai][bj][m][0], a1 = acc[ai][bj][m][1];
                    if (Q8_INT_ && deq != 0.f) {
#pragma unroll
                        for (int e = 0; e < 4; ++e) { a0[e] = (float)__float_as_int(a0[e]) * deq; a1[e] = (float)__float_as_int(a1[e]) * deq; } }
                    if (O8) { typedef unsigned u32x2z __attribute__((ext_vector_type(2))); u32x2z o8_; o8_.x = pk_i8x4(a0, q8); o8_.y = pk_i8x4(a1, q8); *(u32x2z*)(base8 + off) = o8_; }
                    else *(u32x4*)(base + off) = pack8(a0, a1); }
    }
};
template <bool RESID_BF16> struct EpiResid {
    static constexpr bool PERM = true, AFTER_DRAIN = false;
    const void* resid; bf16_t* outb; float* ssq; const float* sa = nullptr; float sbw = 1.0f; unsigned char* out8 = nullptr; const float* ssq_q = nullptr;
    __device__ __forceinline__ void operator()(const f32x4 (&acc)[2][2][4][2], const Unit& u, int wr, int wc, int fr, int fq) const {
        asm volatile("" : "+v"(fr), "+v"(fq));
        const int row0 = u.pm * BM + wr * 64 + fr, col0 = u.pn * BM + wc * 32 + 8 * fq;
#pragma unroll
        for (int ai = 0; ai < 2; ++ai)
#pragma unroll
            for (int m = 0; m < 4; ++m) { const int row = row0 + ai * HALF + m * 16; float s = 0.f; const float rs_ = sa ? sa[row] * sbw : 1.0f; const float q8_ = out8 ? (127.0f / H2Q_CLIP) * row_rstd(ssq_q, row, fq) : 0.f;
#pragma unroll
                for (int bj = 0; bj < 2; ++bj) { const size_t off = (size_t)row * 4096 + col0 + bj * HALF;
                    f32x4 r0, r1;
                    if constexpr (RESID_BF16) { const u32x4 rb = *(const u32x4*)((const bf16_t*)resid + off);
                        r0 = (f32x4){__uint_as_float(rb.x << 16), __uint_as_float(rb.x & 0xffff0000u), __uint_as_float(rb.y << 16), __uint_as_float(rb.y & 0xffff0000u)};
                        r1 = (f32x4){__uint_as_float(rb.z << 16), __uint_as_float(rb.z & 0xffff0000u), __uint_as_float(rb.w << 16), __uint_as_float(rb.w & 0xffff0000u)}; }
                    else { r0 = *(const f32x4*)((const float*)resid + off); r1 = *(const f32x4*)((const float*)resid + off + 4); }
                    f32x4 a0 = acc[ai][bj][m][0], a1 = acc[ai][bj][m][1];
                    if (Q8_INT_ && sa) {
#pragma unroll
                        for (int e = 0; e < 4; ++e) { a0[e] = (float)__float_as_int(a0[e]) * rs_; a1[e] = (float)__float_as_int(a1[e]) * rs_; } }
                    const f32x4 v0 = a0 + r0, v1 = a1 + r1;
                    *(u32x4*)(outb + off) = pack8(v0, v1);
                    if (out8) { typedef unsigned u32x2r __attribute__((ext_vector_type(2))); u32x2r o8_; o8_.x = pk_i8x4(v0, q8_); o8_.y = pk_i8x4(v1, q8_); *(u32x2r*)(out8 + off) = o8_; }
                    s += ((v0[0] * v0[0] + v0[1] * v0[1]) + (v0[2] * v0[2] + v0[3] * v0[3])) + ((v1[0] * v1[0] + v1[1] * v1[1]) + (v1[2] * v1[2] + v1[3] * v1[3])); }
                s += __shfl_xor(s, 16); s += __shfl_xor(s, 32);
                if (fq == 0) ssq[(size_t)row * 64 + u.pn * 4 + wc] = s; }
    }
};
__device__ __forceinline__ float row_rstd(const float* ssq, int row, int fq) {
    const f32x4* p = (const f32x4*)(ssq + (size_t)row * 64 + fq * 16); float s = 0.f;
#pragma unroll
    for (int k = 0; k < 4; ++k) { const f32x4 v = p[k]; s += (v[0] + v[1]) + (v[2] + v[3]); }
    s += __shfl_xor(s, 16); s += __shfl_xor(s, 32);
    return __builtin_amdgcn_rsqf(s * (1.0f / 4096.0f) + 1e-6f);
}
struct EpiRowScale {
    static constexpr bool PERM = true, AFTER_DRAIN = false;
    bf16_t* O; int ldc; const float* ssq; const float* ssq_q = nullptr; float sbw = 1.0f;
    __device__ __forceinline__ void operator()(const f32x4 (&acc)[2][2][4][2], const Unit& u, int wr, int wc, int fr, int fq) const {
        const int row0 = u.pm * BM + wr * 64 + fr, col0 = u.pn * BM + wc * 32 + 8 * fq;
#pragma unroll
        for (int ai = 0; ai < 2; ++ai)
#pragma unroll
            for (int m = 0; m < 4; ++m) { const int row = row0 + ai * HALF + m * 16; float rs = row_rstd(ssq, row, fq);
                if (ssq_q) rs = rs * (H2Q_CLIP / 127.0f) * sbw / row_rstd(ssq_q, row, fq);
#pragma unroll
                for (int bj = 0; bj < 2; ++bj) { f32x4 a0 = acc[ai][bj][m][0], a1 = acc[ai][bj][m][1];
                    if (Q8_INT_ && ssq_q) {
#pragma unroll
                        for (int e = 0; e < 4; ++e) { a0[e] = (float)__float_as_int(a0[e]); a1[e] = (float)__float_as_int(a1[e]); } }
                    *(u32x4*)(O + (size_t)row * ldc + col0 + bj * HALF) = pack8(a0 * rs, a1 * rs); } }
    }
};
struct EpiSoftmax {
    static constexpr bool PERM = true, AFTER_DRAIN = true;
    bf16_t* O; int ldc; const float* ssq; float scale_log2e;
    __device__ __forceinline__ void fused(f32x4 (&acc)[2][2][4][2], const Unit& u, int wr, int wc, int fr, int fq, PG8_LAS unsigned char* lds, int wid, int lane) const {
        typedef float f32x2v __attribute__((ext_vector_type(2)));
        PG8_LAS f32x2v* X = (PG8_LAS f32x2v*)lds;
        float mwv[2][4];
#pragma unroll
        for (int ai = 0; ai < 2; ++ai)
#pragma unroll
            for (int m = 0; m < 4; ++m) { const int rl = ai * HALF + wr * 64 + m * 16 + fr; const float rs = row_rstd(ssq, u.pm * BM + rl, fq) * scale_log2e;
                float mx = -3.0e38f;
#pragma unroll
                for (int bj = 0; bj < 2; ++bj)
#pragma unroll
                    for (int n = 0; n < 2; ++n) { acc[ai][bj][m][n] = acc[ai][bj][m][n] * rs; const f32x4 v = acc[ai][bj][m][n]; mx = fmaxf(mx, fmaxf(fmaxf(v[0], v[1]), fmaxf(v[2], v[3]))); }
                mx = fmaxf(mx, __shfl_xor(mx, 16)); mx = fmaxf(mx, __shfl_xor(mx, 32));
                float sm = 0.f;
#pragma unroll
                for (int bj = 0; bj < 2; ++bj)
#pragma unroll
                    for (int n = 0; n < 2; ++n) { f32x4 v = acc[ai][bj][m][n];
#pragma unroll
                        for (int e = 0; e < 4; ++e) { v[e] = __builtin_amdgcn_exp2f(v[e] - mx); sm += v[e]; } acc[ai][bj][m][n] = v; }
                sm += __shfl_xor(sm, 16); sm += __shfl_xor(sm, 32);
                mwv[ai][m] = mx;
                if (fq == 0) X[rl * 4 + wc] = (f32x2v){mx, sm}; }
        asm volatile("s_waitcnt lgkmcnt(0)" ::: "memory"); __builtin_amdgcn_s_barrier(); asm volatile("" ::: "memory");
        const int col0 = u.pn * BM + wc * 32 + 8 * fq;
#pragma unroll
        for (int ai = 0; ai < 2; ++ai)
#pragma unroll
            for (int m = 0; m < 4; ++m) { const int rl = ai * HALF + wr * 64 + m * 16 + fr;
                const f32x2v a = X[rl * 4 + 0], b = X[rl * 4 + 1], c = X[rl * 4 + 2], d = X[rl * 4 + 3];
                const float Mx = fmaxf(fmaxf(a.x, b.x), fmaxf(c.x, d.x));
                const float S = a.y * __builtin_amdgcn_exp2f(a.x - Mx) + b.y * __builtin_amdgcn_exp2f(b.x - Mx) + c.y * __builtin_amdgcn_exp2f(c.x - Mx) + d.y * __builtin_amdgcn_exp2f(d.x - Mx);
                const float f = __builtin_amdgcn_exp2f(mwv[ai][m] - Mx) / S;
#pragma unroll
                for (int bj = 0; bj < 2; ++bj) *(u32x4*)(O + (size_t)(u.pm * BM + rl) * ldc + col0 + bj * HALF) = pack8(acc[ai][bj][m][0] * f, acc[ai][bj][m][1] * f); }
    }
};

template <class Epi, class Sched, bool ALIGN_EPI = false, bool SP2 = false, bool FP8 = false>
__device__ __forceinline__ void gemm_phase(PG8_LAS unsigned char* lds, const Gemm g, const Sched& S, const Epi& E) {
    int tid_ = threadIdx.x; asm volatile("" : "+v"(tid_));
    const int tid = tid_, wid = __builtin_amdgcn_readfirstlane(tid >> 6), lane = tid & 63, wr = wid >> 2, wc = wid & 3, fr = lane & 15, fq = lane >> 4;
    const int K = g.K, nt = K / BK;
    unsigned voffA[2], voffB[2];
#pragma unroll
    for (int i = 0; i < 2; ++i) { int R, C; stage_rc(tid * 16 + i * 8192, R, C); const int Rb = Epi::PERM ? ((R & ~31) + perm32(R & 31)) : R;
        voffA[i] = (unsigned)(R * g.lda + C) * 2u; voffB[i] = (unsigned)(Rb * g.ldb + C) * 2u; }
    const size_t kstep = (size_t)(BK * 2);
    const size_t hstepA = (size_t)HALF * g.lda * 2, hstepB = (size_t)HALF * g.ldb * 2;

    const unsigned ldsw = (unsigned)wid * 1024u;
    const int aoff = lds_byte(wr * 64 + fr, fq * 8), boff = lds_byte(wc * 32 + fr, fq * 8);
#define PG8_SA(b, h) (((b) * 2 + (h)) * HTB)
#define PG8_SB(b, h) ((4 + (b) * 2 + (h)) * HTB)
#define PG8_STAGE(bufoff, gbase, voff) do { _Pragma("unroll") for (int _i = 0; _i < 2; ++_i) { unsigned keep_; \
        asm volatile("s_mov_b32 %0, m0\n\ts_mov_b32 m0, %3\n\ts_nop 0\n\tglobal_load_lds_dwordx4 %1, %2\n\ts_mov_b32 m0, %0" : "=&s"(keep_) \
            : "v"((voff)[_i]), "s"((const char*)(gbase)), "s"((unsigned)(size_t)(lds + (bufoff) + ldsw + _i * 8192)) : "memory"); } } while (0)
#define PG8_LDA(dst, b, h) do { _Pragma("unroll") for (int m = 0; m < 4; ++m) dst[m] = __builtin_shufflevector(*(const PG8_LAS v4i_*)(lds + PG8_SA(b, h) + aoff + m * 2048), *(const PG8_LAS v4i_*)(lds + PG8_SA(b, h) + aoff + m * 2048 + 1024), 0, 1, 2, 3, 4, 5, 6, 7); } while (0)
#define PG8_LDB(dst, b, h) do { _Pragma("unroll") for (int n = 0; n < 2; ++n) dst[n] = __builtin_shufflevector(*(const PG8_LAS v4i_*)(lds + PG8_SB(b, h) + boff + n * 2048), *(const PG8_LAS v4i_*)(lds + PG8_SB(b, h) + boff + n * 2048 + 1024), 0, 1, 2, 3, 4, 5, 6, 7); } while (0)
#define PG8_LO4(x) __builtin_shufflevector(x, x, 0, 1, 2, 3)
#define PG8_HI4(x) __builtin_shufflevector(x, x, 4, 5, 6, 7)
#define PG8_LO(x) __builtin_bit_cast(bf16x8, __builtin_shufflevector(x, x, 0, 1, 2, 3))
#define PG8_HI(x) __builtin_bit_cast(bf16x8, __builtin_shufflevector(x, x, 4, 5, 6, 7))
#define PG8_MMA(ai, bj, At, Bt) do { __builtin_amdgcn_s_setprio(1); _Pragma("unroll") for (int m = 0; m < 4; ++m) _Pragma("unroll") for (int n = 0; n < 2; ++n) { \
        if constexpr (FP8) { if constexpr (Q8_INT_) { \
                acc[ai][bj][m][n] = __builtin_bit_cast(f32x4, __builtin_amdgcn_mfma_i32_16x16x64_i8(PG8_LO4(Bt[n]), PG8_LO4(At[m]), __builtin_bit_cast(v4i_, acc[ai][bj][m][n]), 0, 0, 0)); \
                acc[ai][bj][m][n] = __builtin_bit_cast(f32x4, __builtin_amdgcn_mfma_i32_16x16x64_i8(PG8_HI4(Bt[n]), PG8_HI4(At[m]), __builtin_bit_cast(v4i_, acc[ai][bj][m][n]), 0, 0, 0)); \
            } else acc[ai][bj][m][n] = __builtin_amdgcn_mfma_scale_f32_16x16x128_f8f6f4(Bt[n], At[m], acc[ai][bj][m][n], 0, 0, 0, 0, 0, 0); } \
        else { acc[ai][bj][m][n] = __builtin_amdgcn_mfma_f32_16x16x32_bf16(PG8_LO(Bt[n]), PG8_LO(At[m]), acc[ai][bj][m][n], 0, 0, 0); acc[ai][bj][m][n] = __builtin_amdgcn_mfma_f32_16x16x32_bf16(PG8_HI(Bt[n]), PG8_HI(At[m]), acc[ai][bj][m][n], 0, 0, 0); } } \
        __builtin_amdgcn_s_setprio(0); } while (0)
#define PG8_WAIT_V(n) asm volatile("s_waitcnt vmcnt(" #n ")" ::: "memory")
#define PG8_WAIT_L(n) asm volatile("s_waitcnt lgkmcnt(" #n ")" ::: "memory")
#define PG8_BAR __builtin_amdgcn_s_barrier()
#define PG8_SCHED __builtin_amdgcn_sched_barrier(0)
    Unit cur, nxt; int ui = 0;
    if (!S.next(0, cur)) return;
    f32x4 acc[2][2][4][2];
#pragma unroll
    for (int a = 0; a < 2; ++a)
#pragma unroll
        for (int b = 0; b < 2; ++b)
#pragma unroll
            for (int m = 0; m < 4; ++m)
#pragma unroll
                for (int n = 0; n < 2; ++n) acc[a][b][m][n] = (f32x4){0.f, 0.f, 0.f, 0.f};
    typedef int v4i_ __attribute__((ext_vector_type(4))); typedef int v8i_ __attribute__((ext_vector_type(8)));
    v8i_ At[4], B0[2], B1[2];
    const char* cA = g.a_ptr(cur); const char* cB = g.b_ptr(cur);
    S.a_ready(cur);
    if constexpr (SP2) {
        PG8_STAGE(PG8_SB(0, 0), cB, voffB); PG8_STAGE(PG8_SB(0, 1), cB + hstepB, voffB); PG8_STAGE(PG8_SA(0, 0), cA, voffA); PG8_STAGE(PG8_SA(0, 1), cA + hstepA, voffA);
        if (wr == 1) PG8_BAR;
        PG8_WAIT_V(2); PG8_BAR;
        PG8_STAGE(PG8_SB(1, 0), cB + kstep, voffB); PG8_STAGE(PG8_SA(1, 0), cA + kstep, voffA); PG8_STAGE(PG8_SB(1, 1), cB + hstepB + kstep, voffB);
        PG8_WAIT_V(6); PG8_BAR;
    } else {
        PG8_STAGE(PG8_SB(0, 0), cB, voffB); PG8_STAGE(PG8_SA(0, 0), cA, voffA); PG8_STAGE(PG8_SB(0, 1), cB + hstepB, voffB); PG8_STAGE(PG8_SA(0, 1), cA + hstepA, voffA);
        if (wr == 1) PG8_BAR;
        PG8_WAIT_V(4); PG8_BAR;
        PG8_STAGE(PG8_SB(1, 0), cB + kstep, voffB); PG8_STAGE(PG8_SA(1, 0), cA + kstep, voffA); PG8_STAGE(PG8_SB(1, 1), cB + hstepB + kstep, voffB);
        PG8_WAIT_V(6); PG8_BAR;
    }
    for (;;) {
        const bool has_next = S.next(ui + 1, nxt);
        const char* nA = has_next ? g.a_ptr(nxt) : cA; const char* nB = has_next ? g.b_ptr(nxt) : cB;
        for (int t = 0; t < nt; t += 2) {
            const bool last = (t == nt - 2);
            const char* a1 = cA + (size_t)(t + 1) * kstep;
            const char* a2 = last ? nA : cA + (size_t)(t + 2) * kstep; const char* b2 = last ? nB : cB + (size_t)(t + 2) * kstep;
            const char* a3 = a2 + kstep; const char* b3 = b2 + kstep;
            if (last && has_next) S.a_ready(nxt);
            if constexpr (SP2) {
            PG8_LDB(B0, 0, 0); PG8_LDB(B1, 0, 1); PG8_SCHED; PG8_LDA(At, 0, 0); PG8_STAGE(PG8_SA(1, 1), a1 + hstepA, voffA);
            PG8_WAIT_V(8); PG8_WAIT_L(0); PG8_BAR; PG8_MMA(0, 0, At, B0); PG8_MMA(0, 1, At, B1); PG8_BAR; PG8_SCHED;
            PG8_LDA(At, 0, 1); PG8_STAGE(PG8_SB(0, 0), b2, voffB); PG8_STAGE(PG8_SB(0, 1), b2 + hstepB, voffB); PG8_STAGE(PG8_SA(0, 0), a2, voffA);
            PG8_WAIT_V(8); PG8_WAIT_L(0); PG8_BAR; PG8_MMA(1, 0, At, B0); PG8_MMA(1, 1, At, B1); PG8_BAR; PG8_SCHED;
            PG8_LDB(B0, 1, 0); PG8_LDB(B1, 1, 1); PG8_SCHED; PG8_LDA(At, 1, 0); PG8_STAGE(PG8_SA(0, 1), a2 + hstepA, voffA);
            PG8_WAIT_V(8); PG8_WAIT_L(0); PG8_BAR; PG8_MMA(0, 0, At, B0); PG8_MMA(0, 1, At, B1); PG8_BAR; PG8_SCHED;
            PG8_LDA(At, 1, 1); PG8_STAGE(PG8_SB(1, 0), b3, voffB); PG8_STAGE(PG8_SB(1, 1), b3 + hstepB, voffB); PG8_STAGE(PG8_SA(1, 0), a3, voffA);
            PG8_WAIT_V(8); PG8_WAIT_L(0); PG8_BAR; PG8_MMA(1, 0, At, B0); PG8_MMA(1, 1, At, B1); PG8_BAR; PG8_SCHED;
            } else {
            PG8_LDB(B0, 0, 0); PG8_SCHED; PG8_LDA(At, 0, 0); PG8_STAGE(PG8_SA(1, 1), a1 + hstepA, voffA);
            PG8_WAIT_L(8); PG8_BAR; PG8_WAIT_L(0); PG8_MMA(0, 0, At, B0); PG8_BAR; PG8_SCHED;
            PG8_LDB(B1, 0, 1); PG8_STAGE(PG8_SB(0, 0), b2, voffB);
            PG8_BAR; PG8_WAIT_L(0); PG8_MMA(0, 1, At, B1); PG8_BAR;
            PG8_LDA(At, 0, 1); PG8_STAGE(PG8_SA(0, 0), a2, voffA);
            PG8_BAR; PG8_WAIT_L(0); PG8_MMA(1, 0, At, B0); PG8_BAR; PG8_SCHED;
            PG8_STAGE(PG8_SB(0, 1), b2 + hstepB, voffB);
            PG8_WAIT_V(6); PG8_BAR; PG8_MMA(1, 1, At, B1); PG8_BAR;
            PG8_LDB(B0, 1, 0); PG8_SCHED; PG8_LDA(At, 1, 0); PG8_STAGE(PG8_SA(0, 1), a2 + hstepA, voffA);
            PG8_WAIT_L(8); PG8_BAR; PG8_WAIT_L(0); PG8_MMA(0, 0, At, B0); PG8_BAR; PG8_SCHED;
            PG8_LDB(B1, 1, 1); PG8_STAGE(PG8_SB(1, 0), b3, voffB);
            PG8_BAR; PG8_WAIT_L(0); PG8_MMA(0, 1, At, B1); PG8_BAR;
            PG8_LDA(At, 1, 1); PG8_STAGE(PG8_SA(1, 0), a3, voffA);
            PG8_BAR; PG8_WAIT_L(0); PG8_MMA(1, 0, At, B0); PG8_BAR; PG8_SCHED;
            PG8_STAGE(PG8_SB(1, 1), b3 + hstepB, voffB);
            PG8_WAIT_V(6); PG8_BAR; PG8_MMA(1, 1, At, B1); PG8_BAR;
            }
        }
        if constexpr (ALIGN_EPI) { if (wr == 0) PG8_BAR; }
        if constexpr (!Epi::AFTER_DRAIN) { E(acc, cur, wr, wc, fr, fq); S.done(cur); }
        if (!has_next) break;
#pragma unroll
        for (int a = 0; a < 2; ++a)
#pragma unroll
            for (int b = 0; b < 2; ++b)
#pragma unroll
                for (int m = 0; m < 4; ++m)
#pragma unroll
                    for (int n = 0; n < 2; ++n) acc[a][b][m][n] = (f32x4){0.f, 0.f, 0.f, 0.f};
        cur = nxt; cA = nA; cB = nB; ++ui;
        if constexpr (ALIGN_EPI) { if (wr == 1) PG8_BAR; }
    }
    PG8_WAIT_V(0);
    if constexpr (!ALIGN_EPI) { if (wr == 0) PG8_BAR; }
    PG8_BAR;
    if constexpr (Epi::AFTER_DRAIN) { E.fused(acc, cur, wr, wc, fr, fq, lds, wid, lane); S.done(cur); }
#undef PG8_SA
#undef PG8_SB
#undef PG8_STAGE
#undef PG8_LDA
#undef PG8_LDB
#undef PG8_LO
#undef PG8_HI
#undef PG8_MMA
#undef PG8_WAIT_V
#undef PG8_WAIT_L
#undef PG8_BAR
#undef PG8_SCHED
}
}
#define GAS __attribute__((address_space(1)))
#define LAS __attribute__((address_space(3)))
typedef unsigned short bf16;
typedef unsigned v4u __attribute__((ext_vector_type(4)));
typedef float f32x4 __attribute__((ext_vector_type(4)));
typedef short bf16x8 __attribute__((ext_vector_type(8)));
typedef GAS unsigned gu32;
typedef GAS unsigned long long gu64;
#define RLX_AGENT __ATOMIC_RELAXED, __HIP_MEMORY_SCOPE_AGENT
#define LDS_WAIT() asm volatile("s_waitcnt lgkmcnt(0)" ::: "memory")
#define VM_WAIT() asm volatile("s_waitcnt vmcnt(0)" ::: "memory")
__device__ __forceinline__ unsigned long long rt() { return __builtin_amdgcn_s_memrealtime(); }
__device__ __forceinline__ unsigned f2bf(float f) { unsigned u = __builtin_bit_cast(unsigned, f); return (u + 0x7fffu + ((u >> 16) & 1u)) >> 16; }
__device__ __forceinline__ unsigned pk2(float lo, float hi) { return f2bf(lo) | (f2bf(hi) << 16); }

#define XB_TMO      128
#define XB_XCNT(j)  (256  + 64 * (j))
#define XB_XSUB(j)  (1280 + 64 * (j))
#define XB_XGEN(j)  (2304 + 64 * (j))
#define XB_TOP      3328
#define XB_TOPGEN   3392
#define XCD_BAR_WORDS 3456
#define XB_SPIN_CAP (1u << 18)

__device__ __forceinline__ unsigned xb_ld(unsigned* p)              { return __hip_atomic_load(p, __ATOMIC_RELAXED, __HIP_MEMORY_SCOPE_AGENT); }
__device__ __forceinline__ unsigned xb_add(unsigned* p, unsigned v) { return __hip_atomic_fetch_add(p, v, __ATOMIC_RELAXED, __HIP_MEMORY_SCOPE_AGENT); }
__device__ __forceinline__ unsigned xb_xcc_id() { return (unsigned)__builtin_amdgcn_s_getreg((3 << 11) | 20) & 0xFu; }
#define XB_SPIN(cond, bar) do { unsigned _sp = 0; while (cond) { __builtin_amdgcn_s_sleep(1); \
    if ((++_sp & 255u) == 0u) { if (xb_ld(&(bar)[XB_TMO])) break; if (_sp > XB_SPIN_CAP) { atomicAdd(&(bar)[XB_TMO], 1u); break; } } } } while (0)

struct XcdBarrier {
    unsigned* bar; unsigned x;
    volatile LAS unsigned* st;
};

__device__ __forceinline__ XcdBarrier xcd_barrier_post(unsigned* bar, volatile LAS unsigned* st) {
    XcdBarrier b; b.bar = bar; b.x = xb_xcc_id(); b.st = st;
    if (threadIdx.x == 0) (void)xb_add(&bar[XB_XCNT(b.x)], 1u);
    return b;
}
__device__ __forceinline__ void xcd_barrier_complete(unsigned* bar, unsigned x, unsigned& nloc, unsigned& nx) {
    const unsigned G = gridDim.x * gridDim.y * gridDim.z;
    unsigned sum, cnt, mine, sp = 0u;
    for (;;) {
        sum = 0u; cnt = 0u; mine = 0u;
#pragma unroll
        for (unsigned j = 0; j < 16; ++j) { const unsigned c = xb_ld(&bar[XB_XCNT(j)]); sum += c; cnt += (c > 0u) ? 1u : 0u; mine = (j == x) ? c : mine; }
        if (sum == G) break;
        __builtin_amdgcn_s_sleep(1);
        if ((++sp & 255u) == 0u) { if (xb_ld(&bar[XB_TMO])) break; if (sp > XB_SPIN_CAP) { atomicAdd(&bar[XB_TMO], 1u); break; } }
    }
    nloc = mine > 0u ? mine : 1u; nx = cnt > 0u ? cnt : 1u;
}

__device__ __forceinline__ void xcd_barrier(const XcdBarrier& b) {
    asm volatile("s_waitcnt vmcnt(0)" ::: "memory");
    __syncthreads();
    if (threadIdx.x == 0) {
        unsigned* bar = b.bar;
        __builtin_amdgcn_s_waitcnt(0);
        unsigned nloc = b.st[0], nx = b.st[1];
        if (nloc == 0u) { xcd_barrier_complete(bar, b.x, nloc, nx); b.st[0] = nloc; b.st[1] = nx; }
        const unsigned old = xb_add(&bar[XB_XSUB(b.x)], 1u);
        const unsigned gen = old / nloc;
        if (old + 1u == (gen + 1u) * nloc) {
            __builtin_amdgcn_fence(__ATOMIC_RELEASE, "agent");
            asm volatile("s_waitcnt vmcnt(0)" ::: "memory");
            const unsigned og = xb_add(&bar[XB_TOP], 1u);
            const unsigned tg = og / nx;
            if (og + 1u == (tg + 1u) * nx) xb_add(&bar[XB_TOPGEN], 1u);
            else XB_SPIN(xb_ld(&bar[XB_TOPGEN]) == tg, bar);
            __builtin_amdgcn_fence(__ATOMIC_ACQUIRE, "agent");
            xb_add(&bar[XB_XGEN(b.x)], 1u);
            asm volatile("s_waitcnt vmcnt(0)" ::: "memory");
        } else {
            XB_SPIN(xb_ld(&bar[XB_XGEN(b.x)]) == gen, bar);
            __builtin_amdgcn_fence(__ATOMIC_ACQUIRE, "agent");
            asm volatile("s_waitcnt vmcnt(0)" ::: "memory");
        }
    }
    __syncthreads();
}

constexpr int NWAVES = 8, NTHR = 512;
constexpr int D = 4096, BATCH = 4, SEQ = 4096, M = BATCH * SEQ, MEML = 256, MROWS = BATCH * MEML, NIN = 14336;
constexpr int COL_DQ = 0, COL_DK = 2048, COL_DV = 4096, COL_HQ = 6144, COL_HF = 8192, COL_HI = 10240, COL_HG = 12288;
constexpr int NEXP = 16384, PEER_H = 8, PEER_K = 16, NSEL = PEER_H * PEER_K;
constexpr float EPS = 1e-6f, LOG2E = 1.4426950408889634f;
#ifndef Q8_INT
#define Q8_INT 1
#endif
constexpr float WIN_QS = Q8_INT ? 1344.0f : 2048.0f;
constexpr size_t MiB = 1u << 20;
constexpr size_t WS_CTL = 0, CTL_ZERO_BYTES = 1 * MiB;
constexpr size_t WS_SUBK = 1 * MiB;
constexpr size_t WS_XN = 2 * MiB;
constexpr size_t WS_WIN = 130 * MiB;
constexpr size_t WS_WOUT = 242 * MiB, WS_WCQ = 274 * MiB, WS_WCKV = 306 * MiB, WS_WCO = 370 * MiB, WS_WPQ = 402 * MiB;
constexpr size_t WS_PROJ = 418 * MiB;
constexpr size_t WS_H1F = WS_PROJ, WS_H1B = WS_PROJ + 256 * MiB, WS_PB = WS_PROJ + 384 * MiB;
constexpr size_t WS_MEMN = 866 * MiB, WS_KV = 874 * MiB, WS_WKP = 890 * MiB, WS_VP = 922 * MiB;
constexpr size_t WS_EIDX = 954 * MiB, WS_GATE = 962 * MiB, WS_HSSQ = 970 * MiB, WS_SSQ1 = 974 * MiB, WS_SSQ2 = 978 * MiB;
constexpr size_t WS_ATT = 982 * MiB;
constexpr size_t WS_DOWN = 1014 * MiB, WS_UP = 1078 * MiB, WS_WSEL = 1142 * MiB, WS_DSC = 1150 * MiB, WS_USC = 1151 * MiB, WS_END = 1152 * MiB;
constexpr float KV_Q8 = 127.0f / 6.5f;
constexpr float MIX_CLIP = 8.0f, MIX_Q8 = 127.0f / MIX_CLIP;
constexpr size_t WS_XN8 = 1152 * MiB, WS_WIN8 = 1216 * MiB, WS_END2 = 1272 * MiB;
constexpr size_t WS_SA = 1150 * MiB + 512 * 1024;
constexpr int CW_AMAX = 8;
constexpr int CW_BAR = 4096;
constexpr int RING_BYTES = 131072, LDS_BYTES = 163840, LDSCTL_OFF = LDS_BYTES - 1024, MISC_OFF = LDSCTL_OFF + 320;

struct Args { const float* in[23]; float* out; unsigned char* ws; int ph_lo, ph_hi, use_bar, pad; };
struct Frame {
    LAS unsigned char* lds;
    volatile LAS unsigned* MISC;
    gu32* ctl;
    int tid, lane, wave, vcu, G;
    unsigned char* ws;
    const Args* ka;
    float* out;
};
__device__ __forceinline__ float bf2f(unsigned short b) { return __uint_as_float((unsigned)b << 16); }
__device__ __forceinline__ float bflo(unsigned w) { return __uint_as_float(w << 16); }
__device__ __forceinline__ float bfhi(unsigned w) { return __uint_as_float(w & 0xffff0000u); }
__device__ __forceinline__ float wave_sum(float v) {
#pragma unroll
    for (int o = 1; o < 64; o <<= 1) v += __shfl_xor(v, o);
    return v;
}
__device__ __forceinline__ void p0_transpose_item(const float* W, int K, int N, bf16* WT, const float* ks, LAS float* scr, int item, int lane) {
    const int nblk = N / 32, kb = item / nblk, nb = item % nblk, k0 = 64 * kb, n0 = 32 * nb;
#pragma unroll 8
    for (int i = 0; i < 32; ++i) { const int kk = 2 * i + (lane >> 5); float v = W[(size_t)(k0 + kk) * N + n0 + (lane & 31)]; if (ks) v *= ks[k0 + kk]; scr[kk * 33 + (lane & 31)] = v; }
    LDS_WAIT(); asm volatile("" ::: "memory");
    const int c = lane & 7;
#pragma unroll
    for (int j = 0; j < 4; ++j) { const int n = (lane >> 3) + 8 * j; const LAS float* s = scr + (8 * c) * 33 + n;
        v4u o; o.x = pk2(s[0 * 33], s[1 * 33]); o.y = pk2(s[2 * 33], s[3 * 33]); o.z = pk2(s[4 * 33], s[5 * 33]); o.w = pk2(s[6 * 33], s[7 * 33]);
        *(GAS v4u*)(WT + (size_t)(n0 + n) * K + k0 + 8 * c) = o; }
    LDS_WAIT(); asm volatile("" ::: "memory");
}
#ifndef FP8_SEGS
#define FP8_SEGS 0x7f
#endif
#ifndef Q8_INT
#define Q8_INT 1
#endif
__device__ __forceinline__ unsigned q8_pack4(float a, float b, float c, float d) {
    const int ia = (int)rintf(a), ib = (int)rintf(b), ic = (int)rintf(c), id = (int)rintf(d);
    return ((unsigned)ia & 255u) | (((unsigned)ib & 255u) << 8) | (((unsigned)ic & 255u) << 16) | ((unsigned)id << 24); }
__device__ __forceinline__ void p0_transpose_item_fp8(const float* W, int K, int N, unsigned char* WT, float qs, LAS float* scr, int item, int lane, const float* ks = nullptr) {
    const int nblk = N / 32, kb = item / nblk, nb = item % nblk, k0 = 64 * kb, n0 = 32 * nb;
    float wl_[32];
    { const float* wp_ = W + (size_t)(k0 + (lane >> 5)) * N + n0 + (lane & 31); const size_t st_ = (size_t)2 * N;
#pragma unroll
      for (int i = 0; i < 32; ++i) wl_[i] = wp_[i * st_]; }
    float kl_[32];
    if (ks) {
#pragma unroll
        for (int i = 0; i < 32; ++i) kl_[i] = ks[k0 + 2 * i + (lane >> 5)]; }
#pragma unroll
    for (int i = 0; i < 32; ++i) { const int kk = 2 * i + (lane >> 5); float wv_ = wl_[i] * qs; if (ks) wv_ *= kl_[i]; scr[kk * 33 + (lane & 31)] = __builtin_amdgcn_fmed3f(wv_, Q8_INT ? -127.0f : -448.0f, Q8_INT ? 127.0f : 448.0f); }
    LDS_WAIT(); asm volatile("" ::: "memory");
    const int c = lane & 3;
#pragma unroll
    for (int j = 0; j < 2; ++j) { const int n = (lane >> 2) + 16 * j; const LAS float* sp = scr + (16 * c) * 33 + n; v4u o; unsigned ow[4];
#pragma unroll
        for (int q = 0; q < 4; ++q) {
#if Q8_INT
            ow[q] = q8_pack4(sp[(4 * q) * 33], sp[(4 * q + 1) * 33], sp[(4 * q + 2) * 33], sp[(4 * q + 3) * 33]);
#else
            int w = __builtin_amdgcn_cvt_pk_fp8_f32(sp[(4 * q) * 33], sp[(4 * q + 1) * 33], 0, false); w = __builtin_amdgcn_cvt_pk_fp8_f32(sp[(4 * q + 2) * 33], sp[(4 * q + 3) * 33], w, true); ow[q] = (unsigned)w;
#endif
        }
        o.x = ow[0]; o.y = ow[1]; o.z = ow[2]; o.w = ow[3];
        *(GAS v4u*)(WT + (size_t)(n0 + n) * K + k0 + 16 * c) = o; }
    LDS_WAIT(); asm volatile("" ::: "memory");
}
__device__ __forceinline__ void row4096_norm_to_fp8(const float* src, const float* g, unsigned char* dst, bf16* dst16, float* sa_out, int lane) {
    const GAS f32x4* xr = (const GAS f32x4*)src + lane;
    f32x4 v[16]; float s = 0.f;
#pragma unroll
    for (int j = 0; j < 16; ++j) { v[j] = xr[64 * j]; s += (v[j].x * v[j].x + v[j].y * v[j].y) + (v[j].z * v[j].z + v[j].w * v[j].w); }
    const float r = __builtin_amdgcn_rsqf(wave_sum(s) * (1.f / 4096.f) + EPS);
    float am = 0.f;
#pragma unroll
    for (int j = 0; j < 16; ++j) { v[j] = v[j] * r * ((const GAS f32x4*)g)[64 * j + lane]; am = fmaxf(am, fmaxf(fmaxf(fabsf(v[j].x), fabsf(v[j].y)), fmaxf(fabsf(v[j].z), fabsf(v[j].w)))); }
#pragma unroll
    for (int o = 1; o < 64; o <<= 1) am = fmaxf(am, __shfl_xor(am, o));
    const float q = (am > 0.f) ? (Q8_INT ? 127.0f : 448.0f) / am : 1.0f;
    GAS unsigned* o4 = (GAS unsigned*)dst + lane; GAS unsigned long long* o8 = (GAS unsigned long long*)dst16 + lane;
#pragma unroll
    for (int j = 0; j < 16; ++j) {
#if Q8_INT
        o4[64 * j] = q8_pack4(v[j].x * q, v[j].y * q, v[j].z * q, v[j].w * q);
#else
        int w = __builtin_amdgcn_cvt_pk_fp8_f32(v[j].x * q, v[j].y * q, 0, false); w = __builtin_amdgcn_cvt_pk_fp8_f32(v[j].z * q, v[j].w * q, w, true); o4[64 * j] = (unsigned)w;
#endif
        if ((FP8_SEGS & 0x7f) != 0x7f) o8[64 * j] = (unsigned long long)pk2(v[j].x, v[j].y) | ((unsigned long long)pk2(v[j].z, v[j].w) << 32); }
    if (lane == 0) *sa_out = (am > 0.f) ? am * (1.0f / (Q8_INT ? 127.0f : 448.0f)) : 1.0f;
}
__device__ __forceinline__ void row4096_bf16_to_i8(const bf16* src, unsigned char* dst, float* sc_out, int lane) {
    typedef unsigned u32x2q __attribute__((ext_vector_type(2)));
    v4u v[8]; float am = 0.f;
#pragma unroll
    for (int j = 0; j < 8; ++j) { v[j] = *(const GAS v4u*)(src + 512 * j + 8 * lane);
        const unsigned wd[4] = {v[j].x, v[j].y, v[j].z, v[j].w};
#pragma unroll
        for (int e = 0; e < 4; ++e) am = fmaxf(am, fmaxf(fabsf(bflo(wd[e])), fabsf(bfhi(wd[e])))); }
#pragma unroll
    for (int o = 1; o < 64; o <<= 1) am = fmaxf(am, __shfl_xor(am, o));
    const float q = (am > 0.f) ? 127.0f / am : 1.0f;
#pragma unroll
    for (int j = 0; j < 8; ++j) { u32x2q o;
        o.x = q8_pack4(bflo(v[j].x) * q, bfhi(v[j].x) * q, bflo(v[j].y) * q, bfhi(v[j].y) * q); o.y = q8_pack4(bflo(v[j].z) * q, bfhi(v[j].z) * q, bflo(v[j].w) * q, bfhi(v[j].w) * q);
        *(GAS u32x2q*)(dst + 512 * j + 8 * lane) = o; }
    if (lane == 0) *sc_out = (am > 0.f) ? am * (1.0f / 127.0f) : 1.0f;
}
__device__ __forceinline__ void p0_absmax(Frame& F) {
    const GAS f32x4* W = (const GAS f32x4*)F.ka->in[3]; const size_t n4 = (size_t)D * NIN / 4, stride = (size_t)F.G * NTHR;
    float am = 0.f;
    for (size_t i = (size_t)F.vcu * NTHR + F.tid; i < n4; i += stride) { const f32x4 v = W[i]; am = fmaxf(am, fmaxf(fmaxf(fabsf(v.x), fabsf(v.y)), fmaxf(fabsf(v.z), fabsf(v.w)))); }
#pragma unroll
    for (int o = 1; o < 64; o <<= 1) am = fmaxf(am, __shfl_xor(am, o));
    if (F.lane == 0) (void)__hip_atomic_fetch_max((unsigned*)(F.ctl + CW_AMAX), __float_as_uint(am), __ATOMIC_RELAXED, __HIP_MEMORY_SCOPE_AGENT);
}
__device__ __forceinline__ void row4096_to_bf16(const float* src, bf16* dst, const float* g, float sc, int mode, int lane, unsigned char* dst8 = nullptr, float q8 = 0.f) {
    const GAS f32x4* xr = (const GAS f32x4*)src + lane;
    f32x4 v[16]; float s = 0.f;
#pragma unroll
    for (int j = 0; j < 16; ++j) { v[j] = xr[64 * j]; s += (v[j].x * v[j].x + v[j].y * v[j].y) + (v[j].z * v[j].z + v[j].w * v[j].w); }
    float r = sc;
    if (mode == 1) r = __builtin_amdgcn_rsqf(wave_sum(s) * (1.f / 4096.f) + EPS);
    GAS unsigned long long* o8 = (GAS unsigned long long*)dst + lane;
#pragma unroll
    for (int j = 0; j < 16; ++j) { f32x4 w = v[j] * r; if (mode == 1) w = w * ((const GAS f32x4*)g)[64 * j + lane];
        if (dst8) ((GAS unsigned*)dst8)[64 * j + lane] = pg8::pk_i8x4(w, q8);
        else o8[64 * j] = (unsigned long long)pk2(w.x, w.y) | ((unsigned long long)pk2(w.z, w.w) << 32); }
}
__device__ __forceinline__ void row4096_to_fp8(const float* src, unsigned char* dst, float* sc_out, int lane) {
    const GAS f32x4* xr = (const GAS f32x4*)src + lane;
    f32x4 v[16]; float am = 0.f;
#pragma unroll
    for (int j = 0; j < 16; ++j) { v[j] = xr[64 * j]; am = fmaxf(am, fmaxf(fmaxf(fabsf(v[j].x), fabsf(v[j].y)), fmaxf(fabsf(v[j].z), fabsf(v[j].w)))); }
#pragma unroll
    for (int o = 1; o < 64; o <<= 1) am = fmaxf(am, __shfl_xor(am, o));
    const float q = (am > 0.f) ? 448.0f / am : 1.0f;
    GAS unsigned* o4 = (GAS unsigned*)dst + lane;
#pragma unroll
    for (int j = 0; j < 16; ++j) { int w = __builtin_amdgcn_cvt_pk_fp8_f32(v[j].x * q, v[j].y * q, 0, false); w = __builtin_amdgcn_cvt_pk_fp8_f32(v[j].z * q, v[j].w * q, w, true); o4[64 * j] = (unsigned)w; }
    if (lane == 0) *sc_out = (am > 0.f) ? am * (1.0f / 448.0f) : 1.0f;
}
__device__ __forceinline__ void row4096_to_fp4(const float* src, unsigned char* dst, float* sc_out, int lane) {
    const GAS f32x4* xr = (const GAS f32x4*)src + lane;
    f32x4 v[16]; float am = 0.f;
#pragma unroll
    for (int j = 0; j < 16; ++j) { v[j] = xr[64 * j]; am = fmaxf(am, fmaxf(fmaxf(fabsf(v[j].x), fabsf(v[j].y)), fmaxf(fabsf(v[j].z), fabsf(v[j].w)))); }
#pragma unroll
    for (int o = 1; o < 64; o <<= 1) am = fmaxf(am, __shfl_xor(am, o));
    const float q = (am > 0.f) ? 6.0f / am : 1.0f;
#pragma unroll
    for (int j = 0; j < 16; ++j) { unsigned w = __builtin_amdgcn_cvt_scalef32_pk_fp4_f32(0u, v[j].x * q, v[j].y * q, 1.0f, 0); w = __builtin_amdgcn_cvt_scalef32_pk_fp4_f32(w, v[j].z * q, v[j].w * q, 1.0f, 1);
        *(GAS unsigned short*)(dst + 1024 * (j >> 3) + 16 * (32 * (j & 1) + (lane >> 1)) + 4 * ((j >> 1) & 3) + 2 * (lane & 1)) = (unsigned short)w; }
    if (lane == 0) *sc_out = (am > 0.f) ? am * (1.0f / 6.0f) : 1.0f;
}
__device__ __forceinline__ unsigned pack_i8x4(float a, float b, float c, float d) {
    const int ia = (int)rintf(a), ib = (int)rintf(b), ic = (int)rintf(c), id = (int)rintf(d);
    return ((unsigned)ia & 255u) | (((unsigned)ib & 255u) << 8) | (((unsigned)ic & 255u) << 16) | ((unsigned)id << 24); }
__device__ __forceinline__ void row4096_to_i8(const float* src, unsigned char* dst, float* sc_out, int lane) {
    const GAS f32x4* xr = (const GAS f32x4*)src + lane;
    f32x4 v[16]; float am = 0.f;
#pragma unroll
    for (int j = 0; j < 16; ++j) { v[j] = xr[64 * j]; am = fmaxf(am, fmaxf(fmaxf(fabsf(v[j].x), fabsf(v[j].y)), fmaxf(fabsf(v[j].z), fabsf(v[j].w)))); }
#pragma unroll
    for (int o = 1; o < 64; o <<= 1) am = fmaxf(am, __shfl_xor(am, o));
    const float q = (am > 0.f) ? 127.0f / am : 1.0f;
    GAS unsigned* o4 = (GAS unsigned*)dst + lane;
#pragma unroll
    for (int j = 0; j < 16; ++j) o4[64 * j] = pack_i8x4(v[j].x * q, v[j].y * q, v[j].z * q, v[j].w * q);
    if (lane == 0) *sc_out = (am > 0.f) ? am * (1.0f / 127.0f) : 1.0f;
}
__device__ __forceinline__ void p0_prologue(Frame& F) {
    LAS float* scr = (LAS float*)(F.lds + F.wave * 16384);
    const int gw = F.vcu * NWAVES + F.wave, NGW = F.G * NWAVES;
    bf16* WS = (bf16*)F.ws;
    const float qs_in = WIN_QS;
    constexpr int I_IN = 64 * (NIN / 32), I_OUT = 64 * 128, I_CKV = 64 * 256, I_CO = 64 * 128, I_PQ = 64 * 64;
    constexpr int NITEMS = I_IN + I_OUT + I_CKV + I_CO + I_PQ;
    for (int it = gw; it < NITEMS; it += NGW) {
        int r = it;
        if (r < I_IN) { const int nb = r % (NIN / 32), kb = r / (NIN / 32), seg = nb >> 6;
            if ((FP8_SEGS >> seg) & 1) p0_transpose_item_fp8(F.ka->in[3], D, NIN, F.ws + WS_WIN8, qs_in, scr, kb * (NIN / 32) + nb, F.lane);
            else p0_transpose_item(F.ka->in[3], D, NIN, (bf16*)(F.ws + WS_WIN), nullptr, scr, kb * (NIN / 32) + nb, F.lane);
            continue; } r -= I_IN;
        if (r < I_OUT) { p0_transpose_item_fp8(F.ka->in[11], D, D, F.ws + WS_WOUT, WIN_QS, scr, r, F.lane); continue; } r -= I_OUT;
        if (r < I_CKV) { p0_transpose_item_fp8(F.ka->in[15], D, 2 * D, F.ws + WS_WCKV, WIN_QS, scr, r, F.lane); continue; } r -= I_CKV;
        if (r < I_CO) { p0_transpose_item_fp8(F.ka->in[16], D, D, F.ws + WS_WCO, WIN_QS, scr, r, F.lane); continue; } r -= I_CO;
        p0_transpose_item_fp8(F.ka->in[18], D, 2048, F.ws + WS_WPQ, WIN_QS, scr, r, F.lane, F.ka->in[17]);
    }
    (void)WS;
    constexpr int R_X = M, R_MEM = MROWS, R_CQ = D, R_DOWN = NEXP, R_UP = NEXP, R_SK = 64;
    constexpr int NROWS = R_X + R_MEM + R_CQ + R_DOWN + R_UP + R_SK;
    for (int it = gw; it < NROWS; it += NGW) {
        int r = it;
        if (r < R_X) { row4096_norm_to_fp8(F.ka->in[0] + (size_t)r * D, F.ka->in[2], F.ws + WS_XN8 + (size_t)r * D, (bf16*)(F.ws + WS_XN) + (size_t)r * D, (float*)(F.ws + WS_SA) + r, F.lane); continue; } r -= R_X;
        if (r < R_MEM) { row4096_to_bf16(F.ka->in[1] + (size_t)r * D, nullptr, F.ka->in[13], 1.f, 1, F.lane, F.ws + WS_MEMN + (size_t)r * D, KV_Q8); continue; } r -= R_MEM;
        if (r < R_CQ) { row4096_to_bf16(F.ka->in[14] + (size_t)r * D, nullptr, nullptr, F.ka->in[12][r], 0, F.lane, F.ws + WS_WCQ + (size_t)r * D, WIN_QS); continue; } r -= R_CQ;
        if (r < R_DOWN) { row4096_to_i8(F.ka->in[20] + (size_t)r * D, F.ws + WS_DOWN + (size_t)r * D, (float*)(F.ws + WS_DSC) + r, F.lane); continue; } r -= R_DOWN;
        if (r < R_UP) { row4096_to_fp4(F.ka->in[21] + (size_t)r * D, F.ws + WS_UP + (size_t)r * 2048, (float*)(F.ws + WS_USC) + r, F.lane); continue; }        r -= R_UP;
        row4096_to_bf16(F.ka->in[19] + (size_t)r * D, (bf16*)(F.ws + WS_SUBK) + (size_t)r * D, nullptr, 1.f, 0, F.lane);
    }
}

#define DPP_MUL(d, a, b, J) asm volatile("v_mul_f32_dpp %0, %1, %2 row_newbcast:" #J " row_mask:0xf bank_mask:0xf" : "=v"(d) : "v"(a), "v"(b))
#define DPP_FMAC(d, a, b, J) asm volatile("v_fmac_f32_dpp %0, %1, %2 row_newbcast:" #J " row_mask:0xf bank_mask:0xf" : "+v"(d) : "v"(a), "v"(b))
constexpr int HG_T = 32, HG_P = 36;
#define HG_STEP(QV, FV, KV, IV, TT) { float u0_, u1_, u2_, u3_, u4_, u5_, u6_, u7_, a0 = 0.f, a1 = 0.f; \
    asm volatile("s_nop 1\n\tv_mul_f32_dpp %0, %1, %2 row_newbcast:0 row_mask:0xf bank_mask:0xf" : "=v"(u0_) : "v"(FV), "v"(s[0]), "v"(QV), "v"(KV)); \
    DPP_MUL(u1_, FV, s[1], 1); DPP_MUL(u2_, FV, s[2], 2); DPP_MUL(u3_, FV, s[3], 3); DPP_MUL(u4_, FV, s[4], 4); DPP_MUL(u5_, FV, s[5], 5); DPP_MUL(u6_, FV, s[6], 6); DPP_MUL(u7_, FV, s[7], 7); \
    DPP_FMAC(u0_, KV, IV, 0); DPP_FMAC(u1_, KV, IV, 1); DPP_FMAC(u2_, KV, IV, 2); DPP_FMAC(u3_, KV, IV, 3); DPP_FMAC(u4_, KV, IV, 4); DPP_FMAC(u5_, KV, IV, 5); DPP_FMAC(u6_, KV, IV, 6); DPP_FMAC(u7_, KV, IV, 7); \
    DPP_FMAC(a0, QV, u0_, 0); DPP_FMAC(a1, QV, u1_, 1); DPP_FMAC(a0, QV, u2_, 2); DPP_FMAC(a1, QV, u3_, 3); DPP_FMAC(a0, QV, u4_, 4); DPP_FMAC(a1, QV, u5_, 5); DPP_FMAC(a0, QV, u6_, 6); DPP_FMAC(a1, QV, u7_, 7); \
    s[0] = u0_; s[1] = u1_; s[2] = u2_; s[3] = u3_; s[4] = u4_; s[5] = u5_; s[6] = u6_; s[7] = u7_; Pl[pslot + (TT) * 32] = a0 + a1; }
__device__ __forceinline__ void hgrn_unit(Frame& F, int b, int h, int vq) {
    const int tid = F.tid, lane = F.lane, w = F.wave;
    LAS float* Ql = (LAS float*)F.lds; LAS float* Fl = Ql + 128 * HG_P; LAS float* Kl = Fl + 128 * HG_P; LAS float* Il = Kl + 128 * HG_P; LAS float* Pl = Il + 32 * HG_P;
    const bf16* Pb = (const bf16*)(F.ws + WS_PROJ) + (size_t)b * SEQ * NIN;
    bf16* MIX = (bf16*)(F.ws + WS_XN); float* HSSQ = (float*)(F.ws + WS_HSSQ);
    const int lrow = tid & 31, lseg = tid >> 5;
    const bf16* qsrc = Pb + (size_t)lrow * NIN + COL_HQ + h * 128 + lseg * 8;
    const bf16* ksrc = Pb + (size_t)lrow * NIN + COL_HF + h * 128 + lseg * 8;
    const int iseg = (tid >> 5) & 3;
    const bf16* isrc = Pb + (size_t)lrow * NIN + COL_HI + h * 128 + vq * 32 + iseg * 8;
    float s[8];
#pragma unroll
    for (int j = 0; j < 8; ++j) s[j] = 0.f;
    v4u rq = *(const GAS v4u*)qsrc, rk = *(const GAS v4u*)ksrc, ri = (v4u){0u, 0u, 0u, 0u};
    if (tid < 128) ri = *(const GAS v4u*)isrc;
    const int idxq = (16 * w + 8 * (lane >> 5) + (lane & 7)) * HG_P, idxi = (lane & 31) * HG_P;
    const int pslot = (w * 2 + (lane >> 5)) * HG_T * 32 + (lane & 31);
    constexpr int NCH = SEQ / HG_T;
    __syncthreads();
    for (int c = 0; c < NCH; ++c) {
        {
            const unsigned qa[4] = {rq.x, rq.y, rq.z, rq.w}, ka[4] = {rk.x, rk.y, rk.z, rk.w}, ia[4] = {ri.x, ri.y, ri.z, ri.w};
            const int o = (lseg * 8) * HG_P + lrow;
#pragma unroll
            for (int j = 0; j < 4; ++j) { const float q0 = bflo(qa[j]), q1 = bfhi(qa[j]), k0 = bflo(ka[j]), k1 = bfhi(ka[j]);
                Ql[o + (2 * j) * HG_P] = q0; Ql[o + (2 * j + 1) * HG_P] = q1; Kl[o + (2 * j) * HG_P] = k0; Kl[o + (2 * j + 1) * HG_P] = k1; Fl[o + (2 * j) * HG_P] = 1.0f - k0; Fl[o + (2 * j + 1) * HG_P] = 1.0f - k1; }
            if (tid < 128) { const int oi = (iseg * 8) * HG_P + lrow;
#pragma unroll
                for (int j = 0; j < 4; ++j) { Il[oi + (2 * j) * HG_P] = bflo(ia[j]); Il[oi + (2 * j + 1) * HG_P] = bfhi(ia[j]); } }
        }
        if (c + 1 < NCH) { const size_t adv = (size_t)(c + 1) * HG_T * NIN; rq = *(const GAS v4u*)(qsrc + adv); rk = *(const GAS v4u*)(ksrc + adv); if (tid < 128) ri = *(const GAS v4u*)(isrc + adv); }
        __syncthreads();
        f32x4 qv = *(const LAS f32x4*)(Ql + idxq), fv = *(const LAS f32x4*)(Fl + idxq), kv = *(const LAS f32x4*)(Kl + idxq), iv = *(const LAS f32x4*)(Il + idxi);
#pragma unroll 2
        for (int t4 = 0; t4 < HG_T; t4 += 4) {
            const int tn = (t4 + 4 < HG_T) ? t4 + 4 : t4;
            const f32x4 qn = *(const LAS f32x4*)(Ql + idxq + tn), fn = *(const LAS f32x4*)(Fl + idxq + tn), kn = *(const LAS f32x4*)(Kl + idxq + tn), in_ = *(const LAS f32x4*)(Il + idxi + tn);
            HG_STEP(qv.x, fv.x, kv.x, iv.x, t4 + 0)
            HG_STEP(qv.y, fv.y, kv.y, iv.y, t4 + 1)
            HG_STEP(qv.z, fv.z, kv.z, iv.z, t4 + 2)
            HG_STEP(qv.w, fv.w, kv.w, iv.w, t4 + 3)
            qv = qn; fv = fn; kv = kn; iv = in_;
        }
        __syncthreads();
        {
            const int t = tid >> 4, vp = tid & 15; typedef float f32x2v __attribute__((ext_vector_type(2)));
            f32x2v o = {0.f, 0.f};
#pragma unroll
            for (int p = 0; p < 16; ++p) { const f32x2v x = *(LAS f32x2v*)(Pl + (p * HG_T + t) * 32 + 2 * vp); o += x; }
            const size_t grow = (size_t)b * SEQ + (size_t)c * HG_T + t;
            *(GAS unsigned*)(MIX + grow * D + 2048 + h * 128 + vq * 32 + 2 * vp) = pk2(o.x, o.y);
            float ss = o.x * o.x + o.y * o.y;
            ss += __shfl_xor(ss, 1); ss += __shfl_xor(ss, 2); ss += __shfl_xor(ss, 4); ss += __shfl_xor(ss, 8);
            if (vp == 0) HSSQ[grow * 64 + h * 4 + vq] = ss;
        }
    }
    __syncthreads();
}
#define DPPX(v, ctrl) __builtin_amdgcn_update_dpp(0, (v), (ctrl), 0xf, 0xf, false)
typedef short s16x4 __attribute__((ext_vector_type(4)));
#define MFMA16K16(a, b, c) __builtin_amdgcn_mfma_f32_16x16x16bf16_1k((a), (b), (c), 0, 0, 0)
#define MFMA16K32(a, b, c) __builtin_amdgcn_mfma_f32_16x16x32_bf16((a), (b), (c), 0, 0, 0)
constexpr int HM_P = 272;
constexpr int HM_NS = 4, HM_BLK = 39936;
__device__ __forceinline__ void hgrn_unit_mfma(Frame& F, int b, int h, int vq) {
    const int tid = F.tid, lane = F.lane, w = F.wave, l15 = lane & 15, kg = lane >> 4;
    const bf16* Pb = (const bf16*)(F.ws + WS_PROJ) + (size_t)b * SEQ * NIN;
    bf16* MIX = (bf16*)(F.ws + WS_XN); float* HSSQ = (float*)(F.ws + WS_HSSQ);
    const int lt = tid >> 5, ls = tid & 31;
    const bf16* qksrc = Pb + (size_t)lt * NIN + (ls < 16 ? COL_HQ : COL_HF) + h * 128 + (ls & 15) * 8;
    const bf16* isrc = Pb + (size_t)((tid >> 2) & 15) * NIN + COL_HI + h * 128 + vq * 32 + (tid & 3) * 8;
    v4u rqk[HM_NS], ri[HM_NS];
#pragma unroll
    for (int u = 0; u < HM_NS; ++u) { rqk[u] = *(const GAS v4u*)(qksrc + (size_t)u * 16 * NIN); ri[u] = (v4u){0u, 0u, 0u, 0u}; if (tid < 64) ri[u] = *(const GAS v4u*)(isrc + (size_t)u * 16 * NIN); }
    f32x4 S[2] = {(f32x4){0.f, 0.f, 0.f, 0.f}, (f32x4){0.f, 0.f, 0.f, 0.f}};
    constexpr int NIT = SEQ / (16 * HM_NS);
    __syncthreads();
    for (int c = 0; c < NIT; ++c) {
#pragma unroll
        for (int u = 0; u < HM_NS; ++u) { LAS unsigned char* L = F.lds + u * HM_BLK;
            *(LAS v4u*)((LAS unsigned short*)(L + (ls < 16 ? 0 : 4096)) + lt * 128 + (ls & 15) * 8) = rqk[u];
            if (tid < 64) *(LAS v4u*)((LAS unsigned short*)(L + 8192) + (tid >> 2) * 32 + (tid & 3) * 8) = ri[u]; }
        if (c + 1 < NIT) {
#pragma unroll
            for (int u = 0; u < HM_NS; ++u) { const size_t adv = (size_t)((c + 1) * HM_NS + u) * 16 * NIN; rqk[u] = *(const GAS v4u*)(qksrc + adv); if (tid < 64) ri[u] = *(const GAS v4u*)(isrc + adv); } }
        __syncthreads();
#pragma unroll
        for (int u = 0; u < HM_NS; ++u) {
            LAS unsigned char* L = F.lds + u * HM_BLK;
            LAS unsigned short* RAWQ = (LAS unsigned short*)L; LAS unsigned short* RAWK = (LAS unsigned short*)(L + 4096); LAS unsigned short* RAWI = (LAS unsigned short*)(L + 8192);
            LAS unsigned char* QT = L + 9216; LAS unsigned char* KT = L + 13568; LAS unsigned short* KH = (LAS unsigned short*)(L + 17920); LAS unsigned short* IT = (LAS unsigned short*)(L + 22016); LAS float* D16 = (LAS float*)(L + 23040);
            const int d = tid >> 2, tq = tid & 3;
            float qv[4], kv[4], cs[4]; float run = 0.f;
#pragma unroll
            for (int j = 0; j < 4; ++j) { const int t = 4 * tq + j; qv[j] = bf2f(RAWQ[t * 128 + d]); kv[j] = bf2f(RAWK[t * 128 + d]); run += __log2f(fmaxf(1.0f - kv[j], 1.0e-6f)); cs[j] = run; }
            const float t0 = __int_as_float(DPPX(__float_as_int(run), 0x00)), t1 = __int_as_float(DPPX(__float_as_int(run), 0x55)), t2 = __int_as_float(DPPX(__float_as_int(run), 0xAA)), t3 = __int_as_float(DPPX(__float_as_int(run), 0xFF));
            const float off = (tq > 0 ? t0 : 0.f) + (tq > 1 ? t1 : 0.f) + (tq > 2 ? t2 : 0.f), b16 = (t0 + t1) + (t2 + t3);
#pragma unroll
            for (int j = 0; j < 4; ++j) { const int t = 4 * tq + j; const float bt = off + cs[j];
                *(LAS unsigned short*)(QT + t * HM_P + d * 2) = (unsigned short)f2bf(qv[j] * __builtin_amdgcn_exp2f(bt));
                *(LAS unsigned short*)(KT + t * HM_P + d * 2) = (unsigned short)f2bf(kv[j] * __builtin_amdgcn_exp2f(-bt));
                KH[d * 16 + t] = (unsigned short)f2bf(kv[j] * __builtin_amdgcn_exp2f(b16 - bt)); }
            if (tq == 0) D16[d] = __builtin_amdgcn_exp2f(b16);
            IT[(tid & 31) * 16 + (tid >> 5)] = RAWI[(tid >> 5) * 32 + (tid & 31)];
        }
        __syncthreads();
#pragma unroll
        for (int u = 0; u < HM_NS; ++u) {
            LAS unsigned char* L = F.lds + u * HM_BLK;
            LAS unsigned char* QT = L + 9216; LAS unsigned char* KT = L + 13568; LAS unsigned short* KH = (LAS unsigned short*)(L + 17920); LAS unsigned short* IT = (LAS unsigned short*)(L + 22016); LAS float* D16 = (LAS float*)(L + 23040); LAS float* PART = (LAS float*)(L + 23552);
            typedef unsigned u32x2v __attribute__((ext_vector_type(2)));
            const s16x4 aq = *(const LAS s16x4*)(QT + l15 * HM_P + (16 * w + 4 * kg) * 2);
            const s16x4 bi0 = *(const LAS s16x4*)(IT + l15 * 16 + 4 * kg), bi1 = *(const LAS s16x4*)(IT + (16 + l15) * 16 + 4 * kg);
            f32x4 O0 = {0.f, 0.f, 0.f, 0.f}, O1 = O0;
            { const s16x4 bs0 = __builtin_bit_cast(s16x4, (u32x2v){pg8::cvt_pk_bf16(S[0][0], S[0][1]), pg8::cvt_pk_bf16(S[0][2], S[0][3])}), bs1 = __builtin_bit_cast(s16x4, (u32x2v){pg8::cvt_pk_bf16(S[1][0], S[1][1]), pg8::cvt_pk_bf16(S[1][2], S[1][3])});
              O0 = MFMA16K16(aq, bs0, O0); O1 = MFMA16K16(aq, bs1, O1); }
            if (w == u) {
                f32x4 at = {0.f, 0.f, 0.f, 0.f};
#pragma unroll
                for (int ks = 0; ks < 4; ++ks) { const bf16x8 ak = *(const LAS bf16x8*)(KT + l15 * HM_P + (32 * ks + 8 * kg) * 2), bq = *(const LAS bf16x8*)(QT + l15 * HM_P + (32 * ks + 8 * kg) * 2); at = MFMA16K32(ak, bq, at); }
#pragma unroll
                for (int r = 0; r < 4; ++r) if (4 * kg + r > l15) at[r] = 0.f;
                const s16x4 aA = __builtin_bit_cast(s16x4, (u32x2v){pg8::cvt_pk_bf16(at[0], at[1]), pg8::cvt_pk_bf16(at[2], at[3])});
                O0 = MFMA16K16(aA, bi0, O0); O1 = MFMA16K16(aA, bi1, O1);
            }
            LAS float* pp = PART + (w * 16 + 4 * kg) * 32 + l15;
#pragma unroll
            for (int r = 0; r < 4; ++r) { pp[r * 32] = O0[r]; pp[r * 32 + 16] = O1[r]; }
            const f32x4 d4 = *(const LAS f32x4*)(D16 + 16 * w + 4 * kg);
            const s16x4 akh = *(const LAS s16x4*)(KH + (16 * w + l15) * 16 + 4 * kg);
            S[0] = MFMA16K16(akh, bi0, S[0] * d4); S[1] = MFMA16K16(akh, bi1, S[1] * d4);
        }
        __syncthreads();
        {
            const int t = (tid >> 4) & 15, vp = tid & 15; typedef float f32x2v __attribute__((ext_vector_type(2)));
#pragma unroll
            for (int u = tid >> 8; u < HM_NS; u += 2) {
            const LAS float* PART = (const LAS float*)(F.lds + u * HM_BLK + 23552);
            f32x2v o = {0.f, 0.f};
#pragma unroll
            for (int p = 0; p < 8; ++p) { const f32x2v x = *(const LAS f32x2v*)(PART + (p * 16 + t) * 32 + 2 * vp); o += x; }
            const size_t grow = (size_t)b * SEQ + (size_t)(c * HM_NS + u) * 16 + t;
            *(GAS unsigned*)(MIX + grow * D + 2048 + h * 128 + vq * 32 + 2 * vp) = pk2(o.x, o.y);
            float ss = o.x * o.x + o.y * o.y;
            ss += __shfl_xor(ss, 1); ss += __shfl_xor(ss, 2); ss += __shfl_xor(ss, 4); ss += __shfl_xor(ss, 8);
            if (vp == 0) HSSQ[grow * 64 + h * 4 + vq] = ss;
            }
        }
    }
    __syncthreads();
}
#define HBAR() asm volatile("s_waitcnt lgkmcnt(0)\n\ts_barrier" ::: "memory")
constexpr int HH_NS = 4, HH_BLK = 37888;
__device__ __forceinline__ void hgrn_head_mfma(Frame& F, int b, int h) {
    const int tid = F.tid, lane = F.lane, w = F.wave, l15 = lane & 15, kg = lane >> 4;
    const bf16* Pb = (const bf16*)(F.ws + WS_PROJ) + (size_t)b * SEQ * NIN;
    bf16* MIX = (bf16*)(F.ws + WS_XN); const float* ng = F.ka->in[10];
    const int pp = tid & 255, pst = pp >> 4, psg = pp & 15;
    const bf16* qksrc = Pb + (size_t)pst * NIN + (tid < 256 ? COL_HQ : COL_HF) + h * 128 + psg * 8;
    const bf16* isrc = Pb + (size_t)pst * NIN + COL_HI + h * 128 + psg * 8;
    v4u rqk[HH_NS], ri[HH_NS];
#pragma unroll
    for (int u = 0; u < HH_NS; ++u) { rqk[u] = *(const GAS v4u*)(qksrc + (size_t)u * 16 * NIN); ri[u] = (v4u){0u, 0u, 0u, 0u}; if (tid < 256) ri[u] = *(const GAS v4u*)(isrc + (size_t)u * 16 * NIN); }
    f32x4 S[8];
#pragma unroll
    for (int j = 0; j < 8; ++j) S[j] = (f32x4){0.f, 0.f, 0.f, 0.f};
    f32x4 n0 = *(const GAS f32x4*)(ng + 8 * (tid & 15)), n1 = *(const GAS f32x4*)(ng + 8 * (tid & 15) + 4);
    asm volatile("" : "+v"(n0), "+v"(n1));
    constexpr int NIT = SEQ / (16 * HH_NS);
    __syncthreads();
    for (int c = 0; c < NIT; ++c) {
#pragma unroll
        for (int u = 0; u < HH_NS; ++u) { LAS unsigned char* L = F.lds + u * HH_BLK;
            *(LAS v4u*)((LAS unsigned short*)(L + (tid < 256 ? 0 : 4096)) + pst * 128 + psg * 8) = rqk[u];
            if (tid < 256) *(LAS v4u*)((LAS unsigned short*)(L + 8192) + pst * 128 + psg * 8) = ri[u]; }
#define HH_GLD(dst, ptr) asm volatile("global_load_dwordx4 %0, %1, off" : "=v"(dst) : "v"(ptr) : "memory")
        if (c + 1 < NIT) {
#pragma unroll
            for (int u = 0; u < HH_NS; ++u) { const size_t adv = (size_t)((c + 1) * HH_NS + u) * 16 * NIN; HH_GLD(rqk[u], qksrc + adv); if (tid < 256) HH_GLD(ri[u], isrc + adv); } }
        v4u gpre[2];
#pragma unroll
        for (int k = 0; k < 2; ++k) HH_GLD(gpre[k], Pb + ((size_t)(c * HH_NS + (tid >> 8) + 2 * k) * 16 + ((tid >> 4) & 15)) * NIN + COL_HG + h * 128 + 8 * (tid & 15));
#undef HH_GLD
        HBAR();
        {
            const int u = w >> 1, d = 64 * (w & 1) + lane;
            LAS unsigned char* L = F.lds + u * HH_BLK;
            LAS unsigned short* RAWQ = (LAS unsigned short*)L; LAS unsigned short* RAWK = (LAS unsigned short*)(L + 4096);
            LAS unsigned char* QT = L + 12288; LAS unsigned char* KT = L + 16640; LAS unsigned char* KHb = L + 20992; LAS float* D16 = (LAS float*)(L + 29184);
            float kv[16], cs[16]; float run = 0.f;
#pragma unroll
            for (int t = 0; t < 16; ++t) { kv[t] = bf2f(RAWK[t * 128 + d]); run += __log2f(fmaxf(1.0f - kv[t], 1.0e-6f)); cs[t] = run; }
            const float b16 = run;
            unsigned kh[8];
#pragma unroll
            for (int t = 0; t < 16; t += 2) {
                const float q0 = bf2f(RAWQ[t * 128 + d]), q1 = bf2f(RAWQ[(t + 1) * 128 + d]);
                *(LAS unsigned short*)(QT + t * HM_P + d * 2) = (unsigned short)f2bf(q0 * __builtin_amdgcn_exp2f(cs[t]));
                *(LAS unsigned short*)(QT + (t + 1) * HM_P + d * 2) = (unsigned short)f2bf(q1 * __builtin_amdgcn_exp2f(cs[t + 1]));
                *(LAS unsigned short*)(KT + t * HM_P + d * 2) = (unsigned short)f2bf(kv[t] * __builtin_amdgcn_exp2f(-cs[t]));
                *(LAS unsigned short*)(KT + (t + 1) * HM_P + d * 2) = (unsigned short)f2bf(kv[t + 1] * __builtin_amdgcn_exp2f(-cs[t + 1]));
                kh[t >> 1] = pk2(kv[t] * __builtin_amdgcn_exp2f(b16 - cs[t]), kv[t + 1] * __builtin_amdgcn_exp2f(b16 - cs[t + 1])); }
            *(LAS v4u*)(KHb + d * 32) = (v4u){kh[0], kh[1], kh[2], kh[3]}; *(LAS v4u*)(KHb + d * 32 + 16) = (v4u){kh[4], kh[5], kh[6], kh[7]};
            D16[d] = __builtin_amdgcn_exp2f(b16);
        }
        {
            const int u = tid >> 7, v = tid & 127;
            LAS unsigned char* L = F.lds + u * HH_BLK; LAS unsigned short* RAWI = (LAS unsigned short*)(L + 8192); LAS unsigned char* ITb = L + 25088;
            unsigned iw[8];
#pragma unroll
            for (int t = 0; t < 16; t += 2) iw[t >> 1] = (unsigned)RAWI[t * 128 + v] | ((unsigned)RAWI[(t + 1) * 128 + v] << 16);
            *(LAS v4u*)(ITb + v * 32) = (v4u){iw[0], iw[1], iw[2], iw[3]}; *(LAS v4u*)(ITb + v * 32 + 16) = (v4u){iw[4], iw[5], iw[6], iw[7]};
        }
        HBAR();
        typedef unsigned u32x2v __attribute__((ext_vector_type(2)));
        s16x4 aA[HH_NS];
#pragma unroll
        for (int u = 0; u < HH_NS; ++u) {
            LAS unsigned char* L = F.lds + u * HH_BLK; LAS unsigned char* QT = L + 12288; LAS unsigned char* KT = L + 16640;
            f32x4 at = {0.f, 0.f, 0.f, 0.f};
#pragma unroll
            for (int ks = 0; ks < 4; ++ks) { const bf16x8 ak = *(const LAS bf16x8*)(KT + l15 * HM_P + (32 * ks + 8 * kg) * 2), bq = *(const LAS bf16x8*)(QT + l15 * HM_P + (32 * ks + 8 * kg) * 2); at = MFMA16K32(ak, bq, at); }
#pragma unroll
            for (int r = 0; r < 4; ++r) if (4 * kg + r > l15) at[r] = 0.f;
            aA[u] = __builtin_bit_cast(s16x4, (u32x2v){pg8::cvt_pk_bf16(at[0], at[1]), pg8::cvt_pk_bf16(at[2], at[3])});
        }
#pragma unroll
        for (int u = 0; u < HH_NS; ++u) {
            LAS unsigned char* L = F.lds + u * HH_BLK;
            LAS unsigned char* QT = L + 12288; LAS unsigned short* KH = (LAS unsigned short*)(L + 20992); LAS unsigned short* IT = (LAS unsigned short*)(L + 25088); LAS float* D16 = (LAS float*)(L + 29184); LAS float* OUT = (LAS float*)(L + 29696);
            const s16x4 bi = *(const LAS s16x4*)(IT + (16 * w + l15) * 16 + 4 * kg);
            f32x4 O0 = {0.f, 0.f, 0.f, 0.f}, O1 = O0;
            O1 = MFMA16K16(aA[u], bi, O1);
#pragma unroll
            for (int j = 0; j < 8; j += 2) {
                const s16x4 aq0 = *(const LAS s16x4*)(QT + l15 * HM_P + (16 * j + 4 * kg) * 2), aq1 = *(const LAS s16x4*)(QT + l15 * HM_P + (16 * (j + 1) + 4 * kg) * 2);
                const s16x4 bs0 = __builtin_bit_cast(s16x4, (u32x2v){pg8::cvt_pk_bf16(S[j][0], S[j][1]), pg8::cvt_pk_bf16(S[j][2], S[j][3])});
                const s16x4 bs1 = __builtin_bit_cast(s16x4, (u32x2v){pg8::cvt_pk_bf16(S[j + 1][0], S[j + 1][1]), pg8::cvt_pk_bf16(S[j + 1][2], S[j + 1][3])});
                O0 = MFMA16K16(aq0, bs0, O0); O1 = MFMA16K16(aq1, bs1, O1); }
            const f32x4 O = O0 + O1;
            LAS float* op = OUT + (4 * kg) * 128 + 16 * w + l15;
#pragma unroll
            for (int r = 0; r < 4; ++r) op[r * 128] = O[r];
#pragma unroll
            for (int j = 0; j < 8; ++j) { const f32x4 d4 = *(const LAS f32x4*)(D16 + 16 * j + 4 * kg);
                const s16x4 akh = *(const LAS s16x4*)(KH + (16 * j + l15) * 16 + 4 * kg);
                S[j] = MFMA16K16(akh, bi, S[j] * d4); }
        }
        HBAR();
        asm volatile("s_waitcnt vmcnt(0)" ::: "memory");
        {
            const int t = (tid >> 4) & 15, vs = tid & 15;
#pragma unroll
            for (int k = 0; k < 2; ++k) { const int u = (tid >> 8) + 2 * k;
                const LAS float* OUT = (const LAS float*)(F.lds + u * HH_BLK + 29696);
                const size_t grow = (size_t)b * SEQ + (size_t)(c * HH_NS + u) * 16 + t;
                const v4u g = gpre[k];
                const f32x4 o0 = *(const LAS f32x4*)(OUT + t * 128 + 8 * vs), o1 = *(const LAS f32x4*)(OUT + t * 128 + 8 * vs + 4);
                float ss = ((o0.x * o0.x + o0.y * o0.y) + (o0.z * o0.z + o0.w * o0.w)) + ((o1.x * o1.x + o1.y * o1.y) + (o1.z * o1.z + o1.w * o1.w));
                ss += __shfl_xor(ss, 1); ss += __shfl_xor(ss, 2); ss += __shfl_xor(ss, 4); ss += __shfl_xor(ss, 8);
                const float rstd = __builtin_amdgcn_rsqf(ss * (1.f / 128.f) + EPS);
                typedef unsigned u32x2m __attribute__((ext_vector_type(2))); u32x2m r;
                r.x = pg8::pk_i8x4((f32x4){o0.x * rstd * n0.x * bflo(g.x), o0.y * rstd * n0.y * bfhi(g.x), o0.z * rstd * n0.z * bflo(g.y), o0.w * rstd * n0.w * bfhi(g.y)}, MIX_Q8);
                r.y = pg8::pk_i8x4((f32x4){o1.x * rstd * n1.x * bflo(g.z), o1.y * rstd * n1.y * bfhi(g.z), o1.z * rstd * n1.z * bflo(g.w), o1.w * rstd * n1.w * bfhi(g.w)}, MIX_Q8);
                *(GAS u32x2m*)(F.ws + WS_XN8 + grow * D + 2048 + h * 128 + 8 * vs) = r;
            }
        }
    }
    __syncthreads();
}
__device__ __forceinline__ void hgrn_fixup(Frame& F) {
    bf16* MIX = (bf16*)(F.ws + WS_XN); const float* HSSQ = (const float*)(F.ws + WS_HSSQ); const bf16* PROJ = (const bf16*)(F.ws + WS_PROJ); const float* ng = F.ka->in[10];
    const size_t total = (size_t)M * 256, stride = (size_t)F.G * NTHR;
    for (size_t idx = (size_t)F.vcu * NTHR + F.tid; idx < total; idx += stride) {
        const size_t row = idx >> 8; const int cg = (int)(idx & 255), hh = cg >> 4, col = cg * 8;
        const f32x4 q = *(const GAS f32x4*)(HSSQ + row * 64 + hh * 4);
        const float rstd = __builtin_amdgcn_rsqf(((q.x + q.y) + (q.z + q.w)) * (1.f / 128.f) + EPS);
        const v4u o = *(const GAS v4u*)(MIX + row * D + 2048 + col), g = *(const GAS v4u*)(PROJ + row * NIN + COL_HG + col);
        const f32x4 n0 = *(const GAS f32x4*)(ng + (col & 127)), n1 = *(const GAS f32x4*)(ng + (col & 127) + 4);
        v4u r;
        r.x = pk2(bflo(o.x) * rstd * n0.x * bflo(g.x), bfhi(o.x) * rstd * n0.y * bfhi(g.x)); r.y = pk2(bflo(o.y) * rstd * n0.z * bflo(g.y), bfhi(o.y) * rstd * n0.w * bfhi(g.y));
        r.z = pk2(bflo(o.z) * rstd * n1.x * bflo(g.z), bfhi(o.z) * rstd * n1.y * bfhi(g.z)); r.w = pk2(bflo(o.w) * rstd * n1.z * bflo(g.w), bfhi(o.w) * rstd * n1.w * bfhi(g.w));
        *(GAS v4u*)(MIX + row * D + 2048 + col) = r;
    }
}
typedef float f32x16 __attribute__((ext_vector_type(16)));
typedef short v4i16_t __attribute__((ext_vector_type(4)));
#define MFMA32(a, b, c) __builtin_amdgcn_mfma_f32_32x32x16_bf16((a), (b), (c), 0, 0, 0)
__device__ __forceinline__ int crow(int i, int hh) { return (i & 3) + 8 * (i >> 2) + 4 * hh; }
__device__ __forceinline__ float xhalf_max(float m) { auto rr = __builtin_amdgcn_permlane32_swap(__float_as_uint(m), __float_as_uint(m), false, false); return fmaxf(__uint_as_float(rr[0]), __uint_as_float(rr[1])); }
__device__ __forceinline__ float xhalf_sum(float m) { auto rr = __builtin_amdgcn_permlane32_swap(__float_as_uint(m), __float_as_uint(m), false, false); return __uint_as_float(rr[0]) + __uint_as_float(rr[1]); }
constexpr int AT_KP = 144, AT_VP = 320, AT_KB = 64 * AT_KP, AT_VB = 64 * AT_VP, AT_VOFF = 2 * AT_KB, AT_AOFF = AT_VOFF + 2 * AT_VB;
__device__ __forceinline__ void attn_unit(Frame& F, int b, int h, int qb, float lam) {
    const int tid = F.tid, lane = F.lane, w = F.wave, r = lane & 31, hh = lane >> 5;
    const bf16* Pb = (const bf16*)(F.ws + WS_PROJ) + (size_t)b * SEQ * NIN;
    LAS unsigned char* Kl = F.lds; LAS unsigned char* Vl = F.lds + AT_VOFF; LAS float* Al = (LAS float*)(F.lds + AT_AOFF) + w * 32;
    const int q0 = qb * 256 + w * 32, qpos = q0 + r;
    const float cs = exp2f(-0.5f * (float)(h + 1)) * LOG2E;
    const int NT = 4 * (qb + 1);
    float* scr = (float*)(F.ws + WS_ATT) + (size_t)blockIdx.x * 32768;
    const int i16 = lane & 15, q4 = i16 >> 2, p4 = i16 & 3, g16 = (lane >> 4) & 1;
    const int vrd = (4 * hh + q4) * AT_VP + 32 * g16 + 8 * p4;
    f32x16 O[4];
    for (int c = 0; c < 2; ++c) {
        bf16x8 qf[4];
#pragma unroll
        for (int s = 0; s < 4; ++s) qf[s] = *(const GAS bf16x8*)(Pb + (size_t)qpos * NIN + COL_DQ + h * 128 + c * 64 + 16 * s + 8 * hh);
#pragma unroll
        for (int d = 0; d < 4; ++d)
#pragma unroll
            for (int i = 0; i < 16; ++i) O[d][i] = 0.f;
        float mrun = -1.0e30f, lrun = 0.f;
        const int krow = tid >> 3, kseg = tid & 7, vrow = tid >> 4, vseg = tid & 15;
        const unsigned koff = (unsigned)(krow * NIN + kseg * 8) * 2u, voff = (unsigned)(vrow * NIN + vseg * 8) * 2u;
        const char* kbase = (const char*)(Pb + COL_DK + h * 128 + c * 64); const char* vbase = (const char*)(Pb + COL_DV + h * 128);
        const int kdst = krow * AT_KP + kseg * 16, vdst = vrow * AT_VP + vseg * 16;
        v4u rkA, rv0A, rv1A, rkB, rv0B, rv1B;
#define AT_LD(S, TT) do { const size_t adv_ = (size_t)(TT) * 64 * NIN * 2; const char* kb2_ = kbase + adv_; const char* vb2_ = vbase + adv_; rk##S = *(const GAS v4u*)(kb2_ + koff); rv0##S = *(const GAS v4u*)(vb2_ + voff); rv1##S = *(const GAS v4u*)(vb2_ + (size_t)32 * NIN * 2 + voff); } while (0)
#define AT_ST(S, BB) do { *(LAS v4u*)(Kl + (BB) * AT_KB + kdst) = rk##S; *(LAS v4u*)(Vl + (BB) * AT_VB + vdst) = rv0##S; *(LAS v4u*)(Vl + (BB) * AT_VB + vdst + 32 * AT_VP) = rv1##S; } while (0)
        AT_LD(A, NT - 1);
        AT_LD(B, NT - 2);
        __syncthreads();
        AT_ST(A, 0);
        __syncthreads();
#define AT_ITER(IT, SLD, SST) do { const int it = (IT); \
            const int t = NT - 1 - it, buf = it & 1; \
            if (it + 2 < NT) AT_LD(SLD, t - 2); \
            if (64 * t <= q0 + 31) { \
                f32x16 st[2]; \
            _Pragma("unroll") \
                for (int nb = 0; nb < 2; ++nb) { \
            _Pragma("unroll") \
                    for (int i = 0; i < 16; ++i) st[nb][i] = 0.f; \
            _Pragma("unroll") \
                    for (int s = 0; s < 4; ++s) { const bf16x8 kf = *(const LAS bf16x8*)(Kl + buf * AT_KB + (32 * nb + r) * AT_KP + (16 * s + 8 * hh) * 2); st[nb] = MFMA32(kf, qf[s], st[nb]); } \
                } \
                const bool band = (64 * t + 63 > q0); \
                float cs_ = cs; asm volatile("" : "+v"(cs_)); \
                const float basev = cs_ * (float)(64 * t - qpos + 4 * hh); \
                float mx = -3.0e38f; \
                if (band) { \
                    const int thr = qpos - 64 * t - 4 * hh; \
            _Pragma("unroll") \
                    for (int nb = 0; nb < 2; ++nb) \
            _Pragma("unroll") \
                        for (int i = 0; i < 16; ++i) { const int kc = 32 * nb + (i & 3) + 8 * (i >> 2); float v = fmaf(cs_, (float)kc, st[nb][i]); \
                            if (kc > thr) v = -1.0e30f; st[nb][i] = v; mx = fmaxf(mx, v); } \
                } else { \
            _Pragma("unroll") \
                    for (int nb = 0; nb < 2; ++nb) \
            _Pragma("unroll") \
                        for (int i = 0; i < 16; ++i) { const int kc = 32 * nb + (i & 3) + 8 * (i >> 2); const float v = fmaf(cs_, (float)kc, st[nb][i]); st[nb][i] = v; mx = fmaxf(mx, v); } \
                } \
                const float mxt = xhalf_max(mx + basev); \
                if (__builtin_amdgcn_ballot_w64(mxt > mrun + 8.0f) != 0ull) { \
                    const float mnew = fmaxf(mrun, mxt), alpha = __builtin_amdgcn_exp2f(mrun - mnew); mrun = mnew; lrun *= alpha; \
                    if (hh == 0) Al[r] = alpha; \
                    f32x4 a4[4]; \
            _Pragma("unroll") \
                    for (int g = 0; g < 4; ++g) a4[g] = *(const LAS f32x4*)(Al + 8 * g + 4 * hh); \
            _Pragma("unroll") \
                    for (int d = 0; d < 4; ++d) \
            _Pragma("unroll") \
                        for (int i = 0; i < 16; ++i) O[d][i] *= a4[i >> 2][i & 3]; \
                } \
                const float mref = mrun - basev; \
                float rs = 0.f; \
            _Pragma("unroll") \
                for (int nb = 0; nb < 2; ++nb) \
            _Pragma("unroll") \
                    for (int i = 0; i < 16; ++i) { const float p = __builtin_amdgcn_exp2f(st[nb][i] - mref); st[nb][i] = p; rs += p; } \
                rs = xhalf_sum(rs); lrun += rs; \
            _Pragma("unroll") \
                for (int nb = 0; nb < 2; ++nb) \
            _Pragma("unroll") \
                    for (int s2 = 0; s2 < 2; ++s2) { \
                        v4u pw; pw.x = pg8::cvt_pk_bf16(st[nb][8 * s2 + 0], st[nb][8 * s2 + 1]); pw.y = pg8::cvt_pk_bf16(st[nb][8 * s2 + 2], st[nb][8 * s2 + 3]); \
                        pw.z = pg8::cvt_pk_bf16(st[nb][8 * s2 + 4], st[nb][8 * s2 + 5]); pw.w = pg8::cvt_pk_bf16(st[nb][8 * s2 + 6], st[nb][8 * s2 + 7]); \
                        const bf16x8 pf = __builtin_bit_cast(bf16x8, pw); \
                        const LAS unsigned char* vb = Vl + buf * AT_VB + (32 * nb + 16 * s2) * AT_VP + vrd; \
            _Pragma("unroll") \
                        for (int d = 0; d < 4; ++d) { \
                            const v4i16_t lo = __builtin_amdgcn_ds_read_tr16_b64_v4i16((LAS v4i16_t*)(vb + d * 64)), hi = __builtin_amdgcn_ds_read_tr16_b64_v4i16((LAS v4i16_t*)(vb + d * 64 + 8 * AT_VP)); \
                            const bf16x8 vf = __builtin_shufflevector(lo, hi, 0, 1, 2, 3, 4, 5, 6, 7); \
                            O[d] = MFMA32(pf, vf, O[d]); \
                        } \
                    } \
            } \
            if (it + 1 < NT) AT_ST(SST, buf ^ 1); \
            HBAR(); } while (0)
#pragma unroll 1
        for (int it2 = 0; it2 < NT; it2 += 2) { AT_ITER(it2, A, B); AT_ITER(it2 + 1, B, A); }
#undef AT_ITER
#undef AT_LD
#undef AT_ST
        if (hh == 0) Al[r] = 1.0f / lrun;
        f32x4 a4[4];
#pragma unroll
        for (int g = 0; g < 4; ++g) a4[g] = *(const LAS f32x4*)(Al + 8 * g + 4 * hh);
        float* sp = scr + tid * 64; asm volatile("" : "+v"(sp));
        if (c == 0) {
#pragma unroll
            for (int d = 0; d < 4; ++d)
#pragma unroll
                for (int g = 0; g < 4; ++g) *(GAS f32x4*)(sp + d * 16 + 4 * g) = (f32x4){O[d][4 * g], O[d][4 * g + 1], O[d][4 * g + 2], O[d][4 * g + 3]} * a4[g];
        } else {
            asm volatile("s_waitcnt vmcnt(0)" ::: "memory");
#pragma unroll
            for (int d = 0; d < 4; ++d)
#pragma unroll
                for (int g = 0; g < 4; ++g) { const f32x4 o0 = *(const GAS f32x4*)(sp + d * 16 + 4 * g);
#pragma unroll
                    for (int j = 0; j < 4; ++j) O[d][4 * g + j] = o0[j] - lam * (O[d][4 * g + j] * a4[g][j]); }
        }
    }
    const float* sg = F.ka->in[8]; bf16* MIX = (bf16*)(F.ws + WS_XN);
    float gcol[4];
#pragma unroll
    for (int d = 0; d < 4; ++d) gcol[d] = sg[d * 32 + r] * 0.8f;
    unsigned char* obase = F.ws + WS_XN8 + ((size_t)b * SEQ + q0 + 4 * hh) * D + h * 128 + r; asm volatile("" : "+v"(obase));
#pragma unroll
    for (int i = 0; i < 16; ++i) {
        float p = (O[0][i] * O[0][i] + O[1][i] * O[1][i]) + (O[2][i] * O[2][i] + O[3][i] * O[3][i]);
        p += __shfl_xor(p, 1); p += __shfl_xor(p, 2); p += __shfl_xor(p, 4); p += __shfl_xor(p, 8); p += __shfl_xor(p, 16);
        const float rstd = __builtin_amdgcn_rsqf(p * (1.f / 128.f) + EPS);
        unsigned char* orow = obase + (size_t)((i & 3) + 8 * (i >> 2)) * D;
#pragma unroll
        for (int d = 0; d < 4; ++d) orow[d * 32] = (unsigned char)(int)rintf(__builtin_amdgcn_fmed3f(O[d][i] * rstd * gcol[d] * MIX_Q8, -127.f, 127.f));
    }
}
__device__ __forceinline__ int row16_max_i(int x) {
    x = max(x, DPPX(x, 0xB1)); x = max(x, DPPX(x, 0x4E)); x = max(x, DPPX(x, 0x141)); x = max(x, DPPX(x, 0x140)); return x; }
__device__ __forceinline__ float row16_sum_f(float x) {
    x += __int_as_float(DPPX(__float_as_int(x), 0xB1)); x += __int_as_float(DPPX(__float_as_int(x), 0x4E)); x += __int_as_float(DPPX(__float_as_int(x), 0x141)); x += __int_as_float(DPPX(__float_as_int(x), 0x140)); return x; }
__device__ __forceinline__ int f2sort(float f) { const int b = __float_as_int(f); return b ^ ((b >> 31) & 0x7fffffff); }
__device__ __forceinline__ float sort2f(int k) { return __int_as_float(k ^ ((k >> 31) & 0x7fffffff)); }
__device__ __forceinline__ void topk_phase(Frame& F) {
    const int tid = F.tid, lane = F.lane, w = F.wave, r = lane & 31, hh = lane >> 5, g16 = tid >> 4, l16 = tid & 15;
    LAS float* Sl = (LAS float*)F.lds;
    LAS float* SV = (LAS float*)(F.lds + 65536);
    LAS int* SI = (LAS int*)(F.lds + 65536 + 8192);
    const bf16* QP = (const bf16*)(F.ws + WS_WIN); const bf16* SUBK = (const bf16*)(F.ws + WS_SUBK);
    int* EIDX = (int*)(F.ws + WS_EIDX); float* GATE = (float*)(F.ws + WS_GATE);
#define TK_GLD(dst, ptr, off) asm volatile("global_load_dwordx4 %0, %1, off offset:" #off : "=v"(dst) : "v"(ptr) : "memory")
#define TK_LOADS(itx) do { const int head_ = (itx) & 7, tile_ = (itx) >> 3; \
        const bf16* Q_ = QP + (size_t)(tile_ * 64 + r) * 2048 + head_ * 256 + (w >> 2) * 128 + 8 * hh; const bf16* Q1_ = Q_ + (size_t)32 * 2048; \
        const bf16* SK_ = SUBK + ((size_t)(head_ * 2 + (w >> 2)) * 128 + 32 * (w & 3) + r) * 128 + 8 * hh; \
        TK_GLD(kf[0], SK_, 0); TK_GLD(q0[0], Q_, 0); TK_GLD(q1[0], Q1_, 0); TK_GLD(kf[1], SK_, 32); TK_GLD(q0[1], Q_, 32); TK_GLD(q1[1], Q1_, 32); \
        TK_GLD(kf[2], SK_, 64); TK_GLD(q0[2], Q_, 64); TK_GLD(q1[2], Q1_, 64); TK_GLD(kf[3], SK_, 96); TK_GLD(q0[3], Q_, 96); TK_GLD(q1[3], Q1_, 96); \
        TK_GLD(kf[4], SK_, 128); TK_GLD(q0[4], Q_, 128); TK_GLD(q1[4], Q1_, 128); TK_GLD(kf[5], SK_, 160); TK_GLD(q0[5], Q_, 160); TK_GLD(q1[5], Q1_, 160); \
        TK_GLD(kf[6], SK_, 192); TK_GLD(q0[6], Q_, 192); TK_GLD(q1[6], Q1_, 192); TK_GLD(kf[7], SK_, 224); TK_GLD(q0[7], Q_, 224); TK_GLD(q1[7], Q1_, 224); } while (0)
    bf16x8 kf[8], q0[8], q1[8];
    if (F.vcu < (M / 64) * PEER_H) TK_LOADS(F.vcu);
    for (int it = F.vcu; it < (M / 64) * PEER_H; it += F.G) {
        const int head = it & 7, tile = it >> 3;
        {
            const int c = w >> 2, kb = w & 3;
            f32x16 acc[2];
#pragma unroll
            for (int i = 0; i < 16; ++i) { acc[0][i] = 0.f; acc[1][i] = 0.f; }
            asm volatile("s_waitcnt vmcnt(0)" ::: "memory");
#pragma unroll
            for (int s = 0; s < 8; ++s) asm volatile("" : "+v"(kf[s]), "+v"(q0[s]), "+v"(q1[s]));
#pragma unroll
            for (int s = 0; s < 8; ++s) { acc[0] = MFMA32(q0[s], kf[s], acc[0]); acc[1] = MFMA32(q1[s], kf[s], acc[1]); }
            HBAR();
#pragma unroll
            for (int tb = 0; tb < 2; ++tb)
#pragma unroll
                for (int i = 0; i < 16; ++i) Sl[(32 * tb + crow(i, hh)) * 256 + c * 128 + 32 * kb + r] = acc[tb][i];
            if (it + F.G < (M / 64) * PEER_H) TK_LOADS(it + F.G);
        }
        HBAR();
#pragma unroll 1
        for (int rd = 0; rd < 4; ++rd) {
            const int row = rd * 32 + g16, tok = row >> 1, c = row & 1;
            int key[8];
#pragma unroll
            for (int s = 0; s < 8; ++s) { const int idx = s * 16 + l16; key[s] = (f2sort(Sl[tok * 256 + c * 128 + idx]) & ~127) | (127 - idx); }
#define TK_CE(i, j) do { const int hi_ = max(key[i], key[j]), lo_ = min(key[i], key[j]); key[i] = hi_; key[j] = lo_; } while (0)
            TK_CE(0, 1); TK_CE(2, 3); TK_CE(4, 5); TK_CE(6, 7); TK_CE(0, 2); TK_CE(1, 3); TK_CE(4, 6); TK_CE(5, 7); TK_CE(1, 2); TK_CE(5, 6); TK_CE(0, 4); TK_CE(3, 7);
            TK_CE(1, 5); TK_CE(2, 6); TK_CE(1, 4); TK_CE(3, 6); TK_CE(2, 4); TK_CE(3, 5); TK_CE(3, 4);
#undef TK_CE
            int mine = 0;
#pragma unroll 1
            for (int k = 0; k < 16; ++k) {
                const int m = row16_max_i(key[0]);
                if (l16 == k) mine = m;
                const bool pop = (key[0] == m);
#pragma unroll
                for (int s = 0; s < 7; ++s) key[s] = pop ? key[s + 1] : key[s];
                key[7] = pop ? (int)0x80000000 : key[7];
            }
            SV[(tok * 2 + c) * 16 + l16] = sort2f(mine & ~127); SI[(tok * 2 + c) * 16 + l16] = 127 - (mine & 127);
        }
        HBAR();
#pragma unroll 1
        for (int rd = 0; rd < 2; ++rd) {
            const int tok = rd * 32 + g16;
            const float sv0 = SV[(tok * 2) * 16 + l16];
            int ptr = 0;
            int key = (f2sort(sv0 + SV[(tok * 2 + 1) * 16]) & ~255) | (255 - (l16 * 16));
            int mine = 0;
#pragma unroll 1
            for (int k = 0; k < 16; ++k) {
                const int m = row16_max_i(key);
                if (l16 == k) mine = m;
                if (key == m) { ++ptr; key = (ptr < 16) ? ((f2sort(sv0 + SV[(tok * 2 + 1) * 16 + (ptr & 15)]) & ~255) | (255 - (l16 * 16 + ptr))) : (int)0x80000000; }
            }
            const int flat = 255 - (mine & 255), aw = flat >> 4, bw = flat & 15;
            const float best = sort2f(mine & ~255);
            const int e = SI[(tok * 2) * 16 + aw] * 128 + SI[(tok * 2 + 1) * 16 + bw];
            const float mx = sort2f(row16_max_i(mine) & ~255);
            const float ex = __expf(best - mx), sum = row16_sum_f(ex);
            const size_t o = (size_t)(tile * 64 + tok) * NSEL + head * 16 + l16;
            EIDX[o] = e; GATE[o] = ex / sum;
        }
    }
#undef TK_LOADS
#undef TK_GLD
    __syncthreads();
}
constexpr int PE_SH = 9, PE_NCH = NEXP >> PE_SH;
__device__ __forceinline__ int row16_sum_i(int x) { x += DPPX(x, 0xB1); x += DPPX(x, 0x4E); x += DPPX(x, 0x141); x += DPPX(x, 0x140); return x; }
__device__ __forceinline__ int wave_sum_i(int x) { x = row16_sum_i(x); return __builtin_amdgcn_readlane(x, 0) + __builtin_amdgcn_readlane(x, 16) + __builtin_amdgcn_readlane(x, 32) + __builtin_amdgcn_readlane(x, 48); }
__device__ __forceinline__ void peer_down_phase(Frame& F) {
    const int tid = F.tid, lane = F.lane, w = F.wave;
    LAS unsigned char* XQ = F.lds;
    LAS unsigned* LIST = (LAS unsigned*)(F.lds + 131072);
    LAS float* SX = (LAS float*)(F.lds + 131072 + 16384);
    LAS unsigned* CNT = (LAS unsigned*)(F.lds + 131072 + 16384 + 128);
    const float* gf = F.ka->in[17]; const float* SSQ2 = (const float*)(F.ws + WS_SSQ2); const unsigned char* DOWN = F.ws + WS_DOWN; const float* DSC = (const float*)(F.ws + WS_DSC);
    const int* EIDX = (const int*)(F.ws + WS_EIDX); const float* GATE = (const float*)(F.ws + WS_GATE); float* WSEL = (float*)(F.ws + WS_WSEL);
    for (int g = F.vcu; g < M / 32; g += F.G) {
        const int t0 = g * 32;
        __syncthreads();
        if (tid < 64) CNT[tid] = 0u;
#pragma unroll 1
        for (int k = 0; k < 4; ++k) {
            const int tl = w * 4 + k; const size_t t = (size_t)(t0 + tl);
            const float rstd = __builtin_amdgcn_rsqf(wave_sum(SSQ2[t * 64 + lane]) * (1.f / 4096.f) + EPS);
            const bf16* h2 = (const bf16*)(F.ws + WS_XN) + t * D;
            f32x4 x[16]; float am = 0.f;
#pragma unroll
            for (int i = 0; i < 4; ++i) { const int e0 = (i * 64 + lane) * 16; const v4u ha = *(const GAS v4u*)(h2 + e0), hb = *(const GAS v4u*)(h2 + e0 + 8);
                const f32x4 hv[4] = {(f32x4){bflo(ha.x), bfhi(ha.x), bflo(ha.y), bfhi(ha.y)}, (f32x4){bflo(ha.z), bfhi(ha.z), bflo(ha.w), bfhi(ha.w)}, (f32x4){bflo(hb.x), bfhi(hb.x), bflo(hb.y), bfhi(hb.y)}, (f32x4){bflo(hb.z), bfhi(hb.z), bflo(hb.w), bfhi(hb.w)}};
#pragma unroll
                for (int q = 0; q < 4; ++q) { const f32x4 v = hv[q] * *(const GAS f32x4*)(gf + e0 + 4 * q) * rstd; x[4 * i + q] = v;
                    am = fmaxf(am, fmaxf(fmaxf(fabsf(v.x), fabsf(v.y)), fmaxf(fabsf(v.z), fabsf(v.w)))); } }
#pragma unroll
            for (int o = 1; o < 64; o <<= 1) am = fmaxf(am, __shfl_xor(am, o));
            const float qs = (am > 0.f) ? 127.0f / am : 1.0f;
#pragma unroll
            for (int i = 0; i < 4; ++i) { v4u pk;
                pk.x = pack_i8x4(x[4 * i + 0].x * qs, x[4 * i + 0].y * qs, x[4 * i + 0].z * qs, x[4 * i + 0].w * qs); pk.y = pack_i8x4(x[4 * i + 1].x * qs, x[4 * i + 1].y * qs, x[4 * i + 1].z * qs, x[4 * i + 1].w * qs);
                pk.z = pack_i8x4(x[4 * i + 2].x * qs, x[4 * i + 2].y * qs, x[4 * i + 2].z * qs, x[4 * i + 2].w * qs); pk.w = pack_i8x4(x[4 * i + 3].x * qs, x[4 * i + 3].y * qs, x[4 * i + 3].z * qs, x[4 * i + 3].w * qs);
                *(LAS v4u*)(XQ + tl * 4096 + (i * 64 + lane) * 16) = pk; }
            if (lane == 0) SX[tl] = (am > 0.f) ? am * (1.0f / 127.0f) : 1.0f;
        }
        unsigned rec[8];
#pragma unroll
        for (int k = 0; k < 8; ++k) { const int r = tid + 512 * k, tl = r >> 7, j = r & 127; const unsigned e = (unsigned)EIDX[(size_t)(t0 + tl) * NSEL + j]; rec[k] = e | ((unsigned)tl << 14) | ((unsigned)j << 19); }
        __syncthreads();
#pragma unroll
        for (int k = 0; k < 8; ++k) (void)__hip_atomic_fetch_add((unsigned*)&CNT[(rec[k] & 16383u) >> PE_SH], 1u, __ATOMIC_RELAXED, __HIP_MEMORY_SCOPE_WORKGROUP);
        __syncthreads();
        if (tid == 0) { unsigned run = 0u; for (int c = 0; c < PE_NCH; ++c) { const unsigned n = CNT[c]; CNT[32 + c] = run; run += n; } }
        __syncthreads();
#pragma unroll
        for (int k = 0; k < 8; ++k) { const unsigned pos = __hip_atomic_fetch_add((unsigned*)&CNT[32 + ((rec[k] & 16383u) >> PE_SH)], 1u, __ATOMIC_RELAXED, __HIP_MEMORY_SCOPE_WORKGROUP); LIST[pos] = rec[k]; }
        __syncthreads();
#pragma unroll 1
        for (int p = w * 8; p < 4096; p += 64) {
            const unsigned myrec = LIST[p + (lane & 7)];
            const unsigned me = myrec & 16383u, mtl = (myrec >> 14) & 31u, mj = myrec >> 19;
            const size_t oidx = (size_t)(t0 + (int)mtl) * NSEL + mj;
            const float mg = GATE[oidx], md = DSC[me], ms = SX[mtl];
            v4u v[8][4];
#pragma unroll
            for (int k = 0; k < 8; ++k) { const unsigned e = (unsigned)__builtin_amdgcn_readlane((int)me, k); const unsigned char* rowp = DOWN + (size_t)e * D + lane * 16;
#pragma unroll
                for (int i = 0; i < 4; ++i) v[k][i] = *(const GAS v4u*)(rowp + i * 1024); }
            int res = 0;
#pragma unroll
            for (int k = 0; k < 8; ++k) { const unsigned tl = (unsigned)__builtin_amdgcn_readlane((int)mtl, k); const LAS unsigned char* xp = XQ + tl * 4096 + lane * 16; int a = 0;
#pragma unroll
                for (int i = 0; i < 4; ++i) { const v4u xv = *(const LAS v4u*)(xp + i * 1024);
                    a = __builtin_amdgcn_sdot4((int)v[k][i].x, (int)xv.x, a, false); a = __builtin_amdgcn_sdot4((int)v[k][i].y, (int)xv.y, a, false);
                    a = __builtin_amdgcn_sdot4((int)v[k][i].z, (int)xv.z, a, false); a = __builtin_amdgcn_sdot4((int)v[k][i].w, (int)xv.w, a, false); }
                const int tot = wave_sum_i(a);
                if (lane == k) res = tot; }
            if (lane < 8) { const float act = (float)res * ms * md; WSEL[oidx] = mg * 0.5f * act * (1.0f + erff(act * 0.70710678118654752f)); }
        }
    }
    __syncthreads();
}
__device__ __forceinline__ void peer_up_phase(Frame& F) {
    typedef float f32x2_ __attribute__((ext_vector_type(2)));
    typedef _Float16 h16x8 __attribute__((ext_vector_type(8)));
    const int tid = F.tid, lane = F.lane, w = F.wave;
    LAS h16x8* ACH = (LAS h16x8*)F.lds;
    LAS unsigned* LREC = (LAS unsigned*)(F.lds + 131072);
    LAS float* LW = (LAS float*)(F.lds + 131072 + 8192);
    LAS float* PR = (LAS float*)(F.lds + 131072 + 16384);
    const unsigned char* UP = F.ws + WS_UP; const float* USC = (const float*)(F.ws + WS_USC); const int* EIDX = (const int*)(F.ws + WS_EIDX); const float* WSEL = (const float*)(F.ws + WS_WSEL); const float* fg = F.ka->in[22];
    for (int g = F.vcu; g < M / 16; g += F.G) {
        const int t0 = g * 16;
        __syncthreads();
        {
            LAS unsigned* HR = LREC + 256 * w; LAS float* HW = LW + 256 * w;
#pragma unroll
            for (int i = 0; i < 4; ++i) { const size_t o = (size_t)(t0 + 2 * w + (i >> 1)) * NSEL + (i & 1) * 64 + lane; const unsigned e = (unsigned)EIDX[o]; HR[64 * i + lane] = e; HW[64 * i + lane] = WSEL[o] * USC[e]; }
            asm volatile("s_waitcnt lgkmcnt(0)" ::: "memory");
            const unsigned char* ub = UP + lane * 16;
            float ra[64];
#pragma unroll
            for (int e = 0; e < 64; ++e) ra[e] = 0.f;
            v4u vn[4][2];
#pragma unroll
            for (int q = 0; q < 4; ++q) { const unsigned char* rp = ub + (size_t)(HR[q] & 16383u) * 2048; vn[q][0] = *(const GAS v4u*)rp; vn[q][1] = *(const GAS v4u*)(rp + 1024); }
#pragma unroll 1
            for (int p = 0; p < 256; p += 4) {
                v4u v[4][2];
#pragma unroll
                for (int q = 0; q < 4; ++q) { v[q][0] = vn[q][0]; v[q][1] = vn[q][1]; }
                { const int pn = (p + 4 < 256) ? p + 4 : p;
#pragma unroll
                  for (int q = 0; q < 4; ++q) { const unsigned char* rp = ub + (size_t)(HR[pn + q] & 16383u) * 2048; vn[q][0] = *(const GAS v4u*)rp; vn[q][1] = *(const GAS v4u*)(rp + 1024); } }
#pragma unroll
                for (int q = 0; q < 4; ++q) {
                    const float wv = HW[p + q];
#pragma unroll
                    for (int k = 0; k < 2; ++k) { const unsigned vw[4] = {v[q][k].x, v[q][k].y, v[q][k].z, v[q][k].w};
#pragma unroll
                        for (int d = 0; d < 4; ++d) { const int b = 32 * k + 8 * d;
                            const f32x2_ c0 = __builtin_amdgcn_cvt_scalef32_pk_f32_fp4(vw[d], 1.0f, 0), c1 = __builtin_amdgcn_cvt_scalef32_pk_f32_fp4(vw[d], 1.0f, 1), c2 = __builtin_amdgcn_cvt_scalef32_pk_f32_fp4(vw[d], 1.0f, 2), c3 = __builtin_amdgcn_cvt_scalef32_pk_f32_fp4(vw[d], 1.0f, 3);
                            ra[b + 0] = fmaf(wv, c0.x, ra[b + 0]); ra[b + 1] = fmaf(wv, c0.y, ra[b + 1]); ra[b + 2] = fmaf(wv, c1.x, ra[b + 2]); ra[b + 3] = fmaf(wv, c1.y, ra[b + 3]);
                            ra[b + 4] = fmaf(wv, c2.x, ra[b + 4]); ra[b + 5] = fmaf(wv, c2.y, ra[b + 5]); ra[b + 6] = fmaf(wv, c3.x, ra[b + 6]); ra[b + 7] = fmaf(wv, c3.y, ra[b + 7]); } }
                }
                if ((p & 127) == 124) { asm volatile("; token done: store its row" ::: "memory");
                    LAS h16x8* ap = ACH + (2 * w + (p >> 7)) * 512 + lane;
#pragma unroll
                    for (int c = 0; c < 8; ++c) { h16x8 t;
#pragma unroll
                        for (int e = 0; e < 8; ++e) { t[e] = (_Float16)ra[8 * c + e]; ra[8 * c + e] = 0.f; }
                        ap[64 * c] = t; } }
            }
        }
        __syncthreads();
        {
            int tq = tid; asm volatile("" : "+v"(tq));
            const int col0 = 8 * tq;
            const f32x4 g0 = *(const GAS f32x4*)(fg + col0), g1 = *(const GAS f32x4*)(fg + col0 + 4);
#pragma unroll 1
            for (int kk = 0; kk < 2; ++kk) {
                f32x4 y0[8], y1[8];
                if (kk) __syncthreads();
#pragma unroll
                for (int k = 0; k < 8; ++k) { const int tk = 8 * kk + k; const v4u hb = *(const GAS v4u*)((const bf16*)(F.ws + WS_XN) + (size_t)(t0 + tk) * D + col0);
                    const h16x8 a8 = ACH[tk * 512 + tq];
                    y0[k] = (f32x4){bflo(hb.x), bfhi(hb.x), bflo(hb.y), bfhi(hb.y)} + (f32x4){(float)a8[0], (float)a8[1], (float)a8[2], (float)a8[3]};
                    y1[k] = (f32x4){bflo(hb.z), bfhi(hb.z), bflo(hb.w), bfhi(hb.w)} + (f32x4){(float)a8[4], (float)a8[5], (float)a8[6], (float)a8[7]};
                    float ss = ((y0[k].x * y0[k].x + y0[k].y * y0[k].y) + (y0[k].z * y0[k].z + y0[k].w * y0[k].w)) + ((y1[k].x * y1[k].x + y1[k].y * y1[k].y) + (y1[k].z * y1[k].z + y1[k].w * y1[k].w));
                    ss = wave_sum(ss);
                    if (lane == 0) PR[k * 8 + w] = ss; }
                __syncthreads();
#pragma unroll
                for (int k = 0; k < 8; ++k) { const f32x4 p0 = *(const LAS f32x4*)(PR + k * 8), p1 = *(const LAS f32x4*)(PR + k * 8 + 4);
                    const float tot = ((p0.x + p0.y) + (p0.z + p0.w)) + ((p1.x + p1.y) + (p1.z + p1.w));
                    const float rstd = __builtin_amdgcn_rsqf(tot * (1.f / 4096.f) + EPS);
                    float* orow = F.out + (size_t)(t0 + 8 * kk + k) * D + col0;
                    *(GAS f32x4*)orow = y0[k] * rstd * g0; *(GAS f32x4*)(orow + 4) = y1[k] * rstd * g1; }
            }
        }
    }
    __syncthreads();
}
constexpr int N_PHASES = 12;
__global__ void __launch_bounds__(NTHR, 2) hybrid_fwd(Args args) {
    extern __shared__ __attribute__((aligned(16))) unsigned char lds[];
    Frame F;
    F.lds = (LAS unsigned char*)lds;
    F.MISC = (volatile LAS unsigned*)(F.lds + MISC_OFF);
    F.tid = threadIdx.x; F.lane = F.tid & 63; F.wave = __builtin_amdgcn_readfirstlane(F.tid >> 6);
    F.G = gridDim.x; { const int bx = blockIdx.x; F.vcu = (F.G % 8 == 0) ? (bx % 8) * (F.G / 8) + bx / 8 : bx; }
    F.ws = args.ws; F.ctl = (gu32*)(args.ws + WS_CTL); F.out = args.out;
    F.ka = (const Args*)__builtin_amdgcn_kernarg_segment_ptr();
    for (int u = F.tid; u < (LDS_BYTES - LDSCTL_OFF) / 4; u += NTHR) ((LAS unsigned*)(F.lds + LDSCTL_OFF))[u] = 0u;
    __syncthreads();
    XcdBarrier bar; bar.bar = (unsigned*)(F.ctl + CW_BAR); bar.x = 0; bar.st = nullptr;
    if (args.use_bar) bar = xcd_barrier_post((unsigned*)(F.ctl + CW_BAR), F.MISC + 8);
    const int lo = args.ph_lo, hi = args.ph_hi;
#ifndef PH_MASK
#define PH_MASK 0xfff
#endif
#define IN(k) ((((PH_MASK) >> (k)) & 1) && lo <= (k) && (k) < hi)
#define SEAM(k) do { if (IN(k) && IN((k) + 1)) xcd_barrier(bar); } while (0)
    unsigned char* ws = args.ws;
    bf16* XN = (bf16*)(ws + WS_XN);


    if (IN(1)) { p0_prologue(F); } SEAM(1);

    if (IN(2)) {
        {
            constexpr unsigned segs8 = []{ unsigned m = 0; int n = 0; for (int sgi = 0; sgi < 7; ++sgi) if ((FP8_SEGS >> sgi) & 1) { m |= (unsigned)sgi << (3 * n); ++n; } return m; }();
            constexpr unsigned segs16 = []{ unsigned m = 0; int n = 0; for (int sgi = 0; sgi < 7; ++sgi) if (!((FP8_SEGS >> sgi) & 1)) { m |= (unsigned)sgi << (3 * n); ++n; } return m; }();
            constexpr int n8 = __builtin_popcount(FP8_SEGS & 0x7f), n16 = 7 - n8;
            if (n8 > 0) { pg8::Gemm g{(const bf16*)(ws + WS_XN8), (const bf16*)(ws + WS_WIN8), D / 2, D / 2, D / 2, 0, 0, 0, 0}; pg8::SegOrder S; S.init(M, n8, segs8, F.G, (int)blockIdx.x);
                pg8::EpiInproj E{(bf16*)(ws + WS_PROJ), NIN, F.ka->in[9], (const float*)(ws + WS_SA), 1.0f / WIN_QS};
                pg8::gemm_phase<pg8::EpiInproj, pg8::SegOrder, true, true, true>(F.lds, g, S, E); }
            if (n16 > 0) { pg8::Gemm g{XN, (const bf16*)(ws + WS_WIN), D, D, D, 0, 0, 0, 0}; pg8::SegOrder S; S.init(M, n16, segs16, F.G, (int)blockIdx.x);
                pg8::EpiInproj E{(bf16*)(ws + WS_PROJ), NIN, F.ka->in[9], nullptr, 1.0f};
                pg8::gemm_phase<pg8::EpiInproj, pg8::SegOrder, true, true, false>(F.lds, g, S, E); }
        }
    } SEAM(2);

    if (IN(3)) {
        const int s3 = F.vcu & 3;
        { const int kvc = (s3 == 1 || s3 == 2) ? (F.vcu >> 2) * 2 + (s3 - 1) : 128 + F.vcu;
          pg8::Gemm g{(const bf16*)(ws + WS_MEMN), (const bf16*)(ws + WS_WCKV), D / 2, D / 2, D / 2, 0, 0, 0, 0}; pg8::StaticOrder S; S.init(MROWS, 2 * D, F.G, kvc, 1 << 20);
          pg8::EpiBf16Z E{nullptr, 2 * D, 0, 0, ws + WS_KV, KV_Q8, 1.0f / (KV_Q8 * WIN_QS)};
          pg8::gemm_phase<pg8::EpiBf16Z, pg8::StaticOrder, true, true, true>(F.lds, g, S, E); }
#ifndef NO_HGRN
        if (s3 == 0) for (int u = F.vcu >> 2; u < 64; u += F.G / 4) hgrn_head_mfma(F, u >> 4, u & 15);
#endif
#ifndef NO_ATTN
        float lam;
        { int ln_ = F.lane; asm volatile("" : "+v"(ln_)); const float a = wave_sum(F.ka->in[4][ln_] * F.ka->in[5][ln_]), c = wave_sum(F.ka->in[6][ln_] * F.ka->in[7][ln_]); lam = __expf(a) - __expf(c) + 0.2f; }
        for (int u = F.vcu; u < 256; u += F.G) {
            const int bh = u >> 2, s = u & 3;
            const unsigned qlist = (s == 0) ? 0x013u : (s == 1) ? 0x48CDu : (s == 2) ? 0x267ABu : 0x59EFu; const int nq = (s == 0) ? 3 : (s == 2) ? 5 : 4;
#pragma unroll 1
            for (int k = 0; k < nq; ++k) { const int qb = (int)((qlist >> (4 * k)) & 15u); attn_unit(F, bh >> 4, bh & 15, qb, lam); }
        }
#endif
    } SEAM(3);

    if (IN(4)) {
        for (int r = (int)blockIdx.x * NTHR + F.tid; r < M; r += F.G * NTHR) ((float*)(ws + WS_SA))[r] = 1.0f / MIX_Q8;
        { pg8::Gemm g{(const bf16*)(ws + WS_KV), (const bf16*)(ws + WS_WCQ), 512, D, D / 2, (size_t)MEML * D, 512, 0, 512}; pg8::BatchOrder S; S.init(4, 4, 1, 16, F.G, (int)blockIdx.x);
          pg8::EpiBf16Z E{(bf16*)(ws + WS_WKP), D, (size_t)1024 * D, (size_t)256 * D, nullptr, 0.f, 1.0f / (KV_Q8 * WIN_QS)};
          pg8::gemm_phase<pg8::EpiBf16Z, pg8::BatchOrder, true, true, true>(F.lds, g, S, E); }
        { pg8::Gemm g{(const bf16*)(ws + WS_WCO), (const bf16*)(ws + WS_KV + D), 512, D / 2, D, 0, 512, (size_t)MEML * D, 512}; pg8::BatchOrder S; S.init(4, 4, 16, 1, F.G, (int)blockIdx.x);
          pg8::EpiBf16Z E{(bf16*)(ws + WS_VP), 1024, (size_t)D * 1024, 256, nullptr, 0.f, 1.0f / (KV_Q8 * WIN_QS)};
          pg8::gemm_phase<pg8::EpiBf16Z, pg8::BatchOrder, true, true, true>(F.lds, g, S, E); }
    } SEAM(4);

    if (IN(5)) {
        pg8::Gemm g{(const bf16*)(ws + WS_XN8), (const bf16*)(ws + WS_WOUT), D / 2, D / 2, D / 2, 0, 0, 0, 0}; pg8::StaticOrder S; S.init(M, D, F.G, (int)blockIdx.x, 1 << 20);
        pg8::EpiResid<false> E{F.ka->in[0], (bf16*)(ws + WS_H1B), (float*)(ws + WS_SSQ1), (const float*)(ws + WS_SA), 1.0f / WIN_QS};
        pg8::gemm_phase<pg8::EpiResid<false>, pg8::StaticOrder, true, true, true>(F.lds, g, S, E);
    } SEAM(5);

    if (IN(6)) {
        pg8::Gemm g{(const bf16*)(ws + WS_H1B), (const bf16*)(ws + WS_WKP), D, D, D, 0, 0, (size_t)1024 * D, 0}; pg8::StaticOrder S; S.init(M, 1024, F.G, (int)blockIdx.x, 16);
        pg8::EpiSoftmax E{(bf16*)(ws + WS_PB), 1024, (const float*)(ws + WS_SSQ1), 0.03125f * LOG2E};
        pg8::gemm_phase<pg8::EpiSoftmax, pg8::StaticOrder, false, true>(F.lds, g, S, E);
    } SEAM(6);

    if (IN(7)) {
        pg8::Gemm g{(const bf16*)(ws + WS_PB), (const bf16*)(ws + WS_VP), 1024, 1024, 1024, 0, 0, (size_t)D * 1024, 0}; pg8::StaticOrder S; S.init(M, D, F.G, (int)blockIdx.x, 16);
        pg8::EpiResid<true> E{(const bf16*)(ws + WS_H1B), XN, (float*)(ws + WS_SSQ2), nullptr, 1.0f, ws + WS_XN8, (const float*)(ws + WS_SSQ1)};
        pg8::gemm_phase<pg8::EpiResid<true>, pg8::StaticOrder, true, true>(F.lds, g, S, E);
    } SEAM(7);

    if (IN(8)) {
        pg8::Gemm g{(const bf16*)(ws + WS_XN8), (const bf16*)(ws + WS_WPQ), D / 2, D / 2, D / 2, 0, 0, 0, 0}; pg8::StaticOrder S; S.init(M, 2048, F.G, (int)blockIdx.x, 1 << 20);
        pg8::EpiRowScale E{(bf16*)(ws + WS_WIN), 2048, (const float*)(ws + WS_SSQ2), (const float*)(ws + WS_SSQ1), 1.0f / WIN_QS};
        pg8::gemm_phase<pg8::EpiRowScale, pg8::StaticOrder, true, true, true>(F.lds, g, S, E);
    } SEAM(8);

    if (IN(9)) { topk_phase(F); } SEAM(9);
    if (IN(10)) { peer_down_phase(F); } SEAM(10);
    if (IN(11)) { peer_up_phase(F); }
#undef IN
#undef SEAM
}

#ifndef MK_SPLIT
#define MK_SPLIT 0
#endif
#ifndef PROBE_REP_MASK
#define PROBE_REP_MASK 0x0
#endif
#ifndef MK_LAST_PHASE
#define MK_LAST_PHASE N_PHASES
#endif
extern "C" void kernel_launch(void* const* d_in, const int* in_sizes, int n_in, void* d_out, int out_size, void* d_ws, size_t ws_size, hipStream_t stream) {
    static int grid = 0;
    if (grid == 0) {
        if (n_in != 23 || out_size != M * D || ws_size < WS_END2) { fprintf(stderr, "kernel_launch: unexpected shapes (n_in %d out %d ws %zu)\n", n_in, out_size, ws_size); grid = -1; return; }
        int dev = 0, cus = 0, per_cu = 0;
        if (hipGetDevice(&dev) != hipSuccess || hipDeviceGetAttribute(&cus, hipDeviceAttributeMultiprocessorCount, dev) != hipSuccess) { grid = -1; return; }
        if (hipFuncSetAttribute((const void*)hybrid_fwd, hipFuncAttributeMaxDynamicSharedMemorySize, LDS_BYTES) != hipSuccess) { fprintf(stderr, "kernel_launch: hipFuncSetAttribute failed\n"); grid = -1; return; }
        if (hipOccupancyMaxActiveBlocksPerMultiprocessor(&per_cu, (const void*)hybrid_fwd, NTHR, LDS_BYTES) != hipSuccess || per_cu < 1) fprintf(stderr, "kernel_launch: occupancy query reports %d\n", per_cu);
        (void)hipGetLastError();
        grid = cus;
        if (grid != 256) { fprintf(stderr, "kernel_launch: built for 256 CUs, device has %d\n", cus); grid = -1; return; }
    }
    if (grid < 0) return;
    (void)hipMemsetAsync((char*)d_ws + WS_CTL, 0, CTL_ZERO_BYTES, stream);
    Args a{};
    for (int i = 0; i < 23; ++i) a.in[i] = (const float*)d_in[i];
    a.out = (float*)d_out; a.ws = (unsigned char*)d_ws; a.pad = 0;
#if MK_SPLIT
    for (int p = 0; p < MK_LAST_PHASE; ++p) { a.ph_lo = p; a.ph_hi = p + 1; a.use_bar = 0;
        for (int rep = 0; rep < 1 + ((PROBE_REP_MASK >> p) & 1); ++rep) hipLaunchKernelGGL(hybrid_fwd, dim3(grid), dim3(NTHR), LDS_BYTES, stream, a); }
#else
    a.ph_lo = 0; a.ph_hi = MK_LAST_PHASE; a.use_bar = 1;
    hipLaunchKernelGGL(hybrid_fwd, dim3(grid), dim3(NTHR), LDS_BYTES, stream, a);
#endif
}
```
